# Optimizing an MI355X kernel written in HIP

```python
import math
import jax, jax.numpy as jnp
from jax import lax
import numpy as np

D_MODEL = 2048
BATCH = 1
SEQ = 8192
DEPTH = 1

N_DIFF_HEADS = 8
DIFF_HEAD_DIM = D_MODEL // N_DIFF_HEADS // 2
DIFF_V_DIM = 2 * DIFF_HEAD_DIM
QK_WIDTH = 2 * N_DIFF_HEADS * DIFF_HEAD_DIM
ATTN_WIDTH = N_DIFF_HEADS * DIFF_V_DIM
ROPE_THETA = 500000.0
ROPE_DIM = DIFF_HEAD_DIM // 4
Q_BLOCK = 128
CONV_WIDTH = D_MODEL
CONV_K = 3
N_BRANCHES = 2
IN_WIDTH = 2 * QK_WIDTH + ATTN_WIDTH + 3 * CONV_WIDTH + N_BRANCHES * D_MODEL
N_EXPERTS = 32
TOP_K = 4
D_EXPERT = D_MODEL
SWIGLU_LIMIT = 7.0
SWIGLU_ALPHA = 1.702
MOE_BLOCK = 128
NORM_EPS = 1e-5
N_MOD = 6

kernel_name = 'hybrid_diffattn_shortconv_moe_block'


def rms_norm(x, g):
    x32 = x.astype(jnp.float32)
    y = x32 * lax.rsqrt(jnp.mean(x32 * x32, axis=-1, keepdims=True) + NORM_EPS)
    return (y * g.astype(jnp.float32)).astype(x.dtype)


def rope_tables(positions):
    inv_freq = ROPE_THETA ** (-jnp.arange(0, ROPE_DIM, 2, dtype=jnp.float32) / ROPE_DIM)
    ang = positions.astype(jnp.float32)[..., None] * inv_freq
    return jnp.cos(ang), jnp.sin(ang)


def apply_partial_rope(t, cos, sin):
    rot, rest = t[..., :ROPE_DIM], t[..., ROPE_DIM:]
    half = ROPE_DIM // 2
    r1, r2 = rot[..., :half], rot[..., half:]
    cc = cos[:, :, None, :].astype(t.dtype)
    ss = sin[:, :, None, :].astype(t.dtype)
    rot = jnp.concatenate([r1 * cc - r2 * ss, r2 * cc + r1 * ss], axis=-1)
    return jnp.concatenate([rot, rest], axis=-1)


def diff_attention(q, k, v, lam):
    B, S = q.shape[0], q.shape[1]
    n_blocks = S // Q_BLOCK
    scale = DIFF_HEAD_DIM ** -0.5
    k32 = k.astype(jnp.float32)
    v32 = v.astype(jnp.float32)
    qb = q.astype(jnp.float32).reshape(B, n_blocks, Q_BLOCK, 2 * N_DIFF_HEADS, DIFF_HEAD_DIM)
    qb = jnp.moveaxis(qb, 1, 0)
    key_idx = jnp.arange(S)
    neg = jnp.finfo(jnp.float32).min

    def one_block(args):
        q_blk, b_idx = args
        s = jnp.einsum('bqhd,bkhd->bhqk', q_blk, k32) * scale
        q_idx = b_idx * Q_BLOCK + jnp.arange(Q_BLOCK)
        causal = key_idx[None, :] <= q_idx[:, None]
        s = jnp.where(causal[None, None], s, neg)
        p = jax.nn.softmax(s, axis=-1).reshape(B, N_DIFF_HEADS, 2, Q_BLOCK, S)
        a = p[:, :, 0] - lam * p[:, :, 1]
        return jnp.einsum('bhqk,bkhe->bqhe', a, v32)

    o = lax.map(one_block, (qb, jnp.arange(n_blocks)))
    return jnp.moveaxis(o, 0, 1).reshape(B, S, N_DIFF_HEADS, DIFF_V_DIM)


def short_gated_conv(gate_b, gate_c, h_c, conv_w):
    u = gate_c * h_c
    conv = lax.conv_general_dilated(
        u, conv_w[:, None, :].astype(u.dtype), window_strides=(1,),
        padding=[(CONV_K - 1, 0)], dimension_numbers=('NWC', 'WIO', 'NWC'),
        feature_group_count=CONV_WIDTH)
    return gate_b * conv


def hybrid_mixer(h, cos, sin, w_in, conv_w, lq1, lk1, lq2, lk2, subln_g,
                 w_attn_out, w_conv_out, w_o, lambda_init):
    B, S, _ = h.shape
    widths = [QK_WIDTH, QK_WIDTH, ATTN_WIDTH, CONV_WIDTH, CONV_WIDTH, CONV_WIDTH, D_MODEL, D_MODEL]
    split_at = [int(v) for v in np.cumsum(widths)[:-1]]
    proj = h @ w_in
    q, k, v, cb, cc, ch, g_attn, g_conv = jnp.split(proj, split_at, axis=-1)

    q = apply_partial_rope(q.reshape(B, S, 2 * N_DIFF_HEADS, DIFF_HEAD_DIM), cos, sin)
    k = apply_partial_rope(k.reshape(B, S, 2 * N_DIFF_HEADS, DIFF_HEAD_DIM), cos, sin)
    v = v.reshape(B, S, N_DIFF_HEADS, DIFF_V_DIM)
    f32 = jnp.float32
    lam = (jnp.exp(jnp.sum(lq1.astype(f32) * lk1.astype(f32)))
           - jnp.exp(jnp.sum(lq2.astype(f32) * lk2.astype(f32))) + lambda_init)
    o = diff_attention(q, k, v, lam)
    o = rms_norm(o, subln_g) * (1.0 - lambda_init)
    y_attn = o.reshape(B, S, ATTN_WIDTH).astype(h.dtype) @ w_attn_out

    y_conv = short_gated_conv(cb, cc, ch, conv_w) @ w_conv_out

    merged = jax.nn.sigmoid(g_attn) * y_attn + jax.nn.sigmoid(g_conv) * y_conv
    return merged @ w_o


def clamped_swiglu(hup):
    x_glu, x_lin = hup[..., ::2], hup[..., 1::2]
    x_glu = jnp.minimum(x_glu, SWIGLU_LIMIT)
    x_lin = jnp.clip(x_lin, -SWIGLU_LIMIT, SWIGLU_LIMIT)
    return x_glu * jax.nn.sigmoid(SWIGLU_ALPHA * x_glu) * (x_lin + 1.0)


def moe(h, w_router, b_router, w_up, b_up, w_down, b_down):
    B, S, D = h.shape
    T = B * S
    xt = h.reshape(T, D)
    logits = (xt @ w_router).astype(jnp.float32) + b_router.astype(jnp.float32)
    top_vals, top_idx = lax.top_k(logits, TOP_K)
    top_w = jax.nn.softmax(top_vals, axis=-1)

    A = T * TOP_K
    flat_e = top_idx.reshape(A)
    flat_tok = jnp.repeat(jnp.arange(T, dtype=jnp.int32), TOP_K)
    flat_w = top_w.reshape(A)
    order = jnp.argsort(flat_e)
    se, stok, sw = flat_e[order], flat_tok[order], flat_w[order]

    counts = jnp.bincount(flat_e, length=N_EXPERTS)
    start = jnp.cumsum(counts) - counts
    padded = (counts + MOE_BLOCK - 1) // MOE_BLOCK * MOE_BLOCK
    pend = jnp.cumsum(padded)
    pstart = pend - padded
    dest = pstart[se] + (jnp.arange(A) - start[se])

    n_blocks = -(-(A + N_EXPERTS * (MOE_BLOCK - 1)) // MOE_BLOCK)
    P = n_blocks * MOE_BLOCK
    slot_tok = jnp.full((P,), T, dtype=jnp.int32).at[dest].set(stok)
    slot_w = jnp.zeros((P,), jnp.float32).at[dest].set(sw)
    block_e = jnp.minimum(
        jnp.searchsorted(pend, jnp.arange(n_blocks) * MOE_BLOCK, side='right'),
        N_EXPERTS - 1)

    x_pad = jnp.concatenate([xt, jnp.zeros((1, D), xt.dtype)], axis=0)
    xs = x_pad[slot_tok].reshape(n_blocks, MOE_BLOCK, D)

    def expert_block(args):
        xb, e = args
        hup = xb @ w_up[e] + b_up[e]
        return clamped_swiglu(hup) @ w_down[e] + b_down[e]

    ys = lax.map(expert_block, (xs, block_e)).reshape(P, D)
    out = jnp.zeros((T + 1, D), jnp.float32).at[slot_tok].add(
        ys.astype(jnp.float32) * slot_w[:, None])
    return out[:T].reshape(B, S, D).astype(h.dtype)


def setup_inputs(seed: int = 0) -> dict:
    key = jax.random.key(seed)
    ks = jax.random.split(key, 26)
    f32 = jnp.float32
    nrm = lambda k, shape, s: jax.random.normal(k, shape, f32) * s
    L = DEPTH
    return {
        'x': nrm(ks[0], (BATCH, SEQ, D_MODEL), 1.0),
        'c': nrm(ks[1], (BATCH, D_MODEL), 1.0),
        'positions': jnp.broadcast_to(jnp.arange(SEQ, dtype=jnp.int32), (BATCH, SEQ)),
        'w_ada': nrm(ks[2], (L, D_MODEL, N_MOD * D_MODEL), D_MODEL ** -0.5),
        'b_ada': nrm(ks[3], (L, N_MOD * D_MODEL), 0.02),
        'norm1_g': 1.0 + nrm(ks[4], (L, D_MODEL), 0.02),
        'w_in': nrm(ks[5], (L, D_MODEL, IN_WIDTH), D_MODEL ** -0.5),
        'conv_w': nrm(ks[6], (L, CONV_K, CONV_WIDTH), CONV_K ** -0.5),
        'lambda_q1': nrm(ks[7], (L, DIFF_HEAD_DIM), 0.1),
        'lambda_k1': nrm(ks[8], (L, DIFF_HEAD_DIM), 0.1),
        'lambda_q2': nrm(ks[9], (L, DIFF_HEAD_DIM), 0.1),
        'lambda_k2': nrm(ks[10], (L, DIFF_HEAD_DIM), 0.1),
        'subln_g': 1.0 + nrm(ks[11], (L, DIFF_V_DIM), 0.02),
        'w_attn_out': nrm(ks[12], (L, ATTN_WIDTH, D_MODEL), ATTN_WIDTH ** -0.5),
        'w_conv_out': nrm(ks[13], (L, CONV_WIDTH, D_MODEL), CONV_WIDTH ** -0.5),
        'w_o': nrm(ks[14], (L, D_MODEL, D_MODEL), D_MODEL ** -0.5),
        'norm2_g': 1.0 + nrm(ks[15], (L, D_MODEL), 0.02),
        'w_router': nrm(ks[16], (L, D_MODEL, N_EXPERTS), D_MODEL ** -0.5),
        'b_router': nrm(ks[17], (L, N_EXPERTS), 0.01),
        'w_up': nrm(ks[18], (L, N_EXPERTS, D_MODEL, 2 * D_EXPERT), D_MODEL ** -0.5),
        'b_up': nrm(ks[19], (L, N_EXPERTS, 2 * D_EXPERT), 0.02),
        'w_down': nrm(ks[20], (L, N_EXPERTS, D_EXPERT, D_MODEL), D_EXPERT ** -0.5),
        'b_down': nrm(ks[21], (L, N_EXPERTS, D_MODEL), 0.02),
        'final_g': 1.0 + nrm(ks[22], (D_MODEL,), 0.02),
    }


def reference(x, c, positions, w_ada, b_ada, norm1_g, w_in, conv_w, lambda_q1, lambda_k1,
              lambda_q2, lambda_k2, subln_g, w_attn_out, w_conv_out, w_o, norm2_g,
              w_router, b_router, w_up, b_up, w_down, b_down, final_g):
    cos, sin = rope_tables(positions)
    c_act = jax.nn.silu(c)
    for l in range(DEPTH):
        lambda_init = 0.8 - 0.6 * math.exp(-0.3 * l)
        mod = c_act @ w_ada[l] + b_ada[l]
        sh1, sc1, g1, sh2, sc2, g2 = [m[:, None, :] for m in jnp.split(mod, N_MOD, axis=-1)]
        h = rms_norm(x, norm1_g[l]) * (1.0 + sc1) + sh1
        x = x + g1 * hybrid_mixer(h, cos, sin, w_in[l], conv_w[l], lambda_q1[l], lambda_k1[l],
                                  lambda_q2[l], lambda_k2[l], subln_g[l], w_attn_out[l],
                                  w_conv_out[l], w_o[l], lambda_init)
        h = rms_norm(x, norm2_g[l]) * (1.0 + sc2) + sh2
        x = x + g2 * moe(h, w_router[l], b_router[l], w_up[l], b_up[l], w_down[l], b_down[l])
    return rms_norm(x, final_g)
```

```cpp
#include <hip/hip_runtime.h>
#include <hip/hip_bf16.h>
#include <cstdio>
#include <cstdint>
namespace pg8 {
#define PG8_LAS __attribute__((address_space(3)))
typedef unsigned short bf16_t;
typedef short bf16x8 __attribute__((ext_vector_type(8)));
typedef float f32x4 __attribute__((ext_vector_type(4)));
typedef unsigned u32x4 __attribute__((ext_vector_type(4)));
constexpr int BM = 256, BK = 64, HALF = 128, HTB = HALF * BK * 2  , STAGE_BYTES = 8 * HTB, NXCD = 8, WGM = 8;

__host__ __device__ __forceinline__ int lds_byte(int r, int c) { const int st = (r >> 4) * 2 + (c >> 5), rr = r & 15, cc = c & 31, ob = rr * 64 + cc * 2; return st * 1024 + (ob ^ (((ob >> 9) & 1) << 5)); }
__host__ __device__ __forceinline__ void stage_rc(int b, int& R, int& C) { const int st = b / 1024, sb = b % 1024, swz = sb ^ (((sb >> 9) & 1) << 5); R = (st >> 1) * 16 + swz / 64; C = (st & 1) * 32 + (swz % 64) / 2; }
__host__ __device__ __forceinline__ int perm32(int rho) { const int n = rho >> 4, i = rho & 15; return 8 * (i >> 2) + 4 * n + (i & 3); }

struct Unit { int pm, pn, e; };
struct Gemm { const bf16_t* A; const bf16_t* Bt; int M, N, K; size_t estride; };

struct StaticOrder {
    int nM, nN, nwg, G, c;
    __host__ __device__ void init(int M, int N, int G_, int c_) { nM = M / BM; nN = N / BM; nwg = nM * nN; G = G_; c = c_; }
    __host__ __device__ bool next(int i, Unit& u) const {
        const long L = (long)i * G + c; if (L >= nwg) return false;
        int wgid = (int)L; { const int q = nwg / NXCD, r = nwg % NXCD, xcd = wgid % NXCD, off = wgid / NXCD; wgid = (xcd < r ? xcd * (q + 1) : r * (q + 1) + (xcd - r) * q) + off; }
        const int nig = WGM * nN, gid = wgid / nig, fm = gid * WGM, gsz = (nM - fm) < WGM ? (nM - fm) : WGM;
        u.pm = fm + ((wgid % nig) % gsz); u.pn = (wgid % nig) / gsz; u.e = 0; return true;
    }
    __device__ __forceinline__ void a_ready(const Unit&) const {}
    __device__ __forceinline__ void done(const Unit&) const {}
};


typedef unsigned u32x2 __attribute__((ext_vector_type(2)));
constexpr int T_ROWS = 8192, R_LD = 10240;
__device__ __forceinline__ unsigned cvt_pk_bf16(float lo, float hi) { unsigned r; asm volatile("v_cvt_pk_bf16_f32 %0, %1, %2" : "=v"(r) : "v"(lo), "v"(hi)); return r; }
__device__ __forceinline__ u32x2 pk4(f32x4 v) { u32x2 w; w.x = cvt_pk_bf16(v[0], v[1]); w.y = cvt_pk_bf16(v[2], v[3]); return w; }
__device__ __forceinline__ float bf_lo(unsigned w) { return __uint_as_float(w << 16); }
__device__ __forceinline__ float bf_hi(unsigned w) { return __uint_as_float(w & 0xffff0000u); }
__device__ __forceinline__ float sigm(float x) { return __builtin_amdgcn_rcpf(1.0f + __expf(-x)); }
__device__ __forceinline__ f32x4 sig4(u32x2 g) { return (f32x4){sigm(bf_lo(g.x)), sigm(bf_hi(g.x)), sigm(bf_lo(g.y)), sigm(bf_hi(g.y))}; }

struct EpiInProj {
    static constexpr bool PERM = false, AFTER_DRAIN = false;
    bf16_t* Q; bf16_t* K; bf16_t* V; bf16_t* R; const float* rope;
    __device__ __forceinline__ void operator()(const f32x4 (&acc)[2][2][4][2], const Unit& u, int wr, int wc, int fr, int fq) const {
        const int row0 = u.pm * BM + wr * 64 + fr; const int pn = u.pn;
        if (pn < 16) {
            bf16_t* base = (pn < 8) ? Q : K; const int hp = (pn & 7) * 2;
#pragma unroll
            for (int ai = 0; ai < 2; ++ai)
#pragma unroll
                for (int m = 0; m < 4; ++m) { const int row = row0 + ai * HALF + m * 16;
                    f32x4 cs = (f32x4){1.f, 1.f, 1.f, 1.f}, sn = (f32x4){0.f, 0.f, 0.f, 0.f};
                    if (wc == 0) { cs = *(const f32x4*)(rope + (size_t)row * 32 + 4 * fq); sn = *(const f32x4*)(rope + (size_t)row * 32 + 16 + 4 * fq); }
#pragma unroll
                    for (int bj = 0; bj < 2; ++bj) { f32x4 v0 = acc[ai][bj][m][0], v1 = acc[ai][bj][m][1];
                        if (wc == 0) { const f32x4 r1 = v0 * cs - v1 * sn, r2 = v1 * cs + v0 * sn; v0 = r1; v1 = r2; }
                        bf16_t* dst = base + ((size_t)(hp + bj) * T_ROWS + row) * 128 + wc * 32 + 4 * fq;
                        *(u32x2*)dst = pk4(v0); *(u32x2*)(dst + 16) = pk4(v1); } }
        } else if (pn < 24) {
            const int hv = (pn - 16) * 2;
#pragma unroll
            for (int ai = 0; ai < 2; ++ai)
#pragma unroll
                for (int m = 0; m < 4; ++m) { const int row = row0 + ai * HALF + m * 16;
#pragma unroll
                    for (int bj = 0; bj < 2; ++bj) { bf16_t* dst = V + ((size_t)(hv + bj) * T_ROWS + row) * 128 + wc * 32 + 4 * fq;
                        *(u32x2*)dst = pk4(acc[ai][bj][m][0]); *(u32x2*)(dst + 16) = pk4(acc[ai][bj][m][1]); } }
        } else {
            const int col0 = (pn - 24) * BM + wc * 32 + 4 * fq;
#pragma unroll
            for (int ai = 0; ai < 2; ++ai)
#pragma unroll
                for (int m = 0; m < 4; ++m) { const int row = row0 + ai * HALF + m * 16;
#pragma unroll
                    for (int bj = 0; bj < 2; ++bj) { bf16_t* dst = R + (size_t)row * R_LD + col0 + bj * HALF;
                        *(u32x2*)dst = pk4(acc[ai][bj][m][0]); *(u32x2*)(dst + 16) = pk4(acc[ai][bj][m][1]); } }
        }
    }
};
struct EpiGate {
    static constexpr bool PERM = false, AFTER_DRAIN = false;
    float* C; const bf16_t* G;
    __device__ __forceinline__ void operator()(const f32x4 (&acc)[2][2][4][2], const Unit& u, int wr, int wc, int fr, int fq) const {
        const int row0 = u.pm * BM + wr * 64 + fr, col0 = u.pn * BM + wc * 32 + 4 * fq;
#pragma unroll
        for (int ai = 0; ai < 2; ++ai)
#pragma unroll
            for (int m = 0; m < 4; ++m) { const int row = row0 + ai * HALF + m * 16;
#pragma unroll
                for (int bj = 0; bj < 2; ++bj)
#pragma unroll
                    for (int n = 0; n < 2; ++n) { const int col = col0 + bj * HALF + n * 16;
                        const u32x2 g = *(const u32x2*)(G + (size_t)row * R_LD + col);
                        *(f32x4*)(C + (size_t)row * 2048 + col) = acc[ai][bj][m][n] * sig4(g); } }
    }
};
struct EpiMerge {
    static constexpr bool PERM = false, AFTER_DRAIN = false;
    const float* Tm; bf16_t* O; const bf16_t* G;
    __device__ __forceinline__ void operator()(const f32x4 (&acc)[2][2][4][2], const Unit& u, int wr, int wc, int fr, int fq) const {
        const int row0 = u.pm * BM + wr * 64 + fr, col0 = u.pn * BM + wc * 32 + 4 * fq;
#pragma unroll
        for (int ai = 0; ai < 2; ++ai)
#pragma unroll
            for (int m = 0; m < 4; ++m) { const int row = row0 + ai * HALF + m * 16;
#pragma unroll
                for (int bj = 0; bj < 2; ++bj)
#pragma unroll
                    for (int n = 0; n < 2; ++n) { const int col = col0 + bj * HALF + n * 16;
                        const u32x2 g = *(const u32x2*)(G + (size_t)row * R_LD + col);
                        const f32x4 tv = *(const f32x4*)(Tm + (size_t)row * 2048 + col);
                        *(u32x2*)(O + (size_t)row * 2048 + col) = pk4(tv + acc[ai][bj][m][n] * sig4(g)); } }
    }
};
struct EpiResid {
    static constexpr bool PERM = false, AFTER_DRAIN = false;
    const float* X; float* O; const float* gate;
    __device__ __forceinline__ void operator()(const f32x4 (&acc)[2][2][4][2], const Unit& u, int wr, int wc, int fr, int fq) const {
        const int row0 = u.pm * BM + wr * 64 + fr, col0 = u.pn * BM + wc * 32 + 4 * fq;
        f32x4 gv[2][2];
#pragma unroll
        for (int bj = 0; bj < 2; ++bj)
#pragma unroll
            for (int n = 0; n < 2; ++n) gv[bj][n] = *(const f32x4*)(gate + col0 + bj * HALF + n * 16);
#pragma unroll
        for (int ai = 0; ai < 2; ++ai)
#pragma unroll
            for (int m = 0; m < 4; ++m) { const int row = row0 + ai * HALF + m * 16;
#pragma unroll
                for (int bj = 0; bj < 2; ++bj)
#pragma unroll
                    for (int n = 0; n < 2; ++n) { const size_t off = (size_t)row * 2048 + col0 + bj * HALF + n * 16;
                        *(f32x4*)(O + off) = *(const f32x4*)(X + off) + gv[bj][n] * acc[ai][bj][m][n]; } }
    }
};
__device__ __forceinline__ float swiglu1(float g, float l) { g = fminf(g, 7.0f); l = fminf(fmaxf(l, -7.0f), 7.0f); return g * sigm(1.702f * g) * (l + 1.0f); }
struct EpiSwiglu {
    static constexpr bool PERM = true, AFTER_DRAIN = false;
    bf16_t* O; const float* bias;
    __device__ __forceinline__ void operator()(const f32x4 (&acc)[2][2][4][2], const Unit& u, int wr, int wc, int fr, int fq) const {
        const int row0 = u.pm * BM + wr * 64 + fr, col0 = u.pn * BM + wc * 32 + 8 * fq; const float* bb = bias + (size_t)u.e * 4096;
        f32x4 bv[2][2];
#pragma unroll
        for (int bj = 0; bj < 2; ++bj)
#pragma unroll
            for (int n = 0; n < 2; ++n) bv[bj][n] = *(const f32x4*)(bb + col0 + bj * HALF + 4 * n);
#pragma unroll
        for (int ai = 0; ai < 2; ++ai)
#pragma unroll
            for (int m = 0; m < 4; ++m) { const int row = row0 + ai * HALF + m * 16;
#pragma unroll
                for (int bj = 0; bj < 2; ++bj) { const f32x4 v0 = acc[ai][bj][m][0] + bv[bj][0], v1 = acc[ai][bj][m][1] + bv[bj][1];
                    u32x2 w; w.x = cvt_pk_bf16(swiglu1(v0[0], v0[1]), swiglu1(v0[2], v0[3])); w.y = cvt_pk_bf16(swiglu1(v1[0], v1[1]), swiglu1(v1[2], v1[3]));
                    *(u32x2*)(O + (size_t)row * 2048 + ((col0 + bj * HALF) >> 1)) = w; } }
    }
};
struct EpiDown {
    static constexpr bool PERM = true, AFTER_DRAIN = false;
    bf16_t* O; const float* bias;
    __device__ __forceinline__ void operator()(const f32x4 (&acc)[2][2][4][2], const Unit& u, int wr, int wc, int fr, int fq) const {
        const int row0 = u.pm * BM + wr * 64 + fr, col0 = u.pn * BM + wc * 32 + 8 * fq; const float* bb = bias + (size_t)u.e * 2048;
        f32x4 bv[2][2];
#pragma unroll
        for (int bj = 0; bj < 2; ++bj)
#pragma unroll
            for (int n = 0; n < 2; ++n) bv[bj][n] = *(const f32x4*)(bb + col0 + bj * HALF + 4 * n);
#pragma unroll
        for (int ai = 0; ai < 2; ++ai)
#pragma unroll
            for (int m = 0; m < 4; ++m) { const int row = row0 + ai * HALF + m * 16;
#pragma unroll
                for (int bj = 0; bj < 2; ++bj) { const f32x4 v0 = acc[ai][bj][m][0] + bv[bj][0], v1 = acc[ai][bj][m][1] + bv[bj][1];
                    u32x4 w; w.x = cvt_pk_bf16(v0[0], v0[1]); w.y = cvt_pk_bf16(v0[2], v0[3]); w.z = cvt_pk_bf16(v1[0], v1[1]); w.w = cvt_pk_bf16(v1[2], v1[3]);
                    *(u32x4*)(O + (size_t)row * 2048 + col0 + bj * HALF) = w; } }
    }
};
struct MoeOrder {
    int nM, nN, nwg, G, c; const PG8_LAS int* tile_e;
    __device__ void init(int nTiles, int N, int G_, int c_, const PG8_LAS int* te) { nM = nTiles; nN = N / BM; nwg = nM * nN; G = G_; c = c_; tile_e = te; }
    __device__ bool next(int i, Unit& u) const {
        const long L = (long)i * G + c; if (L >= nwg) return false;
        int wgid = (int)L; { const int q = nwg / NXCD, r = nwg % NXCD, xcd = wgid % NXCD, off = wgid / NXCD; wgid = (xcd < r ? xcd * (q + 1) : r * (q + 1) + (xcd - r) * q) + off; }
        const int nig = WGM * nN, gid = wgid / nig, fm = gid * WGM, gsz = (nM - fm) < WGM ? (nM - fm) : WGM;
        u.pm = fm + ((wgid % nig) % gsz); u.pn = (wgid % nig) / gsz; u.e = tile_e[u.pm]; return true;
    }
    __device__ __forceinline__ void a_ready(const Unit&) const {}
    __device__ __forceinline__ void done(const Unit&) const {}
};
template <class Epi, class Sched, bool ALIGN_EPI = false, bool SP2 = false>
__device__ __forceinline__ void gemm_phase(PG8_LAS unsigned char* lds, const Gemm g, const Sched& S, const Epi& E, const int tid_in) {
    const int tid = tid_in, wid = __builtin_amdgcn_readfirstlane(tid >> 6), lane = tid & 63, wr = wid >> 2, wc = wid & 3, fr = lane & 15, fq = lane >> 4;
    const int K = g.K, nt = K / BK;
    unsigned voffA[2], voffB[2];
#pragma unroll
    for (int i = 0; i < 2; ++i) { int R, C; stage_rc(tid * 16 + i * 8192, R, C); const int Rb = Epi::PERM ? ((R & ~31) + perm32(R & 31)) : R;
        voffA[i] = (unsigned)(R * K + C) * 2u; voffB[i] = (unsigned)(Rb * K + C) * 2u; }
    const size_t kstep = (size_t)(BK * 2);
    const size_t hstep = (size_t)HALF * K * 2;
    const size_t tstep = 2 * hstep;
    const unsigned ldsw = (unsigned)wid * 1024u;
    const int aoff = lds_byte(wr * 64 + fr, fq * 8), boff = lds_byte(wc * 32 + fr, fq * 8);
#define PG8_SA(b, h) (((b) * 2 + (h)) * HTB)
#define PG8_SB(b, h) ((4 + (b) * 2 + (h)) * HTB)
#define PG8_STAGE(bufoff, gbase, voff) do { _Pragma("unroll") for (int _i = 0; _i < 2; ++_i) \
        __builtin_amdgcn_global_load_lds((const unsigned*)((const char*)(gbase) + (voff)[_i]), (PG8_LAS unsigned*)(lds + (bufoff) + ldsw + _i * 8192), 16, 0, 0); } while (0)
#define PG8_LDA(dst, b, h) do { _Pragma("unroll") for (int m = 0; m < 4; ++m) _Pragma("unroll") for (int k = 0; k < 2; ++k) dst[m][k] = *(const PG8_LAS bf16x8*)(lds + PG8_SA(b, h) + aoff + m * 2048 + k * 1024); } while (0)
#define PG8_LDB(dst, b, h) do { _Pragma("unroll") for (int n = 0; n < 2; ++n) _Pragma("unroll") for (int k = 0; k < 2; ++k) dst[n][k] = *(const PG8_LAS bf16x8*)(lds + PG8_SB(b, h) + boff + n * 2048 + k * 1024); } while (0)
#define PG8_MMA(ai, bj, At, Bt) do { __builtin_amdgcn_s_setprio(1); _Pragma("unroll") for (int m = 0; m < 4; ++m) _Pragma("unroll") for (int n = 0; n < 2; ++n) _Pragma("unroll") for (int k = 0; k < 2; ++k) \
        acc[ai][bj][m][n] = __builtin_amdgcn_mfma_f32_16x16x32_bf16(Bt[n][k], At[m][k], acc[ai][bj][m][n], 0, 0, 0); __builtin_amdgcn_s_setprio(0); } while (0)
#define PG8_WAIT_V(n) asm volatile("s_waitcnt vmcnt(" #n ")" ::: "memory")
#define PG8_WAIT_L(n) asm volatile("s_waitcnt lgkmcnt(" #n ")" ::: "memory")
#define PG8_BAR __builtin_amdgcn_s_barrier()
#define PG8_SCHED __builtin_amdgcn_sched_barrier(0)
    Unit cur, nxt; int ui = 0;
    if (!S.next(0, cur)) return;
    f32x4 acc[2][2][4][2];
#pragma unroll
    for (int a = 0; a < 2; ++a)
#pragma unroll
        for (int b = 0; b < 2; ++b)
#pragma unroll
            for (int m = 0; m < 4; ++m)
#pragma unroll
                for (int n = 0; n < 2; ++n) acc[a][b][m][n] = (f32x4){0.f, 0.f, 0.f, 0.f};
    bf16x8 At[4][2], B0[2][2], B1[2][2];
    const char* cA = (const char*)g.A + (size_t)cur.pm * tstep; const char* cB = (const char*)g.Bt + (size_t)cur.pn * tstep + (size_t)cur.e * g.estride;
    S.a_ready(cur);
    if constexpr (SP2) {
        PG8_STAGE(PG8_SB(0, 0), cB, voffB); PG8_STAGE(PG8_SB(0, 1), cB + hstep, voffB); PG8_STAGE(PG8_SA(0, 0), cA, voffA); PG8_STAGE(PG8_SA(0, 1), cA + hstep, voffA);
        if (wr == 1) PG8_BAR;
        PG8_WAIT_V(2); PG8_BAR;
        PG8_STAGE(PG8_SB(1, 0), cB + kstep, voffB); PG8_STAGE(PG8_SA(1, 0), cA + kstep, voffA); PG8_STAGE(PG8_SB(1, 1), cB + hstep + kstep, voffB);
        PG8_WAIT_V(6); PG8_BAR;
    } else {
        PG8_STAGE(PG8_SB(0, 0), cB, voffB); PG8_STAGE(PG8_SA(0, 0), cA, voffA); PG8_STAGE(PG8_SB(0, 1), cB + hstep, voffB); PG8_STAGE(PG8_SA(0, 1), cA + hstep, voffA);
        if (wr == 1) PG8_BAR;
        PG8_WAIT_V(4); PG8_BAR;
        PG8_STAGE(PG8_SB(1, 0), cB + kstep, voffB); PG8_STAGE(PG8_SA(1, 0), cA + kstep, voffA); PG8_STAGE(PG8_SB(1, 1), cB + hstep + kstep, voffB);
        PG8_WAIT_V(6); PG8_BAR;
    }
    for (;;) {
        const bool has_next = S.next(ui + 1, nxt);
        const char* nA = has_next ? (const char*)g.A + (size_t)nxt.pm * tstep : cA; const char* nB = has_next ? (const char*)g.Bt + (size_t)nxt.pn * tstep + (size_t)nxt.e * g.estride : cB;
        for (int t = 0; t < nt; t += 2) {
            const bool last = (t == nt - 2);
            const char* a1 = cA + (size_t)(t + 1) * kstep;
            const char* a2 = last ? nA : cA + (size_t)(t + 2) * kstep; const char* b2 = last ? nB : cB + (size_t)(t + 2) * kstep;
            const char* a3 = a2 + kstep; const char* b3 = b2 + kstep;
            if (last && has_next) S.a_ready(nxt);
            if constexpr (SP2) {
            PG8_LDB(B0, 0, 0); PG8_LDB(B1, 0, 1); PG8_SCHED; PG8_LDA(At, 0, 0); PG8_STAGE(PG8_SA(1, 1), a1 + hstep, voffA);
            PG8_WAIT_V(8); PG8_WAIT_L(0); PG8_BAR; PG8_MMA(0, 0, At, B0); PG8_MMA(0, 1, At, B1); PG8_BAR; PG8_SCHED;
            PG8_LDA(At, 0, 1); PG8_STAGE(PG8_SB(0, 0), b2, voffB); PG8_STAGE(PG8_SB(0, 1), b2 + hstep, voffB); PG8_STAGE(PG8_SA(0, 0), a2, voffA);
            PG8_WAIT_V(8); PG8_WAIT_L(0); PG8_BAR; PG8_MMA(1, 0, At, B0); PG8_MMA(1, 1, At, B1); PG8_BAR; PG8_SCHED;
            PG8_LDB(B0, 1, 0); PG8_LDB(B1, 1, 1); PG8_SCHED; PG8_LDA(At, 1, 0); PG8_STAGE(PG8_SA(0, 1), a2 + hstep, voffA);
            PG8_WAIT_V(8); PG8_WAIT_L(0); PG8_BAR; PG8_MMA(0, 0, At, B0); PG8_MMA(0, 1, At, B1); PG8_BAR; PG8_SCHED;
            PG8_LDA(At, 1, 1); PG8_STAGE(PG8_SB(1, 0), b3, voffB); PG8_STAGE(PG8_SB(1, 1), b3 + hstep, voffB); PG8_STAGE(PG8_SA(1, 0), a3, voffA);
            PG8_WAIT_V(8); PG8_WAIT_L(0); PG8_BAR; PG8_MMA(1, 0, At, B0); PG8_MMA(1, 1, At, B1); PG8_BAR; PG8_SCHED;
            } else {
            PG8_LDB(B0, 0, 0); PG8_SCHED; PG8_LDA(At, 0, 0); PG8_STAGE(PG8_SA(1, 1), a1 + hstep, voffA);
            PG8_WAIT_L(8); PG8_BAR; PG8_WAIT_L(0); PG8_MMA(0, 0, At, B0); PG8_BAR; PG8_SCHED;
            PG8_LDB(B1, 0, 1); PG8_STAGE(PG8_SB(0, 0), b2, voffB);
            PG8_BAR; PG8_WAIT_L(0); PG8_MMA(0, 1, At, B1); PG8_BAR;
            PG8_LDA(At, 0, 1); PG8_STAGE(PG8_SA(0, 0), a2, voffA);
            PG8_BAR; PG8_WAIT_L(0); PG8_MMA(1, 0, At, B0); PG8_BAR; PG8_SCHED;
            PG8_STAGE(PG8_SB(0, 1), b2 + hstep, voffB);
            PG8_WAIT_V(6); PG8_BAR; PG8_MMA(1, 1, At, B1); PG8_BAR;
            PG8_LDB(B0, 1, 0); PG8_SCHED; PG8_LDA(At, 1, 0); PG8_STAGE(PG8_SA(0, 1), a2 + hstep, voffA);
            PG8_WAIT_L(8); PG8_BAR; PG8_WAIT_L(0); PG8_MMA(0, 0, At, B0); PG8_BAR; PG8_SCHED;
            PG8_LDB(B1, 1, 1); PG8_STAGE(PG8_SB(1, 0), b3, voffB);
            PG8_BAR; PG8_WAIT_L(0); PG8_MMA(0, 1, At, B1); PG8_BAR;
            PG8_LDA(At, 1, 1); PG8_STAGE(PG8_SA(1, 0), a3, voffA);
            PG8_BAR; PG8_WAIT_L(0); PG8_MMA(1, 0, At, B0); PG8_BAR; PG8_SCHED;
            PG8_STAGE(PG8_SB(1, 1), b3 + hstep, voffB);
            PG8_WAIT_V(6); PG8_BAR; PG8_MMA(1, 1, At, B1); PG8_BAR;
            }
        }
        if constexpr (ALIGN_EPI) { if (wr == 0) PG8_BAR; }
        if constexpr (!Epi::AFTER_DRAIN) { E(acc, cur, wr, wc, fr, fq); S.done(cur); }
        if (!has_next) break;
#pragma unroll
        for (int a = 0; a < 2; ++a)
#pragma unroll
            for (int b = 0; b < 2; ++b)
#pragma unroll
                for (int m = 0; m < 4; ++m)
#pragma unroll
                    for (int n = 0; n < 2; ++n) acc[a][b][m][n] = (f32x4){0.f, 0.f, 0.f, 0.f};
        cur = nxt; cA = nA; cB = nB; ++ui;
        if constexpr (ALIGN_EPI) { if (wr == 1) PG8_BAR; }
    }
    PG8_WAIT_V(0);
    if constexpr (!ALIGN_EPI) { if (wr == 0) PG8_BAR; }
    PG8_BAR;
    if constexpr (Epi::AFTER_DRAIN) { E.fused(acc, cur, wr, wc, fr, fq, lds, wid, lane); S.done(cur); }
#undef PG8_SA
#undef PG8_SB
#undef PG8_STAGE
#undef PG8_LDA
#undef PG8_LDB
#undef PG8_MMA
#undef PG8_WAIT_V
#undef PG8_WAIT_L
#undef PG8_BAR
#undef PG8_SCHED
}
}

namespace attn {
constexpr int D = 128; constexpr float THR = 8.f; constexpr bool WSKIP = false; constexpr int LDO = 4096;
constexpr float SCALE = 0.08838834764831845f;
constexpr int NW = 8, QBLK = 32, KVBLK = 64, QB = NW * QBLK;
constexpr int SHM_V = KVBLK * D * 2, SHM_K = KVBLK * D * 2;
constexpr int LDS_BYTES = 2 * SHM_V + 2 * SHM_K + NW * 64 * 4;
static_assert(D == 128, "geometry");

using bf16 = __hip_bfloat16;
typedef short bf16x8 __attribute__((ext_vector_type(8)));
typedef short s16x4 __attribute__((ext_vector_type(4)));
typedef float f32x16 __attribute__((ext_vector_type(16)));
typedef float f32x4 __attribute__((ext_vector_type(4)));
typedef unsigned u32x4 __attribute__((ext_vector_type(4)));
template <class A, class Bt> struct same_t { static constexpr bool v = false; };
template <class A> struct same_t<A, A> { static constexpr bool v = true; };

#define KSWZ(row, colB) ((row) * 256 + ((colB) ^ (((row) & 7) << 4)))
#define SBAR() __builtin_amdgcn_sched_barrier(0)
__device__ __forceinline__ int v_st(int k, int c) { const int kk = (k & ~0xC) | ((k & 4) << 1) | ((k & 8) >> 1); return ((kk >> 3) * 4 + (c >> 5)) * 512 + ((kk & 7) * 32 + (c & 31)) * 2; }
__device__ __forceinline__ int v_rd_base(int lane) { return ((lane & 3) << 3) | (((lane >> 2) & 3) << 6) | (((lane >> 4) & 1) << 5) | (((lane >> 5) & 1) << 8); }
constexpr int v_rd_off(int d0, int ks, int half) { return d0 * 512 + ks * 4096 + half * 2048; }
__device__ __forceinline__ int crow(int r, int hi) { return (r & 3) + 8 * (r >> 2) + 4 * hi; }
__device__ __forceinline__ unsigned cvtpk(float lo, float hi) {
    unsigned r; asm volatile("v_cvt_pk_bf16_f32 %0, %1, %2" : "=v"(r) : "v"(lo), "v"(hi)); return r;
}
__device__ __forceinline__ bf16x8 pack8(f32x4 a, f32x4 b) {
    u32x4 w = {cvtpk(a[0], a[1]), cvtpk(a[2], a[3]), cvtpk(b[0], b[1]), cvtpk(b[2], b[3])};
    return *reinterpret_cast<bf16x8*>(&w);
}
template <class T> __device__ __forceinline__ bf16x8 load8(const T* p) {
    if constexpr (same_t<T, float>::v) { return pack8(*(const f32x4*)p, *(const f32x4*)(p + 4)); }
    else { return *reinterpret_cast<const bf16x8*>(p); }
}
__device__ __forceinline__ void mask_tile(f32x16& p0, f32x16& p1, int dq, unsigned W) {
    const float NEG = -__builtin_inff();
#pragma unroll
    for (int r = 0; r < 16; ++r) {
        const int c = (r & 3) + 8 * (r >> 2);
        if ((unsigned)(dq - c) >= W) p0[r] = NEG;
        if ((unsigned)(dq - c - 32) >= W) p1[r] = NEG;
    }
}
__device__ __forceinline__ void partialSM(f32x16& p0, f32x16& p1, float& m_reg, float& mn, float& alpha) {
    float pmax = p0[0]; for (int r = 1; r < 16; ++r) pmax = fmaxf(pmax, p0[r]); for (int r = 0; r < 16; ++r) pmax = fmaxf(pmax, p1[r]);
    { auto rr = __builtin_amdgcn_permlane32_swap(__float_as_uint(pmax), __float_as_uint(pmax), false, false);
      pmax = fmaxf(__uint_as_float(rr[0]), __uint_as_float(rr[1])); }
    constexpr float C2 = 1.4426950408889634f * SCALE;
    if (__builtin_expect(__all((pmax - m_reg) * SCALE <= THR), 1)) { mn = m_reg; alpha = 1.f; }
    else { mn = fmaxf(m_reg, pmax); alpha = __builtin_amdgcn_exp2f((m_reg - mn) * C2); m_reg = mn; }
    const float mnL = -mn * C2;
    for (int r = 0; r < 16; ++r) p0[r] = fmaf(p0[r], C2, mnL); for (int r = 0; r < 16; ++r) p1[r] = fmaf(p1[r], C2, mnL);
    for (int r = 0; r < 16; ++r) p0[r] = __builtin_amdgcn_exp2f(p0[r]);
}
__device__ __forceinline__ void finishSM(f32x16& p0, f32x16& p1, float alpha, float& l_reg, bf16x8& pa0, bf16x8& pa1, bf16x8& pa2, bf16x8& pa3) {
    for (int r = 0; r < 16; ++r) p1[r] = __builtin_amdgcn_exp2f(p1[r]);
    float ps = 0; for (int r = 0; r < 16; ++r) ps += p0[r]; for (int r = 0; r < 16; ++r) ps += p1[r];
    { auto rr = __builtin_amdgcn_permlane32_swap(__float_as_uint(ps), __float_as_uint(ps), false, false);
      ps = __uint_as_float(rr[0]) + __uint_as_float(rr[1]); }
    l_reg = l_reg * alpha + ps;
#define PK4(P, B_, OUT) do { unsigned a0 = cvtpk(P[B_+0], P[B_+1]), a1 = cvtpk(P[B_+2], P[B_+3]);                          \
        unsigned b0 = cvtpk(P[B_+4], P[B_+5]), b1 = cvtpk(P[B_+6], P[B_+7]);                                             \
        auto r0 = __builtin_amdgcn_permlane32_swap(a0, b0, false, false); auto r1 = __builtin_amdgcn_permlane32_swap(a1, b1, false, false); \
        u32x4 w = {r0[0], r1[0], r0[1], r1[1]}; OUT = *reinterpret_cast<bf16x8*>(&w); } while (0)
    PK4(p0, 0, pa0); PK4(p0, 8, pa1); PK4(p1, 0, pa2); PK4(p1, 8, pa3);
#undef PK4
}
template <int KB, bool SK>
__device__ __forceinline__ void qkt(f32x16& p0, f32x16& p1, const char* K_lds, int r32, int hi, const bf16x8* qr, bool act) {
    if (SK && !act) { const float NEG = -__builtin_inff();
#pragma unroll
        for (int r = 0; r < 16; ++r) { p0[r] = NEG; p1[r] = NEG; } return; }
    p0 = f32x16{}; p1 = f32x16{};
    const char* kb[4];
#pragma unroll
    for (int dd = 0; dd < 4; ++dd) kb[dd] = K_lds + KB * SHM_K + KSWZ(r32, (dd * 16 + hi * 8) * 2);
#pragma unroll
    for (int d0 = 0; d0 < 8; ++d0) { const char* a = kb[d0 & 3] + (d0 >> 2) * 128;
        bf16x8 b0 = *reinterpret_cast<const bf16x8*>(a);
        bf16x8 b1 = *reinterpret_cast<const bf16x8*>(a + 32 * 256);
        p0 = __builtin_amdgcn_mfma_f32_32x32x16_bf16(b0, qr[d0], p0, 0, 0, 0);
        p1 = __builtin_amdgcn_mfma_f32_32x32x16_bf16(b1, qr[d0], p1, 0, 0, 0); }
}
template <int VB, bool SK>
__device__ __forceinline__ void pv_tile(f32x16* o, int vb0, bf16x8 pa0, bf16x8 pa1, bf16x8 pa2, bf16x8 pa3, bool act) {
    if (SK && !act) return;
#define TRRD(dst, off) asm volatile("ds_read_b64_tr_b16 %0, %1 offset:%2" : "=&v"(dst) : "v"(vb0), "i"(off) : "memory")
#define PV_D0(d0) do { s16x4 l0, l1, l2, l3, h0, h1, h2, h3; constexpr int b_ = VB * SHM_V + v_rd_off(d0, 0, 0);     \
        TRRD(l0, b_); TRRD(h0, b_ + 2048); TRRD(l1, b_ + 4096); TRRD(h1, b_ + 6144); TRRD(l2, b_ + 8192); TRRD(h2, b_ + 10240); TRRD(l3, b_ + 12288); TRRD(h3, b_ + 14336); \
        asm volatile("s_waitcnt lgkmcnt(0)" ::: "memory"); SBAR();                 \
        o[d0] = __builtin_amdgcn_mfma_f32_32x32x16_bf16(pa0, (bf16x8){l0[0], l0[1], l0[2], l0[3], h0[0], h0[1], h0[2], h0[3]}, o[d0], 0, 0, 0);   \
        o[d0] = __builtin_amdgcn_mfma_f32_32x32x16_bf16(pa1, (bf16x8){l1[0], l1[1], l1[2], l1[3], h1[0], h1[1], h1[2], h1[3]}, o[d0], 0, 0, 0);   \
        o[d0] = __builtin_amdgcn_mfma_f32_32x32x16_bf16(pa2, (bf16x8){l2[0], l2[1], l2[2], l2[3], h2[0], h2[1], h2[2], h2[3]}, o[d0], 0, 0, 0);   \
        o[d0] = __builtin_amdgcn_mfma_f32_32x32x16_bf16(pa3, (bf16x8){l3[0], l3[1], l3[2], l3[3], h3[0], h3[1], h3[2], h3[3]}, o[d0], 0, 0, 0); } while (0)
    PV_D0(0); PV_D0(1); PV_D0(2); PV_D0(3);
#undef PV_D0
#undef TRRD
}

template <class TIn, class TOut> struct BlockRef { const TIn* Q; const TIn* K; const TIn* V; TOut* O; int P0; };
template <class TIn> struct Seam {
    bf16x8 qr[8];
    bf16x8 st_v0, st_v1, st_k0, st_k1; f32x4 sf0, sf1, sf2, sf3;
    f32x4 tq[16];
};
__device__ __forceinline__ int swa_jlo(int P0, int W) { const int lowk = P0 - W + 1; return lowk > 0 ? lowk / KVBLK : 0; }
#define ROW(p, k0, rr) ((p) + (size_t)((k0) + (rr)) * D + sc)
#define VMW() asm volatile("s_waitcnt vmcnt(0)" ::: "memory")
#define VMWN(n) asm volatile("s_waitcnt vmcnt(%0)" :: "i"(n) : "memory")
#define SLOAD_H(Kp, Vp, k0) do { S.st_v0 = load8<TIn>(ROW(Vp, k0, sr)); S.st_v1 = load8<TIn>(ROW(Vp, k0, 32 + sr));              \
                         S.st_k0 = load8<TIn>(ROW(Kp, k0, sr)); S.st_k1 = load8<TIn>(ROW(Kp, k0, 32 + sr)); } while (0)
#define SWRITE_HK(bf) do { *(bf16x8*)(K_lds + (bf) * SHM_K + kws) = S.st_k0; *(bf16x8*)(K_lds + (bf) * SHM_K + kws + 32 * 256) = S.st_k1; } while (0)
#define SWRITE_HV(bf) do { *(bf16x8*)(V_lds + (bf) * SHM_V + vst0) = S.st_v0; *(bf16x8*)(V_lds + (bf) * SHM_V + vst1) = S.st_v1; } while (0)
#define SWRITE_H(bf) do { SWRITE_HV(bf); SWRITE_HK(bf); } while (0)
#define SLOAD_F(p, k0) do { S.sf0 = *(const f32x4*)ROW(p, k0, sr); S.sf1 = *(const f32x4*)(ROW(p, k0, sr) + 4);                \
                            S.sf2 = *(const f32x4*)ROW(p, k0, 32 + sr); S.sf3 = *(const f32x4*)(ROW(p, k0, 32 + sr) + 4); } while (0)
#define SWRITE_KF(bf) do { *(bf16x8*)(K_lds + (bf) * SHM_K + kws) = pack8(S.sf0, S.sf1); *(bf16x8*)(K_lds + (bf) * SHM_K + kws + 32 * 256) = pack8(S.sf2, S.sf3); } while (0)
#define SWRITE_VF(bf) do { *(bf16x8*)(V_lds + (bf) * SHM_V + vst0) = pack8(S.sf0, S.sf1); *(bf16x8*)(V_lds + (bf) * SHM_V + vst1) = pack8(S.sf2, S.sf3); } while (0)
template <class TIn, class TOut>
__device__ __forceinline__ void causal_swa_prime(const BlockRef<TIn, TOut>& cur, int W, char* lds, Seam<TIn>& S, const int tid_in) {
    constexpr bool F32 = same_t<TIn, float>::v;
    const int tid = tid_in, wid = __builtin_amdgcn_readfirstlane(tid >> 6), lane = tid & 63, r32 = lane & 31, hi = lane >> 5;
    const int sr = tid >> 4, sc = (tid & 15) * 8, kws = KSWZ(sr, sc * 2); char* K_lds = lds + 2 * SHM_V;
    const int kb0 = swa_jlo(cur.P0, W) * KVBLK;
    for (int d0 = 0; d0 < 8; ++d0) S.qr[d0] = load8<TIn>(cur.Q + (size_t)(wid * QBLK + r32) * D + d0 * 16 + hi * 8);
    if constexpr (F32) { SLOAD_F((const float*)cur.K, kb0); VMW(); SWRITE_KF(0); SBAR(); SLOAD_F((const float*)cur.V, kb0); }
    else { SLOAD_H(cur.K, cur.V, kb0); VMW(); SWRITE_HK(0); }
    __syncthreads();
}
template <class TIn, class TOut>
__device__ __forceinline__ void causal_swa_block(const BlockRef<TIn, TOut>& cur, const BlockRef<TIn, TOut>& nxt, int skv, int W, char* lds, Seam<TIn>& S, const int tid_in) {
    constexpr bool F32 = same_t<TIn, float>::v;
    const int tid = tid_in, wid = __builtin_amdgcn_readfirstlane(tid >> 6), lane = tid & 63, r32 = lane & 31, hi = lane >> 5;
    const int j_lo = swa_jlo(cur.P0, W);
    int j_hi = (cur.P0 + QB - 1) / KVBLK + 1; if (j_hi > skv / KVBLK) j_hi = skv / KVBLK;
    const int NT = j_hi - j_lo;
    const int kbn = swa_jlo(nxt.P0, W) * KVBLK;
    const int qlo = cur.P0 + wid * QBLK, qm = qlo + r32 - 4 * hi;
    char* V_lds = lds; char* K_lds = lds + 2 * SHM_V;
    float* ws = (float*)(lds + 2 * SHM_V + 2 * SHM_K) + wid * 64; float* li_l = ws, * al_l = ws + 32;
    float m_reg = -1e30f, l_reg = 0; f32x16 o[4] = {};
    const int sr = tid >> 4, sc = (tid & 15) * 8, vst0 = v_st(sr, sc), vst1 = v_st(32 + sr, sc), kws = KSWZ(sr, sc * 2);
    const int vb0 = (int)(uintptr_t)V_lds + v_rd_base(lane);
    const TIn* Kh = cur.K; const TIn* Vh = cur.V;
#define RESC(a) do { if (__any((a) < 1.f)) { if (hi == 0) al_l[r32] = (a); asm volatile("s_waitcnt lgkmcnt(0)" ::: "memory");              \
                     for (int d_ = 0; d_ < 4; ++d_) for (int r = 0; r < 16; ++r) o[d_][r] *= al_l[crow(r, hi)]; } } while (0)
#define KBASE(t) ((j_lo + (t)) * KVBLK)
#define ACT(t) (KBASE(t) <= qlo + QBLK - 1 && KBASE(t) + KVBLK - 1 >= qlo - W + 1)
#define MASKT(P0_, P1_, t) do { const int kb_ = KBASE(t); if ((!SK || ACT(t)) && (kb_ + KVBLK - 1 > qlo || kb_ <= qlo + QBLK - 1 - W)) mask_tile(P0_, P1_, qm - kb_, (unsigned)W); } while (0)
    constexpr int NQL = F32 ? 16 : 8;
    constexpr bool SK = WSKIP && !F32;
#define SEAM_K0() do { VMWN(NQL); if constexpr (F32) { SWRITE_KF(0); SBAR(); SLOAD_F((const float*)nxt.V, kbn); } else { SWRITE_HK(0); } SBAR(); } while (0)
    f32x16 pA0, pA1, pB0, pB1; float mnA, mnB, alA, alB; bf16x8 pa0, pa1, pa2, pa3;
    if constexpr (F32) { VMW(); SWRITE_VF(0); SBAR(); } else { SWRITE_HV(0); SBAR(); }
    if (NT > 1) { if constexpr (F32) SLOAD_F((const float*)Kh, KBASE(1)); else SLOAD_H(Kh, Vh, KBASE(1)); }
    SBAR(); qkt<0, SK>(pA0, pA1, K_lds, r32, hi, S.qr, ACT(0));
    if constexpr (F32) { if (NT > 1) { VMW(); SWRITE_KF(1); SBAR(); SLOAD_F((const float*)Vh, KBASE(1)); } }
    MASKT(pA0, pA1, 0); partialSM(pA0, pA1, m_reg, mnA, alA);
    if (NT > 1) { VMW(); if constexpr (F32) { SWRITE_VF(1); SBAR(); if (NT > 2) SLOAD_F((const float*)Kh, KBASE(2)); } else SWRITE_H(1); }
    __syncthreads();
#define HALF_STEP(PX0, PX1, mnX, alX, PY0, PY1, alY, t, KB, VB, SB) do {                                                      \
        SBAR(); qkt<KB, SK>(PX0, PX1, K_lds, r32, hi, S.qr, ACT(t));                                             \
        finishSM(PY0, PY1, alY, l_reg, pa0, pa1, pa2, pa3); SBAR();                                                           \
        if ((t) + 1 < NT) { if constexpr (F32) { VMW(); SWRITE_KF(SB); SBAR(); SLOAD_F((const float*)Vh, KBASE((t) + 1)); }  \
                            else { SLOAD_H(Kh, Vh, KBASE((t) + 1)); } SBAR(); }                                               \
        pv_tile<VB, SK>(o, vb0, pa0, pa1, pa2, pa3, ACT((t) - 1)); MASKT(PX0, PX1, (t)); partialSM(PX0, PX1, m_reg, mnX, alX);                                        \
        __syncthreads();                                                                                                      \
        if ((t) + 1 < NT) { VMW(); if constexpr (F32) { SWRITE_VF(SB); SBAR(); if ((t) + 2 < NT) SLOAD_F((const float*)Kh, KBASE((t) + 2)); } \
                            else { SWRITE_H(SB); } }                                                                          \
        RESC(alX); __syncthreads(); } while (0)
    for (int t = 1; t + 1 < NT; t += 2) {
        HALF_STEP(pB0, pB1, mnB, alB, pA0, pA1, alA, t, 1, 0, 0);
        HALF_STEP(pA0, pA1, mnA, alA, pB0, pB1, alB, t + 1, 0, 1, 1);
    }
    const bool even = (NT & 1) == 0;
    if (even) { SBAR(); qkt<1, SK>(pB0, pB1, K_lds, r32, hi, S.qr, ACT(NT - 1)); SBAR(); }
#define QROW(e) (nxt.Q + (size_t)(wid * QBLK + r32) * D + ((e) >> 1) * 16 + hi * 8 + ((e) & 1) * 4)
    if constexpr (F32) { SLOAD_F((const float*)nxt.K, kbn); SBAR();
#pragma unroll
        for (int e = 0; e < 8; ++e) S.tq[e] = *(const f32x4*)QROW(e); }
    else { SLOAD_H(nxt.K, nxt.V, kbn); SBAR();
#pragma unroll
        for (int d0 = 0; d0 < 8; ++d0) S.qr[d0] = load8<TIn>(nxt.Q + (size_t)(wid * QBLK + r32) * D + d0 * 16 + hi * 8); }
    SBAR();
    finishSM(pA0, pA1, alA, l_reg, pa0, pa1, pa2, pa3); SBAR();
    if constexpr (F32) {
#pragma unroll
        for (int e = 8; e < 16; ++e) S.tq[e] = *(const f32x4*)QROW(e); SBAR(); }
#undef QROW
    pv_tile<0, SK>(o, vb0, pa0, pa1, pa2, pa3, ACT(even ? NT - 2 : NT - 1));
    if (even) { MASKT(pB0, pB1, NT - 1); partialSM(pB0, pB1, m_reg, mnB, alB); __syncthreads(); RESC(alB);
        finishSM(pB0, pB1, alB, l_reg, pa0, pa1, pa2, pa3); SBAR(); pv_tile<1, SK>(o, vb0, pa0, pa1, pa2, pa3, ACT(NT - 1)); }
    SBAR(); SEAM_K0();
    if (hi == 0) li_l[r32] = l_reg; asm volatile("s_waitcnt lgkmcnt(0)" ::: "memory");
    float rli[16];
#pragma unroll
    for (int r = 0; r < 16; ++r) rli[r] = __builtin_amdgcn_rcpf(li_l[crow(r, hi)]);
    TOut* Ow = cur.O + (size_t)(wid * QBLK) * LDO;
#pragma unroll
    for (int r = 0; r < 16; ++r) { const int orow = crow(r, hi);
#pragma unroll
        for (int d0 = 0; d0 < 4; ++d0) { const float v = o[d0][r] * rli[r];
            if constexpr (same_t<TOut, float>::v) { Ow[(size_t)orow * LDO + d0 * 32 + r32] = v; }
            else { const float vn = __shfl_xor(v, 1);
                   if ((r32 & 1) == 0) *(unsigned*)(Ow + (size_t)orow * LDO + d0 * 32 + r32) = cvtpk(v, vn); } } }
    if constexpr (F32) {
#pragma unroll
        for (int d0 = 0; d0 < 8; ++d0) S.qr[d0] = pack8(S.tq[2 * d0], S.tq[2 * d0 + 1]); }
    __syncthreads();
#undef RESC
#undef KBASE
#undef ACT
#undef MASKT
#undef SEAM_K0
#undef HALF_STEP
}
#undef ROW
#undef VMW
#undef VMWN
#undef SLOAD_H
#undef SWRITE_HK
#undef SWRITE_HV
#undef SWRITE_H
#undef SLOAD_F
#undef SWRITE_KF
#undef SWRITE_VF


}
#define GAS __attribute__((address_space(1)))
#define LAS __attribute__((address_space(3)))
typedef unsigned short bf16;
typedef unsigned v4u __attribute__((ext_vector_type(4)));
typedef float f32x4 __attribute__((ext_vector_type(4)));
typedef short bf16x8 __attribute__((ext_vector_type(8)));
typedef GAS unsigned gu32;
typedef GAS unsigned long long gu64;
#define RLX_AGENT __ATOMIC_RELAXED, __HIP_MEMORY_SCOPE_AGENT
#define LDS_WAIT() asm volatile("s_waitcnt lgkmcnt(0)" ::: "memory")
#define VM_WAIT() asm volatile("s_waitcnt vmcnt(0)" ::: "memory")
__device__ __forceinline__ unsigned long long rt() { return __builtin_amdgcn_s_memrealtime(); }
__device__ __forceinline__ unsigned f2bf(float f) { unsigned u = __builtin_bit_cast(unsigned, f); return (u + 0x7fffu + ((u >> 16) & 1u)) >> 16; }
__device__ __forceinline__ unsigned pk2(float lo, float hi) { return f2bf(lo) | (f2bf(hi) << 16); }

#define XB_TMO      128
#define XB_XCNT(j)  (256  + 64 * (j))
#define XB_XSUB(j)  (1280 + 64 * (j))
#define XB_XGEN(j)  (2304 + 64 * (j))
#define XB_TOP      3328
#define XB_TOPGEN   3392
#define XCD_BAR_WORDS 3456
#define XB_SPIN_CAP (1u << 18)

__device__ __forceinline__ unsigned xb_ld(unsigned* p)              { return __hip_atomic_load(p, __ATOMIC_RELAXED, __HIP_MEMORY_SCOPE_AGENT); }
__device__ __forceinline__ unsigned xb_add(unsigned* p, unsigned v) { return __hip_atomic_fetch_add(p, v, __ATOMIC_RELAXED, __HIP_MEMORY_SCOPE_AGENT); }
__device__ __forceinline__ unsigned xb_xcc_id() { return (unsigned)__builtin_amdgcn_s_getreg((3 << 11) | 20) & 0xFu; }
#define XB_SPIN(cond, bar) do { unsigned _sp = 0; while (cond) { __builtin_amdgcn_s_sleep(1); \
    if ((++_sp & 255u) == 0u) { if (xb_ld(&(bar)[XB_TMO])) break; if (_sp > XB_SPIN_CAP) { atomicAdd(&(bar)[XB_TMO], 1u); break; } } } } while (0)

struct XcdBarrier {
    unsigned* bar; unsigned x;
    volatile LAS unsigned* st;
};

__device__ __forceinline__ XcdBarrier xcd_barrier_post(unsigned* bar, volatile LAS unsigned* st) {
    XcdBarrier b; b.bar = bar; b.x = xb_xcc_id(); b.st = st;
    if (threadIdx.x == 0) (void)xb_add(&bar[XB_XCNT(b.x)], 1u);
    return b;
}
__device__ __forceinline__ void xcd_barrier_complete(unsigned* bar, unsigned x, unsigned& nloc, unsigned& nx) {
    const unsigned G = gridDim.x * gridDim.y * gridDim.z;
    unsigned sum, cnt, mine, sp = 0u;
    for (;;) {
        sum = 0u; cnt = 0u; mine = 0u;
#pragma unroll
        for (unsigned j = 0; j < 16; ++j) { const unsigned c = xb_ld(&bar[XB_XCNT(j)]); sum += c; cnt += (c > 0u) ? 1u : 0u; mine = (j == x) ? c : mine; }
        if (sum == G) break;
        __builtin_amdgcn_s_sleep(1);
        if ((++sp & 255u) == 0u) { if (xb_ld(&bar[XB_TMO])) break; if (sp > XB_SPIN_CAP) { atomicAdd(&bar[XB_TMO], 1u); break; } }
    }
    nloc = mine > 0u ? mine : 1u; nx = cnt > 0u ? cnt : 1u;
}

__device__ __forceinline__ void xcd_barrier(const XcdBarrier& b, const int tid) {
    asm volatile("s_waitcnt vmcnt(0)" ::: "memory");
    __syncthreads();
    if (tid == 0) {
        unsigned* bar = b.bar;
        __builtin_amdgcn_s_waitcnt(0);
        unsigned nloc = b.st[0], nx = b.st[1];
        if (nloc == 0u) { xcd_barrier_complete(bar, b.x, nloc, nx); b.st[0] = nloc; b.st[1] = nx; }
        const unsigned old = xb_add(&bar[XB_XSUB(b.x)], 1u);
        const unsigned gen = old / nloc;
        if (old + 1u == (gen + 1u) * nloc) {
            __builtin_amdgcn_fence(__ATOMIC_RELEASE, "agent");
            asm volatile("s_waitcnt vmcnt(0)" ::: "memory");
            const unsigned og = xb_add(&bar[XB_TOP], 1u);
            const unsigned tg = og / nx;
            if (og + 1u == (tg + 1u) * nx) xb_add(&bar[XB_TOPGEN], 1u);
            else XB_SPIN(xb_ld(&bar[XB_TOPGEN]) == tg, bar);
            __builtin_amdgcn_fence(__ATOMIC_ACQUIRE, "agent");
            xb_add(&bar[XB_XGEN(b.x)], 1u);
            asm volatile("s_waitcnt vmcnt(0)" ::: "memory");
        } else {
            XB_SPIN(xb_ld(&bar[XB_XGEN(b.x)]) == gen, bar);
            __builtin_amdgcn_fence(__ATOMIC_ACQUIRE, "agent");
            asm volatile("s_waitcnt vmcnt(0)" ::: "memory");
        }
    }
    __syncthreads();
}

constexpr int NWAVES = 8;
#ifndef MK_ONE_LAUNCH
#define MK_ONE_LAUNCH 0
#endif
constexpr int NPHASE = 13;
constexpr int T = 8192, DM = 2048, NE = 32;
constexpr float EPS = 1e-5f;
constexpr size_t MiB = 1u << 20;
constexpr size_t WS_CTL = 0, CTL_ZERO_BYTES = 1 * MiB;
constexpr size_t WS_MODP = 1 * MiB;
constexpr size_t WS_MOD = 2 * MiB;
constexpr size_t WS_ROPE = 3 * MiB;
constexpr size_t WS_WRT = 4 * MiB;
constexpr size_t WS_TOPI = 5 * MiB;
constexpr size_t WS_TOPW = 5 * MiB + 256 * 1024;
constexpr size_t WS_LRANK = 5 * MiB + 512 * 1024;
constexpr size_t WS_TSLOT = 5 * MiB + 768 * 1024;
constexpr size_t WS_CNT = 6 * MiB;
constexpr size_t WS_WIN = 8 * MiB;
constexpr size_t WS_WAO = 72 * MiB, WS_WCO = 80 * MiB, WS_WO = 88 * MiB;
constexpr size_t WS_WUP = 96 * MiB;
constexpr size_t WS_WDN = 608 * MiB;
constexpr size_t WS_H = 864 * MiB;
constexpr size_t WS_Q = 896 * MiB, WS_K = 928 * MiB, WS_V = 960 * MiB;
constexpr size_t WS_R = 992 * MiB;
constexpr size_t WS_OA = 1152 * MiB;
constexpr size_t WS_ON = 1216 * MiB;
constexpr size_t WS_CV = 1248 * MiB;
constexpr size_t WS_TMP = 1280 * MiB;
constexpr size_t WS_MG = 1344 * MiB;
constexpr size_t WS_X1 = 1376 * MiB;
constexpr size_t WS_XS = 1440 * MiB;
constexpr size_t WS_ACT = 1600 * MiB;
constexpr size_t WS_YS = 1760 * MiB;
constexpr size_t WS_END = 1920 * MiB;
constexpr int CW_BAR = 4096;
constexpr int RING_OFF = 0, RING_BYTES = 131072;
constexpr int LDSCTL_OFF = RING_BYTES, MISC_OFF = LDSCTL_OFF + 320, TILE_OFF = LDSCTL_OFF + 1024;
constexpr int LDS_BYTES = 147456;

typedef unsigned u32x2 __attribute__((ext_vector_type(2)));
typedef int i32x4 __attribute__((ext_vector_type(4)));
__device__ __forceinline__ int fresh_lane() { int l; asm volatile("v_mbcnt_lo_u32_b32 %0, -1, 0\n\tv_mbcnt_hi_u32_b32 %0, -1, %0" : "=v"(l)); return l; }
__device__ __forceinline__ float wave_sum(float v) {
#pragma unroll
    for (int o = 1; o < 64; o <<= 1) v += __shfl_xor(v, o);
    return v;
}
__device__ __forceinline__ float dot4(f32x4 a, f32x4 b) { return (a.x * b.x + a.y * b.y) + (a.z * b.z + a.w * b.w); }
__device__ __forceinline__ float bflo(unsigned w) { return __uint_as_float(w << 16); }
__device__ __forceinline__ float bfhi(unsigned w) { return __uint_as_float(w & 0xffff0000u); }
__device__ __forceinline__ u32x2 pack4(f32x4 v) { u32x2 w; w.x = pk2(v.x, v.y); w.y = pk2(v.z, v.w); return w; }
__device__ __forceinline__ f32x4 unpack4(u32x2 w) { return (f32x4){bflo(w.x), bfhi(w.x), bflo(w.y), bfhi(w.y)}; }
__device__ __forceinline__ float inv_freq(int i) {
    float r = 1.000000000e+00f;
    r = i == 1 ? 4.403665960e-01f : r; r = i == 2 ? 1.939227432e-01f : r; r = i == 3 ? 8.539710194e-02f : r; r = i == 4 ? 3.760603070e-02f : r;
    r = i == 5 ? 1.656043902e-02f : r; r = i == 6 ? 7.292664610e-03f : r; r = i == 7 ? 3.211445874e-03f : r; r = i == 8 ? 1.414213562e-03f : r;
    r = i == 9 ? 6.227723788e-04f : r; r = i == 10 ? 2.742481884e-04f : r; r = i == 11 ? 1.207697351e-04f : r; r = i == 12 ? 5.318296098e-05f : r;
    r = i == 13 ? 2.341999971e-05f : r; r = i == 14 ? 1.031338616e-05f : r; r = i == 15 ? 4.541670478e-06f : r;
    return r;
}

struct Args { const void* in[24]; float* out; unsigned char* ws; int ph_lo, ph_hi, li, pad; };
typedef const __attribute__((address_space(4))) unsigned long long* KP;
__device__ __forceinline__ KP kargs() { KP kp = (KP)__builtin_amdgcn_kernarg_segment_ptr(); asm volatile("" : "+s"(kp)); return kp; }
#define KIN(i) ((const void*)(const GAS char*)kp[(i)])
#define KWS() ((unsigned char*)(GAS unsigned char*)kp[25])
#define KOUT() ((float*)(GAS float*)kp[24])

__device__ __forceinline__ void convT_item(const float* W, int K, int N, bf16* WT, LAS unsigned* P, int item, int lane) {
    const int nblk = N >> 6, kb = item / nblk, nb = item - kb * nblk, k0 = kb * 64, n0 = nb * 64;
    const int n4 = (lane & 15) * 4, kq = lane >> 4;
    f32x4 ra[8], rb[8];
#pragma unroll
    for (int i = 0; i < 8; ++i) { const int kp = 4 * i + kq; const float* p = W + (size_t)(k0 + 2 * kp) * N + n0 + n4; ra[i] = *(const GAS f32x4*)p; rb[i] = *(const GAS f32x4*)(p + N); }
#pragma unroll
    for (int i = 0; i < 8; ++i) { const int kp = 4 * i + kq; LAS unsigned* d = P + kp * 65 + n4;
        d[0] = pk2(ra[i].x, rb[i].x); d[1] = pk2(ra[i].y, rb[i].y); d[2] = pk2(ra[i].z, rb[i].z); d[3] = pk2(ra[i].w, rb[i].w); }
    LDS_WAIT(); asm volatile("" ::: "memory");
    const int c = lane & 7;
#pragma unroll
    for (int jj = 0; jj < 8; ++jj) { const int n = (lane >> 3) + 8 * jj; const LAS unsigned* s = P + (4 * c) * 65 + n;
        v4u o; o.x = s[0]; o.y = s[65]; o.z = s[130]; o.w = s[195];
        *(GAS v4u*)(WT + (size_t)(n0 + n) * K + k0 + 8 * c) = o; }
    LDS_WAIT(); asm volatile("" ::: "memory");
}

__device__ __forceinline__ void phase0(KP kp, LAS unsigned char* lds, int wave, int bid, int G) {
    const int lane = fresh_lane(), tid = wave * 64 + lane;
    unsigned char* ws = KWS();
    { const int* pos = (const int*)KIN(2); float* rope = (float*)(ws + WS_ROPE);
      for (int i = bid * 512 + tid; i < T * 16; i += G * 512) { const int t = i >> 4, f = i & 15;
          const float ang = (float)pos[t] * inv_freq(f); double rev = (double)ang * 0.15915494309189535; rev -= __builtin_rint(rev);
          const float fr = (float)rev; rope[t * 32 + f] = __builtin_amdgcn_cosf(fr); rope[t * 32 + 16 + f] = __builtin_amdgcn_sinf(fr); } }
    { const float* wr = (const float*)KIN(17); float* wrt = (float*)(ws + WS_WRT);
      for (int i = bid * 512 + tid; i < NE * DM; i += G * 512) { const int e = i >> 11, c = i & 2047; wrt[i] = wr[c * NE + e]; } }
    for (int u = bid; u < 256; u += G) {
        const int nc = u & 15, kr = u >> 4, n0 = 768 * nc, k0 = 128 * kr;
        const float* cvec = (const float*)KIN(1); const float* wada = (const float*)KIN(3);
        f32x4 acc[3] = {(f32x4){0.f, 0.f, 0.f, 0.f}, (f32x4){0.f, 0.f, 0.f, 0.f}, (f32x4){0.f, 0.f, 0.f, 0.f}};
#pragma unroll 4
        for (int i = 0; i < 16; ++i) { const int k = k0 + wave + 8 * i; const float cv = cvec[k]; const float s = cv / (1.0f + __expf(-cv));
            const float* p = wada + (size_t)k * 12288 + n0 + 4 * lane;
#pragma unroll
            for (int q = 0; q < 3; ++q) acc[q] += s * *(const GAS f32x4*)(p + 256 * q); }
        LAS float* red = (LAS float*)lds;
#pragma unroll
        for (int q = 0; q < 3; ++q) *(LAS f32x4*)(red + wave * 768 + 256 * q + 4 * lane) = acc[q];
        __syncthreads();
        if (tid < 192) { f32x4 s = *(LAS f32x4*)(red + 4 * tid);
#pragma unroll
            for (int w = 1; w < 8; ++w) s += *(LAS f32x4*)(red + w * 768 + 4 * tid);
            *(GAS f32x4*)((float*)(ws + WS_MODP) + (size_t)kr * 12288 + n0 + 4 * tid) = s; }
        __syncthreads();
    }
    {
        LAS unsigned* P = (LAS unsigned*)(lds + wave * 8448);
        const int gw = bid * NWAVES + wave, NGW = G * NWAVES;
        constexpr int I_IN = 32 * 256, I_SQ = 32 * 32, I_UP = 32 * 64, I_DN = 32 * 32;
        constexpr int NITEMS = I_IN + 3 * I_SQ + NE * I_UP + NE * I_DN;
        for (int it = gw; it < NITEMS; it += NGW) {
            int r = it;
            if (r < I_IN) { convT_item((const float*)KIN(6), 2048, 16384, (bf16*)(ws + WS_WIN), P, r, lane); continue; } r -= I_IN;
            if (r < I_SQ) { convT_item((const float*)KIN(13), 2048, 2048, (bf16*)(ws + WS_WAO), P, r, lane); continue; } r -= I_SQ;
            if (r < I_SQ) { convT_item((const float*)KIN(14), 2048, 2048, (bf16*)(ws + WS_WCO), P, r, lane); continue; } r -= I_SQ;
            if (r < I_SQ) { convT_item((const float*)KIN(15), 2048, 2048, (bf16*)(ws + WS_WO), P, r, lane); continue; } r -= I_SQ;
            if (r < NE * I_UP) { const int e = r / I_UP; convT_item((const float*)KIN(19) + (size_t)e * 2048 * 4096, 2048, 4096, (bf16*)(ws + WS_WUP) + (size_t)e * 4096 * 2048, P, r - e * I_UP, lane); continue; } r -= NE * I_UP;
            { const int e = r / I_DN; convT_item((const float*)KIN(21) + (size_t)e * 2048 * 2048, 2048, 2048, (bf16*)(ws + WS_WDN) + (size_t)e * 2048 * 2048, P, r - e * I_DN, lane); }
        }
    }
}

__device__ __forceinline__ void phase1(KP kp, LAS unsigned char* lds, int wave, int bid, int G) {
    const int lane = fresh_lane(), tid = wave * 64 + lane;
    unsigned char* ws = KWS();
    LAS float* A1 = (LAS float*)lds; LAS float* B1 = A1 + 2048;
    const float* modp = (const float*)(ws + WS_MODP); const float* b_ada = (const float*)KIN(4); const float* n1g = (const float*)KIN(5);
    for (int c = tid; c < 2048; c += 512) { float sh = b_ada[c], sc = b_ada[2048 + c];
        for (int r = 0; r < 16; ++r) { sh += modp[r * 12288 + c]; sc += modp[r * 12288 + 2048 + c]; }
        A1[c] = n1g[c] * (1.0f + sc); B1[c] = sh; }
    { float* mod = (float*)(ws + WS_MOD);
      for (int n = bid * 512 + tid; n < 12288; n += G * 512) { float s = b_ada[n]; for (int r = 0; r < 16; ++r) s += modp[r * 12288 + n]; mod[n] = s; } }
    __syncthreads();
    const float* x = (const float*)KIN(0); bf16* H = (bf16*)(ws + WS_H);
    for (int m = bid * NWAVES + wave; m < T; m += G * NWAVES) {
        const GAS f32x4* xr = (const GAS f32x4*)(x + (size_t)m * DM) + lane;
        f32x4 v[8]; float s = 0.f;
#pragma unroll
        for (int j = 0; j < 8; ++j) { v[j] = xr[64 * j]; s += dot4(v[j], v[j]); }
        const float rstd = 1.0f / sqrtf(wave_sum(s) * (1.0f / DM) + EPS);
        GAS u32x2* o8 = (GAS u32x2*)(H + (size_t)m * DM) + lane;
#pragma unroll
        for (int j = 0; j < 8; ++j) { const f32x4 av = *(const LAS f32x4*)(A1 + 256 * j + 4 * lane), bv = *(const LAS f32x4*)(B1 + 256 * j + 4 * lane);
            o8[64 * j] = pack4(v[j] * rstd * av + bv); }
    }
}

__device__ __forceinline__ void phase4(KP kp, int wave, int bid, int G) {
    const int lane = fresh_lane();
    unsigned char* ws = KWS();
    const int gw = bid * NWAVES + wave, NGW = G * NWAVES;
    float lam;
    { const float* q1 = (const float*)KIN(8); const float* k1 = (const float*)KIN(9); const float* q2 = (const float*)KIN(10); const float* k2 = (const float*)KIN(11);
      const float s1 = wave_sum(q1[lane] * k1[lane] + q1[lane + 64] * k1[lane + 64]), s2 = wave_sum(q2[lane] * k2[lane] + q2[lane + 64] * k2[lane + 64]);
      lam = expf(s1) - expf(s2) + 0.2f; }
    const bf16* OA = (const bf16*)(ws + WS_OA); bf16* ON = (bf16*)(ws + WS_ON);
    const f32x4 sg = *(const GAS f32x4*)((const float*)KIN(12) + 4 * lane) * 0.8f;
    for (int it = gw; it < T * 8; it += NGW) { const int t = it >> 3, hd = it & 7;
        const bf16* o0 = OA + (size_t)t * 4096 + hd * 512 + 4 * lane;
        const f32x4 d = unpack4(*(const GAS u32x2*)o0) - lam * unpack4(*(const GAS u32x2*)(o0 + 256));
        const float rstd = 1.0f / sqrtf(wave_sum(dot4(d, d)) * (1.0f / 256.0f) + EPS);
        *(GAS u32x2*)(ON + (size_t)t * DM + hd * 256 + 4 * lane) = pack4(d * rstd * sg); }
    const bf16* R = (const bf16*)(ws + WS_R); bf16* CV = (bf16*)(ws + WS_CV); const float* cw = (const float*)KIN(7);
    for (int it = gw; it < 2048; it += NGW) { const int tb = it >> 2, ch = (it & 3) * 512 + 8 * lane, t0 = tb * 16;
        f32x4 w0a = *(const GAS f32x4*)(cw + ch), w0b = *(const GAS f32x4*)(cw + ch + 4), w1a = *(const GAS f32x4*)(cw + 2048 + ch), w1b = *(const GAS f32x4*)(cw + 2048 + ch + 4),
              w2a = *(const GAS f32x4*)(cw + 4096 + ch), w2b = *(const GAS f32x4*)(cw + 4096 + ch + 4);
        f32x4 u1a = (f32x4){0.f, 0.f, 0.f, 0.f}, u1b = u1a, u2a = u1a, u2b = u1a;
        if (t0 > 0) {
            { const bf16* r = R + (size_t)(t0 - 1) * 10240 + ch; const v4u c = *(const GAS v4u*)(r + 2048), h = *(const GAS v4u*)(r + 4096);
              u1a = unpack4((u32x2){c.x, c.y}) * unpack4((u32x2){h.x, h.y}); u1b = unpack4((u32x2){c.z, c.w}) * unpack4((u32x2){h.z, h.w}); }
            { const bf16* r = R + (size_t)(t0 - 2) * 10240 + ch; const v4u c = *(const GAS v4u*)(r + 2048), h = *(const GAS v4u*)(r + 4096);
              u2a = unpack4((u32x2){c.x, c.y}) * unpack4((u32x2){h.x, h.y}); u2b = unpack4((u32x2){c.z, c.w}) * unpack4((u32x2){h.z, h.w}); }
        }
#pragma unroll 4
        for (int i = 0; i < 16; ++i) { const int t = t0 + i; const bf16* r = R + (size_t)t * 10240 + ch;
            const v4u b = *(const GAS v4u*)r, c = *(const GAS v4u*)(r + 2048), h = *(const GAS v4u*)(r + 4096);
            const f32x4 ua = unpack4((u32x2){c.x, c.y}) * unpack4((u32x2){h.x, h.y}), ub = unpack4((u32x2){c.z, c.w}) * unpack4((u32x2){h.z, h.w});
            const f32x4 ya = unpack4((u32x2){b.x, b.y}) * (w0a * u2a + w1a * u1a + w2a * ua), yb = unpack4((u32x2){b.z, b.w}) * (w0b * u2b + w1b * u1b + w2b * ub);
            const u32x2 pa = pack4(ya), pb = pack4(yb);
            *(GAS v4u*)(CV + (size_t)t * DM + ch) = (v4u){pa.x, pa.y, pb.x, pb.y};
            u2a = u1a; u2b = u1b; u1a = ua; u1b = ub; }
    }
}

__device__ __forceinline__ void phase8(KP kp, LAS unsigned char* lds, int wave, int bid) {
    const int lane = fresh_lane(), tid = wave * 64 + lane;
    unsigned char* ws = KWS();
    LAS float* A2 = (LAS float*)lds; LAS float* B2 = A2 + 2048; LAS int* eidx = (LAS int*)(lds + 16384); LAS float* lgs = (LAS float*)(lds + 17408) + wave * 64;
    const float* mod = (const float*)(ws + WS_MOD); const float* n2g = (const float*)KIN(16);
    for (int c = tid; c < 2048; c += 512) { A2[c] = n2g[c] * (1.0f + mod[4 * 2048 + c]); B2[c] = mod[3 * 2048 + c]; }
    __syncthreads();
    const float* X1 = (const float*)(ws + WS_X1); bf16* H = (bf16*)(ws + WS_H); const float* wrt = (const float*)(ws + WS_WRT); const float* br = (const float*)KIN(18);
    int* TOPI = (int*)(ws + WS_TOPI); float* TOPW = (float*)(ws + WS_TOPW);
    for (int p = 0; p < 2; ++p) {
        const int lt = 4 * wave + 2 * p, t0 = 32 * bid + lt;
        f32x4 h0[8], h1[8]; float s0 = 0.f, s1 = 0.f;
        { const GAS f32x4* xr = (const GAS f32x4*)(X1 + (size_t)t0 * DM) + lane;
#pragma unroll
          for (int j = 0; j < 8; ++j) { h0[j] = xr[64 * j]; h1[j] = xr[512 + 64 * j]; s0 += dot4(h0[j], h0[j]); s1 += dot4(h1[j], h1[j]); } }
        const float r0 = 1.0f / sqrtf(wave_sum(s0) * (1.0f / DM) + EPS), r1 = 1.0f / sqrtf(wave_sum(s1) * (1.0f / DM) + EPS);
        { GAS u32x2* o8 = (GAS u32x2*)(H + (size_t)t0 * DM) + lane;
#pragma unroll
          for (int j = 0; j < 8; ++j) { const f32x4 av = *(const LAS f32x4*)(A2 + 256 * j + 4 * lane), bv = *(const LAS f32x4*)(B2 + 256 * j + 4 * lane);
              h0[j] = h0[j] * r0 * av + bv; h1[j] = h1[j] * r1 * av + bv; o8[64 * j] = pack4(h0[j]); o8[512 + 64 * j] = pack4(h1[j]); } }
        for (int e = 0; e < NE; ++e) { float a0 = 0.f, a1 = 0.f; const GAS f32x4* wp = (const GAS f32x4*)(wrt + (size_t)e * DM) + lane;
#pragma unroll
            for (int j = 0; j < 8; ++j) { const f32x4 w = wp[64 * j]; a0 += dot4(h0[j], w); a1 += dot4(h1[j], w); }
            a0 = wave_sum(a0); a1 = wave_sum(a1);
            if (lane == 0) { const float b = br[e]; lgs[e] = a0 + b; lgs[32 + e] = a1 + b; } }
        LDS_WAIT(); asm volatile("" ::: "memory");
#pragma unroll
        for (int q = 0; q < 2; ++q) {
            unsigned sel = 0u; float tv[4]; int ti[4];
#pragma unroll
            for (int k = 0; k < 4; ++k) { float bv = -3.0e38f; int bi = 0;
                for (int e = 0; e < NE; ++e) { const float v = lgs[32 * q + e]; const bool ok = (((sel >> e) & 1u) == 0u) && (v > bv); bv = ok ? v : bv; bi = ok ? e : bi; }
                sel |= 1u << bi; tv[k] = bv; ti[k] = bi; }
            const float p1 = __expf(tv[1] - tv[0]), p2 = __expf(tv[2] - tv[0]), p3 = __expf(tv[3] - tv[0]); const float inv = 1.0f / (1.0f + p1 + p2 + p3);
            if (lane == 0) { const int t = t0 + q;
                *(GAS i32x4*)(TOPI + t * 4) = (i32x4){ti[0], ti[1], ti[2], ti[3]}; *(GAS f32x4*)(TOPW + t * 4) = (f32x4){inv, p1 * inv, p2 * inv, p3 * inv};
                eidx[(lt + q) * 4 + 0] = ti[0]; eidx[(lt + q) * 4 + 1] = ti[1]; eidx[(lt + q) * 4 + 2] = ti[2]; eidx[(lt + q) * 4 + 3] = ti[3]; }
        }
        LDS_WAIT(); asm volatile("" ::: "memory");
    }
    __syncthreads();
    if (tid < 128) { const int e = eidx[tid]; int rank = 0; for (int q = 0; q < tid; ++q) rank += (eidx[q] == e) ? 1 : 0; ((int*)(ws + WS_LRANK))[32 * bid * 4 + tid] = rank; }
    if (tid < 32) { int cnt = 0; for (int q = 0; q < 128; ++q) cnt += (eidx[q] == tid) ? 1 : 0; ((int*)(ws + WS_CNT))[bid * 32 + tid] = cnt; }
}

__device__ __forceinline__ void moe_tables(const int* CNT, LAS unsigned char* lds, int tid, int bid) {
    LAS int* totp = (LAS int*)lds; LAS int* befp = totp + 512;
    LAS int* tile_e = (LAS int*)(lds + TILE_OFF); LAS int* ntl = tile_e + 160; LAS int* pstart = (LAS int*)(lds + TILE_OFF + 1024); LAS int* before = pstart + 32;
    { const int e = tid & 31, part = tid >> 5; int s = 0, sb = 0;
      for (int i = 0; i < 16; ++i) { const int bb = part * 16 + i; const int c = CNT[bb * 32 + e]; s += c; sb += (bb < bid) ? c : 0; }
      totp[part * 32 + e] = s; befp[part * 32 + e] = sb; }
    __syncthreads();
    int tot = 0, bef = 0;
    if (tid < 32) { for (int p = 0; p < 16; ++p) { tot += totp[p * 32 + tid]; bef += befp[p * 32 + tid]; } }
    __syncthreads();
    if (tid < 32) { totp[tid] = tot; before[tid] = bef; }
    __syncthreads();
    if (tid == 0) { int ps = 0, nt = 0;
        for (int e = 0; e < NE; ++e) { const int c = totp[e]; const int npad = (c + 255) >> 8; pstart[e] = ps; for (int k = 0; k < npad; ++k) { if (nt < 160) tile_e[nt] = e; ++nt; } ps += npad * 256; }
        *ntl = nt < 160 ? nt : 160; }
    __syncthreads();
}

__device__ __forceinline__ void phase9(KP kp, LAS unsigned char* lds, int wave, int bid) {
    const int lane = fresh_lane(), tid = wave * 64 + lane;
    unsigned char* ws = KWS();
    moe_tables((const int*)(ws + WS_CNT), lds, tid, bid);
    const LAS int* pstart = (const LAS int*)(lds + TILE_OFF + 1024); const LAS int* before = pstart + 32;
    const int* TOPI = (const int*)(ws + WS_TOPI); const int* LRANK = (const int*)(ws + WS_LRANK); int* TSLOT = (int*)(ws + WS_TSLOT);
    const bf16* H = (const bf16*)(ws + WS_H); bf16* XS = (bf16*)(ws + WS_XS);
    for (int i = 0; i < 16; ++i) { const int aidx = wave * 16 + i; const int gi = 32 * bid * 4 + aidx; const int t = gi >> 2;
        const int e = TOPI[gi]; const int slot = pstart[e] + before[e] + LRANK[gi];
        if (lane == 0) TSLOT[gi] = slot;
        const GAS v4u* src = (const GAS v4u*)(H + (size_t)t * DM) + lane; GAS v4u* dst = (GAS v4u*)(XS + (size_t)slot * DM) + lane;
#pragma unroll
        for (int q = 0; q < 4; ++q) dst[64 * q] = src[64 * q]; }
}

__device__ __forceinline__ void phase12(KP kp, int wave, int bid, int G) {
    const int lane = fresh_lane();
    unsigned char* ws = KWS();
    const float* X1 = (const float*)(ws + WS_X1); const bf16* YS = (const bf16*)(ws + WS_YS); const float* mod = (const float*)(ws + WS_MOD); const float* fg = (const float*)KIN(23);
    const int* TSLOT = (const int*)(ws + WS_TSLOT); const float* TOPW = (const float*)(ws + WS_TOPW);
    for (int m = bid * NWAVES + wave; m < T; m += G * NWAVES) {
        const GAS f32x4* xr = (const GAS f32x4*)(X1 + (size_t)m * DM) + lane;
        const i32x4 sl = *(const GAS i32x4*)(TSLOT + m * 4); const f32x4 tw = *(const GAS f32x4*)(TOPW + m * 4);
        const GAS u32x2* y0 = (const GAS u32x2*)(YS + (size_t)sl.x * DM) + lane; const GAS u32x2* y1 = (const GAS u32x2*)(YS + (size_t)sl.y * DM) + lane;
        const GAS u32x2* y2 = (const GAS u32x2*)(YS + (size_t)sl.z * DM) + lane; const GAS u32x2* y3 = (const GAS u32x2*)(YS + (size_t)sl.w * DM) + lane;
        f32x4 v[8]; float s = 0.f;
#pragma unroll
        for (int j = 0; j < 8; ++j) {
            const f32x4 mo = tw.x * unpack4(y0[64 * j]) + tw.y * unpack4(y1[64 * j]) + tw.z * unpack4(y2[64 * j]) + tw.w * unpack4(y3[64 * j]);
            const f32x4 g2 = *(const GAS f32x4*)(mod + 5 * 2048 + 256 * j + 4 * lane);
            v[j] = xr[64 * j] + g2 * mo; s += dot4(v[j], v[j]); }
        const float rstd = 1.0f / sqrtf(wave_sum(s) * (1.0f / DM) + EPS);
        GAS f32x4* o = (GAS f32x4*)(KOUT() + (size_t)m * DM) + lane;
#pragma unroll
        for (int j = 0; j < 8; ++j) o[64 * j] = v[j] * rstd * *(const GAS f32x4*)(fg + 256 * j + 4 * lane);
    }
}

__device__ __forceinline__ attn::BlockRef<attn::bf16, attn::bf16> attn_ref(int L, int pass, const attn::bf16* Qb, const attn::bf16* Kb, const attn::bf16* Vb, attn::bf16* OAp) {
    const int x = L & 7, s = (L >> 3) & 31, e = L >> 8, j = 2 * x + (s >> 4), y = s & 15, qb = pass ? 31 - y : y;
    attn::BlockRef<attn::bf16, attn::bf16> r;
    r.Q = Qb + ((size_t)j * T + (size_t)qb * 256) * 128; r.K = Kb + (size_t)j * T * 128; r.V = Vb + (size_t)((j >> 1) * 2 + e) * T * 128;
    r.O = OAp + (size_t)(qb * 256) * 4096 + j * 256 + e * 128; r.P0 = qb * 256;
    return r;
}
__device__ __forceinline__ void phase3(KP kp, char* lds, int wave, int bid, int G) {
    const int tid = wave * 64 + fresh_lane();
    typedef attn::bf16 abf; typedef attn::BlockRef<attn::bf16, attn::bf16> BR;
    unsigned char* ws = KWS();
    const abf* Qb = (const abf*)(ws + WS_Q); const abf* Kb = (const abf*)(ws + WS_K); const abf* Vb = (const abf*)(ws + WS_V); abf* OAp = (abf*)(ws + WS_OA);
    constexpr int total = 512;
    int L = bid; if (L >= total) return;
    int pass = 0;
    BR cur = attn_ref(L, 0, Qb, Kb, Vb, OAp);
    attn::Seam<abf> S;
    attn::causal_swa_prime<abf, abf>(cur, T, lds, S, tid);
    for (;;) {
        const bool more_pass = pass == 0, more_item = L + G < total, last = !more_pass && !more_item;
        int passn = pass + 1, Ln = L;
        if (!more_pass) { passn = 0; Ln = more_item ? L + G : L; }
        const BR nxt = last ? cur : attn_ref(Ln, passn, Qb, Kb, Vb, OAp);
        attn::causal_swa_block<abf, abf>(cur, nxt, T, T, lds, S, tid);
        if (last) break;
        cur = nxt; pass = passn; L = Ln;
    }
}

__global__ void __launch_bounds__(NWAVES * 64, 2) mk_fwd(Args args) {
    extern __shared__ __attribute__((aligned(16))) unsigned char lds_raw[];
    LAS unsigned char* lds = (LAS unsigned char*)lds_raw;
    volatile LAS unsigned* MISC = (volatile LAS unsigned*)(lds + MISC_OFF);
    const int wave = __builtin_amdgcn_readfirstlane(threadIdx.x >> 6);
    const int G = gridDim.x, bid = blockIdx.x;
    const int lo = ((const __attribute__((address_space(4))) int*)__builtin_amdgcn_kernarg_segment_ptr())[52], hi = ((const __attribute__((address_space(4))) int*)__builtin_amdgcn_kernarg_segment_ptr())[53];
    XcdBarrier bar;
    { KP kp = kargs(); gu32* ctl = (gu32*)(KWS() + WS_CTL);
      const int tid = wave * 64 + fresh_lane();
      for (int u = tid; u < (LDS_BYTES - LDSCTL_OFF) / 4; u += NWAVES * 64) ((LAS unsigned*)(lds + LDSCTL_OFF))[u] = 0u;
      __syncthreads();
      bar.bar = (unsigned*)(ctl + CW_BAR); bar.x = 0; bar.st = nullptr;
      if (hi - lo > 1) bar = xcd_barrier_post((unsigned*)(ctl + CW_BAR), MISC + 8); }
#ifndef PH_MASK
#define PH_MASK 0x1FFF
#endif
#define IN(k) (((PH_MASK >> (k)) & 1) && lo <= (k) && (k) < hi)
#define SEAM(k) do { if (IN(k) && IN((k) + 1)) xcd_barrier(bar, wave * 64 + fresh_lane()); } while (0)

    if (IN(0)) { phase0(kargs(), lds, wave, bid, G); SEAM(0); }
    if (IN(1)) { phase1(kargs(), lds, wave, bid, G); SEAM(1); }
    if (IN(2)) {
        KP kp = kargs(); unsigned char* ws = KWS();
        pg8::Gemm g{(const pg8::bf16_t*)(ws + WS_H), (const pg8::bf16_t*)(ws + WS_WIN), T, 16384, 2048, 0};
        pg8::StaticOrder S; S.init(T, 16384, G, bid);
        pg8::EpiInProj E{(pg8::bf16_t*)(ws + WS_Q), (pg8::bf16_t*)(ws + WS_K), (pg8::bf16_t*)(ws + WS_V), (pg8::bf16_t*)(ws + WS_R), (const float*)(ws + WS_ROPE)};
        pg8::gemm_phase<pg8::EpiInProj, pg8::StaticOrder, true, true>(lds + RING_OFF, g, S, E, wave * 64 + fresh_lane());
        SEAM(2);
    }
    if (IN(3)) { phase3(kargs(), (char*)lds_raw + RING_OFF, wave, bid, G); SEAM(3); }
    if (IN(4)) { phase4(kargs(), wave, bid, G); SEAM(4); }
    if (IN(5)) {
        KP kp = kargs(); unsigned char* ws = KWS();
        pg8::Gemm g{(const pg8::bf16_t*)(ws + WS_ON), (const pg8::bf16_t*)(ws + WS_WAO), T, 2048, 2048, 0};
        pg8::StaticOrder S; S.init(T, 2048, G, bid);
        pg8::EpiGate E{(float*)(ws + WS_TMP), (const pg8::bf16_t*)(ws + WS_R) + 6144};
        pg8::gemm_phase<pg8::EpiGate, pg8::StaticOrder, true, true>(lds + RING_OFF, g, S, E, wave * 64 + fresh_lane());
        SEAM(5);
    }
    if (IN(6)) {
        KP kp = kargs(); unsigned char* ws = KWS();
        pg8::Gemm g{(const pg8::bf16_t*)(ws + WS_CV), (const pg8::bf16_t*)(ws + WS_WCO), T, 2048, 2048, 0};
        pg8::StaticOrder S; S.init(T, 2048, G, bid);
        pg8::EpiMerge E{(const float*)(ws + WS_TMP), (pg8::bf16_t*)(ws + WS_MG), (const pg8::bf16_t*)(ws + WS_R) + 8192};
        pg8::gemm_phase<pg8::EpiMerge, pg8::StaticOrder, true, true>(lds + RING_OFF, g, S, E, wave * 64 + fresh_lane());
        SEAM(6);
    }
    if (IN(7)) {
        KP kp = kargs(); unsigned char* ws = KWS();
        pg8::Gemm g{(const pg8::bf16_t*)(ws + WS_MG), (const pg8::bf16_t*)(ws + WS_WO), T, 2048, 2048, 0};
        pg8::StaticOrder S; S.init(T, 2048, G, bid);
        pg8::EpiResid E{(const float*)KIN(0), (float*)(ws + WS_X1), (const float*)(ws + WS_MOD) + 2 * 2048};
        pg8::gemm_phase<pg8::EpiResid, pg8::StaticOrder, true, true>(lds + RING_OFF, g, S, E, wave * 64 + fresh_lane());
        SEAM(7);
    }
    if (IN(8)) { phase8(kargs(), lds, wave, bid); SEAM(8); }
    if (IN(9)) { phase9(kargs(), lds, wave, bid); SEAM(9); }
    if (IN(10)) {
        KP kp = kargs(); unsigned char* ws = KWS();
        if (!IN(9)) moe_tables((const int*)(ws + WS_CNT), lds, wave * 64 + fresh_lane(), bid);
        const LAS int* tile_e = (const LAS int*)(lds + TILE_OFF); const int nTiles = tile_e[160];
        pg8::Gemm g{(const pg8::bf16_t*)(ws + WS_XS), (const pg8::bf16_t*)(ws + WS_WUP), nTiles * 256, 4096, 2048, (size_t)4096 * 2048 * 2};
        pg8::MoeOrder S; S.init(nTiles, 4096, G, bid, tile_e);
        pg8::EpiSwiglu E{(pg8::bf16_t*)(ws + WS_ACT), (const float*)KIN(20)};
        pg8::gemm_phase<pg8::EpiSwiglu, pg8::MoeOrder, true, true>(lds + RING_OFF, g, S, E, wave * 64 + fresh_lane());
        SEAM(10);
    }
    if (IN(11)) {
        KP kp = kargs(); unsigned char* ws = KWS();
        if (!IN(10)) moe_tables((const int*)(ws + WS_CNT), lds, wave * 64 + fresh_lane(), bid);
        const LAS int* tile_e = (const LAS int*)(lds + TILE_OFF); const int nTiles = tile_e[160];
        pg8::Gemm g{(const pg8::bf16_t*)(ws + WS_ACT), (const pg8::bf16_t*)(ws + WS_WDN), nTiles * 256, 2048, 2048, (size_t)2048 * 2048 * 2};
        pg8::MoeOrder S; S.init(nTiles, 2048, G, bid, tile_e);
        pg8::EpiDown E{(pg8::bf16_t*)(ws + WS_YS), (const float*)KIN(22)};
        pg8::gemm_phase<pg8::EpiDown, pg8::MoeOrder, true, true>(lds + RING_OFF, g, S, E, wave * 64 + fresh_lane());
        SEAM(11);
    }
    if (IN(12)) { phase12(kargs(), wave, bid, G); }
#undef IN
#undef SEAM
}

extern "C" void kernel_launch(void* const* d_in, const int* in_sizes, int n_in, void* d_out, int out_size, void* d_ws, size_t ws_size, hipStream_t stream) {
    static int grid = 0;
    if (grid == 0) {
        if (n_in != 24 || out_size != T * DM || ws_size < WS_END) { fprintf(stderr, "kernel_launch: unexpected shapes (n_in %d, out %d, ws %zu)\n", n_in, out_size, ws_size); grid = -1; return; }
        if (hipFuncSetAttribute((const void*)mk_fwd, hipFuncAttributeMaxDynamicSharedMemorySize, LDS_BYTES) != hipSuccess) { fprintf(stderr, "kernel_launch: hipFuncSetAttribute failed\n"); grid = -1; return; }
        int per_cu = 0;
        if (hipOccupancyMaxActiveBlocksPerMultiprocessor(&per_cu, (const void*)mk_fwd, NWAVES * 64, LDS_BYTES) != hipSuccess || per_cu < 1) fprintf(stderr, "kernel_launch: occupancy query reports %d\n", per_cu);
        (void)hipGetLastError();
        grid = 256;
    }
    if (grid < 0) return;
    if (hipMemsetAsync((char*)d_ws + WS_CTL, 0, CTL_ZERO_BYTES, stream) != hipSuccess) { fprintf(stderr, "kernel_launch: memset failed\n"); return; }
    Args a{};
    for (int i = 0; i < 24; ++i) a.in[i] = d_in[i];
    a.out = (float*)d_out; a.ws = (unsigned char*)d_ws;
#if MK_ONE_LAUNCH
    a.ph_lo = 0; a.ph_hi = NPHASE; a.li = 0; a.pad = 0;
    hipLaunchKernelGGL(mk_fwd, dim3(grid), dim3(NWAVES * 64), LDS_BYTES, stream, a);
#else
    for (int p = 0; p < NPHASE; ++p) { a.ph_lo = p; a.ph_hi = p + 1; a.li = p; a.pad = 0;
        hipLaunchKernelGGL(mk_fwd, dim3(grid), dim3(NWAVES * 64), LDS_BYTES, stream, a); }
#endif
}
```

```cpp
#include <hip/hip_runtime.h>
#include <hip/hip_bf16.h>
#include <cstdio>
#include <cstdint>
namespace pg8 {
#define PG8_LAS __attribute__((address_space(3)))
typedef unsigned short bf16_t;
typedef short bf16x8 __attribute__((ext_vector_type(8)));
typedef float f32x4 __attribute__((ext_vector_type(4)));
typedef unsigned u32x4 __attribute__((ext_vector_type(4)));
constexpr int BM = 256, BK = 64, HALF = 128, HTB = HALF * BK * 2  , STAGE_BYTES = 8 * HTB, NXCD = 8, WGM = 8;

__host__ __device__ __forceinline__ int lds_byte(int r, int c) { const int st = (r >> 4) * 2 + (c >> 5), rr = r & 15, cc = c & 31, ob = rr * 64 + cc * 2; return st * 1024 + (ob ^ (((ob >> 9) & 1) << 5)); }
__host__ __device__ __forceinline__ void stage_rc(int b, int& R, int& C) { const int st = b / 1024, sb = b % 1024, swz = sb ^ (((sb >> 9) & 1) << 5); R = (st >> 1) * 16 + swz / 64; C = (st & 1) * 32 + (swz % 64) / 2; }
__host__ __device__ __forceinline__ int perm32(int rho) { const int n = rho >> 4, i = rho & 15; return 8 * (i >> 2) + 4 * n + (i & 3); }

struct Unit { int pm, pn, e; };
struct Gemm { const bf16_t* A; const bf16_t* Bt; int M, N, K; size_t estride; int btiled; };

struct StaticOrder {
    int nM, nN, nwg, G, c, i0 = 0, imax = 1 << 30;
    __host__ __device__ void init(int M, int N, int G_, int c_) { nM = M / BM; nN = N / BM; nwg = nM * nN; G = G_; c = c_; }
    __host__ __device__ bool next(int i, Unit& u) const {
        if (i + i0 >= imax) return false; const long L = (long)(i + i0) * G + c; if (L >= nwg) return false;
        int wgid = (int)L; { const int q = nwg / NXCD, r = nwg % NXCD, xcd = wgid % NXCD, off = wgid / NXCD; wgid = (xcd < r ? xcd * (q + 1) : r * (q + 1) + (xcd - r) * q) + off; }
        const int nig = WGM * nN, gid = wgid / nig, fm = gid * WGM, gsz = (nM - fm) < WGM ? (nM - fm) : WGM;
        u.pm = fm + ((wgid % nig) % gsz); u.pn = (wgid % nig) / gsz; u.e = 0; return true;
    }
    static constexpr bool GATHER = false;
    __device__ __forceinline__ int row_tok(int, int) const { return 0; }
    __device__ __forceinline__ void a_ready(const Unit&) const {}
    __device__ __forceinline__ void done(const Unit&) const {}
};


typedef unsigned u32x2 __attribute__((ext_vector_type(2)));
constexpr int T_ROWS = 8192, R_LD = 10240;
__device__ __forceinline__ unsigned cvt_pk_bf16(float lo, float hi) { unsigned r; asm volatile("v_cvt_pk_bf16_f32 %0, %1, %2" : "=v"(r) : "v"(lo), "v"(hi)); return r; }
__device__ __forceinline__ u32x2 pk4(f32x4 v) { u32x2 w; w.x = cvt_pk_bf16(v[0], v[1]); w.y = cvt_pk_bf16(v[2], v[3]); return w; }
__device__ __forceinline__ float bf_lo(unsigned w) { return __uint_as_float(w << 16); }
__device__ __forceinline__ float bf_hi(unsigned w) { return __uint_as_float(w & 0xffff0000u); }
__device__ __forceinline__ float sigm(float x) { return __builtin_amdgcn_rcpf(1.0f + __expf(-x)); }
__device__ __forceinline__ f32x4 sig4(u32x2 g) { return (f32x4){sigm(bf_lo(g.x)), sigm(bf_hi(g.x)), sigm(bf_lo(g.y)), sigm(bf_hi(g.y))}; }

struct EpiInProj {
    static constexpr bool PERM = true, AFTER_DRAIN = false, HAS_MID = false;
    bf16_t* Q; bf16_t* K; bf16_t* V; bf16_t* R; const float* rope;
    __device__ __forceinline__ void operator()(const f32x4 (&acc)[2][2][4][2], const Unit& u, int wr, int wc, int fr, int fq) const {
        const int row0 = u.pm * BM + wr * 64 + fr; const int pn = u.pn;
        if (pn < 16) {
            bf16_t* base = (pn < 8) ? Q : K; const int hp = (pn & 7) * 2; const float sgn = (fq >= 2) ? 1.0f : -1.0f;
#pragma unroll
            for (int ai = 0; ai < 2; ++ai)
#pragma unroll
                for (int m = 0; m < 4; ++m) { const int row = row0 + ai * HALF + m * 16;
                    f32x4 cs0 = (f32x4){1.f, 1.f, 1.f, 1.f}, cs1 = cs0, sn0 = (f32x4){0.f, 0.f, 0.f, 0.f}, sn1 = sn0;
                    if (wc == 0) { const float* rp = rope + (size_t)row * 32 + 8 * (fq & 1); cs0 = *(const f32x4*)rp; cs1 = *(const f32x4*)(rp + 4); sn0 = *(const f32x4*)(rp + 16) * sgn; sn1 = *(const f32x4*)(rp + 20) * sgn; }
#pragma unroll
                    for (int bj = 0; bj < 2; ++bj) { f32x4 v0 = acc[ai][bj][m][0], v1 = acc[ai][bj][m][1];
                        if (wc == 0) { f32x4 p0, p1;
#pragma unroll
                            for (int i = 0; i < 4; ++i) { p0[i] = __shfl_xor(v0[i], 32); p1[i] = __shfl_xor(v1[i], 32); }
                            v0 = v0 * cs0 + p0 * sn0; v1 = v1 * cs1 + p1 * sn1; }
                        u32x4 w; w.x = cvt_pk_bf16(v0[0], v0[1]); w.y = cvt_pk_bf16(v0[2], v0[3]); w.z = cvt_pk_bf16(v1[0], v1[1]); w.w = cvt_pk_bf16(v1[2], v1[3]);
                        *(u32x4*)(base + ((size_t)(hp + bj) * T_ROWS + row) * 128 + wc * 32 + 8 * fq) = w; } }
        } else if (pn < 24) {
            const int hv = (pn - 16) * 2;
#pragma unroll
            for (int ai = 0; ai < 2; ++ai)
#pragma unroll
                for (int m = 0; m < 4; ++m) { const int row = row0 + ai * HALF + m * 16;
#pragma unroll
                    for (int bj = 0; bj < 2; ++bj) { const f32x4 v0 = acc[ai][bj][m][0], v1 = acc[ai][bj][m][1];
                        u32x4 w; w.x = cvt_pk_bf16(v0[0], v0[1]); w.y = cvt_pk_bf16(v0[2], v0[3]); w.z = cvt_pk_bf16(v1[0], v1[1]); w.w = cvt_pk_bf16(v1[2], v1[3]);
                        *(u32x4*)(V + ((size_t)(hv + bj) * T_ROWS + row) * 128 + wc * 32 + 8 * fq) = w; } }
        } else {
            const int col0 = (pn - 24) * BM + wc * 32 + 8 * fq;
#pragma unroll
            for (int ai = 0; ai < 2; ++ai)
#pragma unroll
                for (int m = 0; m < 4; ++m) { const int row = row0 + ai * HALF + m * 16;
#pragma unroll
                    for (int bj = 0; bj < 2; ++bj) { const f32x4 v0 = acc[ai][bj][m][0], v1 = acc[ai][bj][m][1];
                        u32x4 w; w.x = cvt_pk_bf16(v0[0], v0[1]); w.y = cvt_pk_bf16(v0[2], v0[3]); w.z = cvt_pk_bf16(v1[0], v1[1]); w.w = cvt_pk_bf16(v1[2], v1[3]);
                        *(u32x4*)(R + (size_t)row * R_LD + col0 + bj * HALF) = w; } }
        }
    }
};
struct EpiGate {
    static constexpr bool PERM = false, AFTER_DRAIN = false, HAS_MID = false;
    float* C; const bf16_t* G;
    __device__ __forceinline__ void operator()(const f32x4 (&acc)[2][2][4][2], const Unit& u, int wr, int wc, int fr, int fq) const {
        const int row0 = u.pm * BM + wr * 64 + fr, col0 = u.pn * BM + wc * 32 + 4 * fq;
#pragma unroll
        for (int ai = 0; ai < 2; ++ai)
#pragma unroll
            for (int m = 0; m < 4; ++m) { const int row = row0 + ai * HALF + m * 16;
#pragma unroll
                for (int bj = 0; bj < 2; ++bj)
#pragma unroll
                    for (int n = 0; n < 2; ++n) { const int col = col0 + bj * HALF + n * 16;
                        const u32x2 g = *(const u32x2*)(G + (size_t)row * R_LD + col);
                        *(f32x4*)(C + (size_t)row * 2048 + col) = acc[ai][bj][m][n] * sig4(g); } }
    }
};
struct EpiMerge {
    static constexpr bool PERM = false, AFTER_DRAIN = false, HAS_MID = false;
    const float* Tm; bf16_t* O; const bf16_t* G;
    __device__ __forceinline__ void operator()(const f32x4 (&acc)[2][2][4][2], const Unit& u, int wr, int wc, int fr, int fq) const {
        const int row0 = u.pm * BM + wr * 64 + fr, col0 = u.pn * BM + wc * 32 + 4 * fq;
#pragma unroll
        for (int ai = 0; ai < 2; ++ai)
#pragma unroll
            for (int m = 0; m < 4; ++m) { const int row = row0 + ai * HALF + m * 16;
#pragma unroll
                for (int bj = 0; bj < 2; ++bj)
#pragma unroll
                    for (int n = 0; n < 2; ++n) { const int col = col0 + bj * HALF + n * 16;
                        const u32x2 g = *(const u32x2*)(G + (size_t)row * R_LD + col);
                        const f32x4 tv = *(const f32x4*)(Tm + (size_t)row * 2048 + col);
                        *(u32x2*)(O + (size_t)row * 2048 + col) = pk4(tv + acc[ai][bj][m][n] * sig4(g)); } }
    }
};
struct EpiMerge2 {
    static constexpr bool PERM = true, AFTER_DRAIN = false, HAS_MID = true;
    bf16_t* O; const bf16_t* R;
    static __device__ __forceinline__ float ex(float x) { return __expf(fminf(-x, 60.f)); }
    __device__ __forceinline__ void mid(f32x4 (&acc)[2][2][4][2], const Unit& u, int wr, int wc, int fr, int fq) const {
        const int row0 = u.pm * BM + wr * 64 + fr, col0 = u.pn * BM + wc * 32 + 8 * fq;
        const bf16_t* rp0 = R + (size_t)row0 * R_LD + col0;
#pragma unroll
        for (int ai = 0; ai < 2; ++ai)
#pragma unroll
            for (int m = 0; m < 4; ++m) {
                int off = (ai * HALF + m * 16) * R_LD; asm volatile("" : "+s"(off) :: "memory");
                const bf16_t* rp = rp0 + off;
#pragma unroll
                for (int bj = 0; bj < 2; ++bj) {
                    const u32x4 ga = *(const u32x4*)(rp + 6144 + bj * HALF), gc = *(const u32x4*)(rp + 8192 + bj * HALF);
                    f32x4 r0, r1;
                    r0[0] = (1.0f + ex(bf_lo(gc.x))) * __builtin_amdgcn_rcpf(1.0f + ex(bf_lo(ga.x))); r0[1] = (1.0f + ex(bf_hi(gc.x))) * __builtin_amdgcn_rcpf(1.0f + ex(bf_hi(ga.x)));
                    r0[2] = (1.0f + ex(bf_lo(gc.y))) * __builtin_amdgcn_rcpf(1.0f + ex(bf_lo(ga.y))); r0[3] = (1.0f + ex(bf_hi(gc.y))) * __builtin_amdgcn_rcpf(1.0f + ex(bf_hi(ga.y)));
                    r1[0] = (1.0f + ex(bf_lo(gc.z))) * __builtin_amdgcn_rcpf(1.0f + ex(bf_lo(ga.z))); r1[1] = (1.0f + ex(bf_hi(gc.z))) * __builtin_amdgcn_rcpf(1.0f + ex(bf_hi(ga.z)));
                    r1[2] = (1.0f + ex(bf_lo(gc.w))) * __builtin_amdgcn_rcpf(1.0f + ex(bf_lo(ga.w))); r1[3] = (1.0f + ex(bf_hi(gc.w))) * __builtin_amdgcn_rcpf(1.0f + ex(bf_hi(ga.w)));
                    acc[ai][bj][m][0] *= r0; acc[ai][bj][m][1] *= r1; }
                asm volatile("" : "+v"(acc[ai][0][m][0]), "+v"(acc[ai][0][m][1]), "+v"(acc[ai][1][m][0]), "+v"(acc[ai][1][m][1]) :: "memory"); }
    }
    __device__ __forceinline__ void operator()(const f32x4 (&acc)[2][2][4][2], const Unit& u, int wr, int wc, int fr, int fq) const {
        const int row0 = u.pm * BM + wr * 64 + fr, col0 = u.pn * BM + wc * 32 + 8 * fq;
#pragma unroll
        for (int ai = 0; ai < 2; ++ai)
#pragma unroll
            for (int m = 0; m < 4; ++m) { const int row = row0 + ai * HALF + m * 16;
#pragma unroll
                for (int bj = 0; bj < 2; ++bj) { const int col = col0 + bj * HALF;
                    const u32x4 gc = *(const u32x4*)(R + (size_t)row * R_LD + 8192 + col);
                    f32x4 s0, s1;
                    s0[0] = __builtin_amdgcn_rcpf(1.0f + ex(bf_lo(gc.x))); s0[1] = __builtin_amdgcn_rcpf(1.0f + ex(bf_hi(gc.x))); s0[2] = __builtin_amdgcn_rcpf(1.0f + ex(bf_lo(gc.y))); s0[3] = __builtin_amdgcn_rcpf(1.0f + ex(bf_hi(gc.y)));
                    s1[0] = __builtin_amdgcn_rcpf(1.0f + ex(bf_lo(gc.z))); s1[1] = __builtin_amdgcn_rcpf(1.0f + ex(bf_hi(gc.z))); s1[2] = __builtin_amdgcn_rcpf(1.0f + ex(bf_lo(gc.w))); s1[3] = __builtin_amdgcn_rcpf(1.0f + ex(bf_hi(gc.w)));
                    const f32x4 v0 = acc[ai][bj][m][0] * s0, v1 = acc[ai][bj][m][1] * s1;
                    u32x4 w; w.x = cvt_pk_bf16(v0[0], v0[1]); w.y = cvt_pk_bf16(v0[2], v0[3]); w.z = cvt_pk_bf16(v1[0], v1[1]); w.w = cvt_pk_bf16(v1[2], v1[3]);
                    *(u32x4*)(O + (size_t)row * 2048 + col) = w; } }
    }
};
struct EpiResid {
    static constexpr bool PERM = false, AFTER_DRAIN = false, HAS_MID = false;
    const float* X; float* O; const float* gate;
    __device__ __forceinline__ void operator()(const f32x4 (&acc)[2][2][4][2], const Unit& u, int wr, int wc, int fr, int fq) const {
        const int row0 = u.pm * BM + wr * 64 + fr, col0 = u.pn * BM + wc * 32 + 4 * fq;
        f32x4 gv[2][2];
#pragma unroll
        for (int bj = 0; bj < 2; ++bj)
#pragma unroll
            for (int n = 0; n < 2; ++n) gv[bj][n] = *(const f32x4*)(gate + col0 + bj * HALF + n * 16);
#pragma unroll
        for (int ai = 0; ai < 2; ++ai)
#pragma unroll
            for (int m = 0; m < 4; ++m) { const int row = row0 + ai * HALF + m * 16;
#pragma unroll
                for (int bj = 0; bj < 2; ++bj)
#pragma unroll
                    for (int n = 0; n < 2; ++n) { const size_t off = (size_t)row * 2048 + col0 + bj * HALF + n * 16;
                        *(f32x4*)(O + off) = *(const f32x4*)(X + off) + gv[bj][n] * acc[ai][bj][m][n]; } }
    }
};
__device__ __forceinline__ float swiglu1(float g, float l) { g = fminf(g, 7.0f); l = fminf(fmaxf(l, -7.0f), 7.0f); return g * sigm(1.702f * g) * (l + 1.0f); }
struct EpiSwiglu {
    static constexpr bool PERM = true, AFTER_DRAIN = false, HAS_MID = false;
    bf16_t* O; const float* bias;
    __device__ __forceinline__ void operator()(const f32x4 (&acc)[2][2][4][2], const Unit& u, int wr, int wc, int fr, int fq) const {
        const int row0 = u.pm * BM + wr * 64 + fr, col0 = u.pn * BM + wc * 32 + 8 * fq; const float* bb = bias + (size_t)u.e * 4096;
        f32x4 bv[2][2];
#pragma unroll
        for (int bj = 0; bj < 2; ++bj)
#pragma unroll
            for (int n = 0; n < 2; ++n) bv[bj][n] = *(const f32x4*)(bb + col0 + bj * HALF + 4 * n);
#pragma unroll
        for (int ai = 0; ai < 2; ++ai)
#pragma unroll
            for (int m = 0; m < 4; ++m) { const int row = row0 + ai * HALF + m * 16;
#pragma unroll
                for (int bj = 0; bj < 2; ++bj) { const f32x4 v0 = acc[ai][bj][m][0] + bv[bj][0], v1 = acc[ai][bj][m][1] + bv[bj][1];
                    u32x2 w; w.x = cvt_pk_bf16(swiglu1(v0[0], v0[1]), swiglu1(v0[2], v0[3])); w.y = cvt_pk_bf16(swiglu1(v1[0], v1[1]), swiglu1(v1[2], v1[3]));
                    *(u32x2*)(O + (size_t)row * 2048 + ((col0 + bj * HALF) >> 1)) = w; } }
    }
};
struct EpiDown {
    static constexpr bool PERM = true, AFTER_DRAIN = false, HAS_MID = false;
    bf16_t* O; const float* bias;
    __device__ __forceinline__ void operator()(const f32x4 (&acc)[2][2][4][2], const Unit& u, int wr, int wc, int fr, int fq) const {
        const int row0 = u.pm * BM + wr * 64 + fr, col0 = u.pn * BM + wc * 32 + 8 * fq; const float* bb = bias + (size_t)u.e * 2048;
        f32x4 bv[2][2];
#pragma unroll
        for (int bj = 0; bj < 2; ++bj)
#pragma unroll
            for (int n = 0; n < 2; ++n) bv[bj][n] = *(const f32x4*)(bb + col0 + bj * HALF + 4 * n);
#pragma unroll
        for (int ai = 0; ai < 2; ++ai)
#pragma unroll
            for (int m = 0; m < 4; ++m) { const int row = row0 + ai * HALF + m * 16;
#pragma unroll
                for (int bj = 0; bj < 2; ++bj) { const f32x4 v0 = acc[ai][bj][m][0] + bv[bj][0], v1 = acc[ai][bj][m][1] + bv[bj][1];
                    u32x4 w; w.x = cvt_pk_bf16(v0[0], v0[1]); w.y = cvt_pk_bf16(v0[2], v0[3]); w.z = cvt_pk_bf16(v1[0], v1[1]); w.w = cvt_pk_bf16(v1[2], v1[3]);
                    *(u32x4*)(O + (size_t)row * 2048 + col0 + bj * HALF) = w; } }
    }
};
template <bool GATHER_> struct MoeOrder {
    static constexpr bool GATHER = GATHER_;
    int nM, nN, nwg, G, c, i0 = 0, imax = 1 << 30; const PG8_LAS int* tile_e; const PG8_LAS int* tab = nullptr;
    __device__ __forceinline__ int row_tok(int ui, int r) const { return tab[(ui + i0) * 256 + r]; }
    __device__ __forceinline__ void init(int nTiles, int N, int G_, int c_, const PG8_LAS int* te) { nM = nTiles; nN = N / BM; nwg = nM * nN; G = G_; c = c_; tile_e = te; }
    __device__ __forceinline__ bool next(int i, Unit& u) const {
        if (i + i0 >= imax) return false; const long L = (long)(i + i0) * G + c; if (L >= nwg) return false;
        int wgid = (int)L; { const int q = nwg / NXCD, r = nwg % NXCD, xcd = wgid % NXCD, off = wgid / NXCD; wgid = (xcd < r ? xcd * (q + 1) : r * (q + 1) + (xcd - r) * q) + off; }
        const int tq = wgid / nN, e = tile_e[tq], ft = tile_e[256 + e] >> 8, gsz = (tile_e[320 + e] + 255) >> 8, idx = wgid - ft * nN;
        u.pm = ft + idx % gsz; u.pn = idx / gsz; u.e = e; return true;
    }
    __device__ __forceinline__ void a_ready(const Unit&) const {}
    __device__ __forceinline__ void done(const Unit&) const {}
};
template <class Epi, class Sched, bool ALIGN_EPI = false, bool SP2 = false>
__device__ __forceinline__ void gemm_phase(PG8_LAS unsigned char* lds, const Gemm g, const Sched& S, const Epi& E, const int tid_in) {
    const int tid = tid_in, wid = __builtin_amdgcn_readfirstlane(tid >> 6), lane = tid & 63, wr = wid >> 2, wc = wid & 3, fr = lane & 15, fq = lane >> 4;
    const int K = g.K, nt = K / BK, LDB = g.btiled ? 64 : K;
    unsigned voffA[2], voffB[2]; unsigned vc[2][2] = {{0u, 0u}, {0u, 0u}}, vn[2][2] = {{0u, 0u}, {0u, 0u}}; int gR[2], gC[2];
#pragma unroll
    for (int i = 0; i < 2; ++i) { int R, C; stage_rc(tid * 16 + i * 8192, R, C); const int Rb = Epi::PERM ? ((R & ~31) + perm32(R & 31)) : R;
        voffA[i] = (unsigned)(R * K + C) * 2u; voffB[i] = (unsigned)(Rb * LDB + C) * 2u; gR[i] = R; gC[i] = C * 2; }
    const size_t kstep = (size_t)(BK * 2);
    const size_t hstep = (size_t)HALF * K * 2;
    const size_t tstep = 2 * hstep; const size_t kstepB = g.btiled ? (size_t)32768 : kstep, hstepB = g.btiled ? (size_t)16384 : hstep;
    const unsigned ldsw = (unsigned)wid * 1024u;
    const int aoff = lds_byte(wr * 64 + fr, fq * 8), boff = lds_byte(wc * 32 + fr, fq * 8);
#define PG8_SA(b, h) (((b) * 2 + (h)) * HTB)
#define PG8_SB(b, h) ((4 + (b) * 2 + (h)) * HTB)
#define PG8_STAGE(bufoff, gbase, voff) do { _Pragma("unroll") for (int _i = 0; _i < 2; ++_i) \
        __builtin_amdgcn_global_load_lds((const unsigned*)((const char*)(gbase) + (voff)[_i]), (PG8_LAS unsigned*)(lds + (bufoff) + ldsw + _i * 8192), 16, 0, 0); } while (0)
#define PG8_STAGE_A(bufoff, base, h, isnext) do { if constexpr (Sched::GATHER) { unsigned vv_[2] = {(isnext) ? vn[h][0] : vc[h][0], (isnext) ? vn[h][1] : vc[h][1]}; PG8_STAGE(bufoff, base, vv_); } else { PG8_STAGE(bufoff, (base) + (h) * hstep, voffA); } } while (0)
#define PG8_GFILL(dst, uidx) do { _Pragma("unroll") for (int h_ = 0; h_ < 2; ++h_) _Pragma("unroll") for (int i_ = 0; i_ < 2; ++i_) dst[h_][i_] = (unsigned)S.row_tok((uidx), h_ * HALF + gR[i_]) * (unsigned)(K * 2) + (unsigned)gC[i_]; } while (0)
#define PG8_LDA(dst, b, h) do { _Pragma("unroll") for (int m = 0; m < 4; ++m) _Pragma("unroll") for (int k = 0; k < 2; ++k) dst[m][k] = *(const PG8_LAS bf16x8*)(lds + PG8_SA(b, h) + aoff + m * 2048 + k * 1024); } while (0)
#define PG8_LDB(dst, b, h) do { _Pragma("unroll") for (int n = 0; n < 2; ++n) _Pragma("unroll") for (int k = 0; k < 2; ++k) dst[n][k] = *(const PG8_LAS bf16x8*)(lds + PG8_SB(b, h) + boff + n * 2048 + k * 1024); } while (0)
#define PG8_MMA(ai, bj, At, Bt) do { __builtin_amdgcn_s_setprio(1); _Pragma("unroll") for (int m = 0; m < 4; ++m) _Pragma("unroll") for (int n = 0; n < 2; ++n) _Pragma("unroll") for (int k = 0; k < 2; ++k) \
        acc[ai][bj][m][n] = __builtin_amdgcn_mfma_f32_16x16x32_bf16(Bt[n][k], At[m][k], acc[ai][bj][m][n], 0, 0, 0); __builtin_amdgcn_s_setprio(0); } while (0)
#define PG8_WAIT_V(n) asm volatile("s_waitcnt vmcnt(" #n ")" ::: "memory")
#define PG8_WAIT_L(n) asm volatile("s_waitcnt lgkmcnt(" #n ")" ::: "memory")
#define PG8_BAR __builtin_amdgcn_s_barrier()
#define PG8_SCHED __builtin_amdgcn_sched_barrier(0)
    Unit cur, nxt; int ui = 0;
    if (!S.next(0, cur)) return;
    f32x4 acc[2][2][4][2];
#pragma unroll
    for (int a = 0; a < 2; ++a)
#pragma unroll
        for (int b = 0; b < 2; ++b)
#pragma unroll
            for (int m = 0; m < 4; ++m)
#pragma unroll
                for (int n = 0; n < 2; ++n) acc[a][b][m][n] = (f32x4){0.f, 0.f, 0.f, 0.f};
    bf16x8 At[4][2], B0[2][2], B1[2][2];
    const char* cA = (const char*)g.A + (Sched::GATHER ? (size_t)0 : (size_t)cur.pm * tstep); if constexpr (Sched::GATHER) PG8_GFILL(vc, 0); const char* cB = (const char*)g.Bt + (size_t)cur.pn * tstep + (size_t)cur.e * g.estride;
    S.a_ready(cur);
    if constexpr (SP2) {
        PG8_STAGE(PG8_SB(0, 0), cB, voffB); PG8_STAGE(PG8_SB(0, 1), cB + hstepB, voffB); PG8_STAGE_A(PG8_SA(0, 0), cA, 0, false); PG8_STAGE_A(PG8_SA(0, 1), cA, 1, false);
        if (wr == 1) PG8_BAR;
        PG8_WAIT_V(2); PG8_BAR;
        PG8_STAGE(PG8_SB(1, 0), cB + kstepB, voffB); PG8_STAGE_A(PG8_SA(1, 0), cA + kstep, 0, false); PG8_STAGE(PG8_SB(1, 1), cB + hstepB + kstepB, voffB);
        PG8_WAIT_V(6); PG8_BAR;
    } else {
        PG8_STAGE(PG8_SB(0, 0), cB, voffB); PG8_STAGE_A(PG8_SA(0, 0), cA, 0, false); PG8_STAGE(PG8_SB(0, 1), cB + hstepB, voffB); PG8_STAGE_A(PG8_SA(0, 1), cA, 1, false);
        if (wr == 1) PG8_BAR;
        PG8_WAIT_V(4); PG8_BAR;
        PG8_STAGE(PG8_SB(1, 0), cB + kstepB, voffB); PG8_STAGE_A(PG8_SA(1, 0), cA + kstep, 0, false); PG8_STAGE(PG8_SB(1, 1), cB + hstepB + kstepB, voffB);
        PG8_WAIT_V(6); PG8_BAR;
    }
    for (;;) {
        const bool has_next = S.next(ui + 1, nxt);
        const char* nA = (has_next && !Sched::GATHER) ? (const char*)g.A + (size_t)nxt.pm * tstep : cA; if constexpr (Sched::GATHER) { if (has_next) PG8_GFILL(vn, ui + 1); else { vn[0][0] = vc[0][0]; vn[0][1] = vc[0][1]; vn[1][0] = vc[1][0]; vn[1][1] = vc[1][1]; } } const char* nB = has_next ? (const char*)g.Bt + (size_t)nxt.pn * tstep + (size_t)nxt.e * g.estride : cB;
        for (int seg = 0; seg < (Epi::HAS_MID ? 2 : 1); ++seg) {
        if constexpr (Epi::HAS_MID) { if (seg == 1) E.mid(acc, cur, wr, wc, fr, fq); }
        for (int t = (Epi::HAS_MID && seg == 1) ? nt / 2 : 0; t < ((Epi::HAS_MID && seg == 0) ? nt / 2 : nt); t += 2) {
            const bool last = (t == nt - 2);
            const char* a1 = cA + (size_t)(t + 1) * kstep;
            const char* a2 = last ? nA : cA + (size_t)(t + 2) * kstep; const char* b2 = last ? nB : cB + (size_t)(t + 2) * kstepB;
            const char* a3 = a2 + kstep; const char* b3 = b2 + kstepB;
            if (last && has_next) S.a_ready(nxt);
            if constexpr (SP2) {
            PG8_LDB(B0, 0, 0); PG8_LDB(B1, 0, 1); PG8_SCHED; PG8_LDA(At, 0, 0); PG8_STAGE_A(PG8_SA(1, 1), a1, 1, false);
            PG8_WAIT_V(8); PG8_WAIT_L(0); PG8_BAR; PG8_MMA(0, 0, At, B0); PG8_MMA(0, 1, At, B1); PG8_BAR; PG8_SCHED;
            PG8_LDA(At, 0, 1); PG8_STAGE(PG8_SB(0, 0), b2, voffB); PG8_STAGE(PG8_SB(0, 1), b2 + hstepB, voffB); PG8_STAGE_A(PG8_SA(0, 0), a2, 0, last);
            PG8_WAIT_V(8); PG8_WAIT_L(0); PG8_BAR; PG8_MMA(1, 0, At, B0); PG8_MMA(1, 1, At, B1); PG8_BAR; PG8_SCHED;
            PG8_LDB(B0, 1, 0); PG8_LDB(B1, 1, 1); PG8_SCHED; PG8_LDA(At, 1, 0); PG8_STAGE_A(PG8_SA(0, 1), a2, 1, last);
            PG8_WAIT_V(8); PG8_WAIT_L(0); PG8_BAR; PG8_MMA(0, 0, At, B0); PG8_MMA(0, 1, At, B1); PG8_BAR; PG8_SCHED;
            PG8_LDA(At, 1, 1); PG8_STAGE(PG8_SB(1, 0), b3, voffB); PG8_STAGE(PG8_SB(1, 1), b3 + hstepB, voffB); PG8_STAGE_A(PG8_SA(1, 0), a3, 0, last);
            PG8_WAIT_V(8); PG8_WAIT_L(0); PG8_BAR; PG8_MMA(1, 0, At, B0); PG8_MMA(1, 1, At, B1); PG8_BAR; PG8_SCHED;
            } else {
            PG8_LDB(B0, 0, 0); PG8_SCHED; PG8_LDA(At, 0, 0); PG8_STAGE_A(PG8_SA(1, 1), a1, 1, false);
            PG8_WAIT_L(8); PG8_BAR; PG8_WAIT_L(0); PG8_MMA(0, 0, At, B0); PG8_BAR; PG8_SCHED;
            PG8_LDB(B1, 0, 1); PG8_STAGE(PG8_SB(0, 0), b2, voffB);
            PG8_BAR; PG8_WAIT_L(0); PG8_MMA(0, 1, At, B1); PG8_BAR;
            PG8_LDA(At, 0, 1); PG8_STAGE_A(PG8_SA(0, 0), a2, 0, last);
            PG8_BAR; PG8_WAIT_L(0); PG8_MMA(1, 0, At, B0); PG8_BAR; PG8_SCHED;
            PG8_STAGE(PG8_SB(0, 1), b2 + hstepB, voffB);
            PG8_WAIT_V(6); PG8_BAR; PG8_MMA(1, 1, At, B1); PG8_BAR;
            PG8_LDB(B0, 1, 0); PG8_SCHED; PG8_LDA(At, 1, 0); PG8_STAGE_A(PG8_SA(0, 1), a2, 1, last);
            PG8_WAIT_L(8); PG8_BAR; PG8_WAIT_L(0); PG8_MMA(0, 0, At, B0); PG8_BAR; PG8_SCHED;
            PG8_LDB(B1, 1, 1); PG8_STAGE(PG8_SB(1, 0), b3, voffB);
            PG8_BAR; PG8_WAIT_L(0); PG8_MMA(0, 1, At, B1); PG8_BAR;
            PG8_LDA(At, 1, 1); PG8_STAGE_A(PG8_SA(1, 0), a3, 0, last);
            PG8_BAR; PG8_WAIT_L(0); PG8_MMA(1, 0, At, B0); PG8_BAR; PG8_SCHED;
            PG8_STAGE(PG8_SB(1, 1), b3 + hstepB, voffB);
            PG8_WAIT_V(6); PG8_BAR; PG8_MMA(1, 1, At, B1); PG8_BAR;
            }
        }
        }
        if constexpr (ALIGN_EPI) { if (wr == 0) PG8_BAR; }
        if constexpr (!Epi::AFTER_DRAIN) { E(acc, cur, wr, wc, fr, fq); S.done(cur); }
        if (!has_next) break;
#pragma unroll
        for (int a = 0; a < 2; ++a)
#pragma unroll
            for (int b = 0; b < 2; ++b)
#pragma unroll
                for (int m = 0; m < 4; ++m)
#pragma unroll
                    for (int n = 0; n < 2; ++n) acc[a][b][m][n] = (f32x4){0.f, 0.f, 0.f, 0.f};
        cur = nxt; cA = nA; cB = nB; ++ui; if constexpr (Sched::GATHER) { vc[0][0] = vn[0][0]; vc[0][1] = vn[0][1]; vc[1][0] = vn[1][0]; vc[1][1] = vn[1][1]; }
        if constexpr (ALIGN_EPI) { if (wr == 1) PG8_BAR; }
    }
    PG8_WAIT_V(0);
    if constexpr (!ALIGN_EPI) { if (wr == 0) PG8_BAR; }
    PG8_BAR;
    if constexpr (Epi::AFTER_DRAIN) { E.fused(acc, cur, wr, wc, fr, fq, lds, wid, lane); S.done(cur); }
#undef PG8_SA
#undef PG8_SB
#undef PG8_STAGE
#undef PG8_STAGE_A
#undef PG8_GFILL
#undef PG8_LDA
#undef PG8_LDB
#undef PG8_MMA
#undef PG8_WAIT_V
#undef PG8_WAIT_L
#undef PG8_BAR
#undef PG8_SCHED
}
}

namespace attn {
constexpr int D = 128; constexpr float THR = 8.f; constexpr bool WSKIP = false; constexpr int LDO = 4096;
constexpr float SCALE = 0.08838834764831845f;
constexpr int NW = 8, QBLK = 32, KVBLK = 64, QB = NW * QBLK;
constexpr int SHM_V = KVBLK * D * 2, SHM_K = KVBLK * D * 2;
constexpr int LDS_BYTES = 2 * SHM_V + 2 * SHM_K + NW * 64 * 4;
static_assert(D == 128, "geometry");

using bf16 = __hip_bfloat16;
typedef short bf16x8 __attribute__((ext_vector_type(8)));
typedef short s16x4 __attribute__((ext_vector_type(4)));
typedef float f32x16 __attribute__((ext_vector_type(16)));
typedef float f32x4 __attribute__((ext_vector_type(4)));
typedef unsigned u32x4 __attribute__((ext_vector_type(4)));
template <class A, class Bt> struct same_t { static constexpr bool v = false; };
template <class A> struct same_t<A, A> { static constexpr bool v = true; };

#define KSWZ(row, colB) ((row) * 256 + ((colB) ^ (((row) & 7) << 4)))
#define SBAR() __builtin_amdgcn_sched_barrier(0)
__device__ __forceinline__ int v_st(int k, int c) { const int kk = (k & ~0xC) | ((k & 4) << 1) | ((k & 8) >> 1); return ((kk >> 3) * 4 + (c >> 5)) * 512 + ((kk & 7) * 32 + (c & 31)) * 2; }
__device__ __forceinline__ int v_rd_base(int lane) { return ((lane & 3) << 3) | (((lane >> 2) & 3) << 6) | (((lane >> 4) & 1) << 5) | (((lane >> 5) & 1) << 8); }
constexpr int v_rd_off(int d0, int ks, int half) { return d0 * 512 + ks * 4096 + half * 2048; }
__device__ __forceinline__ int crow(int r, int hi) { return (r & 3) + 8 * (r >> 2) + 4 * hi; }
__device__ __forceinline__ unsigned cvtpk(float lo, float hi) {
    unsigned r; asm volatile("v_cvt_pk_bf16_f32 %0, %1, %2" : "=v"(r) : "v"(lo), "v"(hi)); return r;
}
__device__ __forceinline__ bf16x8 pack8(f32x4 a, f32x4 b) {
    u32x4 w = {cvtpk(a[0], a[1]), cvtpk(a[2], a[3]), cvtpk(b[0], b[1]), cvtpk(b[2], b[3])};
    return *reinterpret_cast<bf16x8*>(&w);
}
template <class T> __device__ __forceinline__ bf16x8 load8(const T* p) {
    if constexpr (same_t<T, float>::v) { return pack8(*(const f32x4*)p, *(const f32x4*)(p + 4)); }
    else { return *reinterpret_cast<const bf16x8*>(p); }
}
__device__ __forceinline__ void mask_tile(f32x16& p0, f32x16& p1, int dq, unsigned W) {
    const float NEG = -__builtin_inff();
#pragma unroll
    for (int r = 0; r < 16; ++r) {
        const int c = (r & 3) + 8 * (r >> 2);
        if ((unsigned)(dq - c) >= W) p0[r] = NEG;
        if ((unsigned)(dq - c - 32) >= W) p1[r] = NEG;
    }
}
__device__ __forceinline__ void partialSM(f32x16& p0, f32x16& p1, float& m_reg, float& mn, float& alpha) {
    float pmax = p0[0]; for (int r = 1; r < 16; ++r) pmax = fmaxf(pmax, p0[r]); for (int r = 0; r < 16; ++r) pmax = fmaxf(pmax, p1[r]);
    { auto rr = __builtin_amdgcn_permlane32_swap(__float_as_uint(pmax), __float_as_uint(pmax), false, false);
      pmax = fmaxf(__uint_as_float(rr[0]), __uint_as_float(rr[1])); }
    constexpr float C2 = 1.4426950408889634f * SCALE;
    if (__builtin_expect(__all((pmax - m_reg) * SCALE <= THR), 1)) { mn = m_reg; alpha = 1.f; }
    else { mn = fmaxf(m_reg, pmax); alpha = __builtin_amdgcn_exp2f((m_reg - mn) * C2); m_reg = mn; }
    const float mnL = -mn * C2;
    for (int r = 0; r < 16; ++r) p0[r] = fmaf(p0[r], C2, mnL); for (int r = 0; r < 16; ++r) p1[r] = fmaf(p1[r], C2, mnL);
    for (int r = 0; r < 16; ++r) p0[r] = __builtin_amdgcn_exp2f(p0[r]);
}
__device__ __forceinline__ void finishSM(f32x16& p0, f32x16& p1, float alpha, float& l_reg, bf16x8& pa0, bf16x8& pa1, bf16x8& pa2, bf16x8& pa3) {
    for (int r = 0; r < 16; ++r) p1[r] = __builtin_amdgcn_exp2f(p1[r]);
    float ps = 0; for (int r = 0; r < 16; ++r) ps += p0[r]; for (int r = 0; r < 16; ++r) ps += p1[r];
    { auto rr = __builtin_amdgcn_permlane32_swap(__float_as_uint(ps), __float_as_uint(ps), false, false);
      ps = __uint_as_float(rr[0]) + __uint_as_float(rr[1]); }
    l_reg = l_reg * alpha + ps;
#define PK4(P, B_, OUT) do { unsigned a0 = cvtpk(P[B_+0], P[B_+1]), a1 = cvtpk(P[B_+2], P[B_+3]);                          \
        unsigned b0 = cvtpk(P[B_+4], P[B_+5]), b1 = cvtpk(P[B_+6], P[B_+7]);                                             \
        auto r0 = __builtin_amdgcn_permlane32_swap(a0, b0, false, false); auto r1 = __builtin_amdgcn_permlane32_swap(a1, b1, false, false); \
        u32x4 w = {r0[0], r1[0], r0[1], r1[1]}; OUT = *reinterpret_cast<bf16x8*>(&w); } while (0)
    PK4(p0, 0, pa0); PK4(p0, 8, pa1); PK4(p1, 0, pa2); PK4(p1, 8, pa3);
#undef PK4
}
template <int KB, bool SK>
__device__ __forceinline__ void qkt(f32x16& p0, f32x16& p1, const char* K_lds, int r32, int hi, const bf16x8* qr, bool act) {
    if (SK && !act) { const float NEG = -__builtin_inff();
#pragma unroll
        for (int r = 0; r < 16; ++r) { p0[r] = NEG; p1[r] = NEG; } return; }
    p0 = f32x16{}; p1 = f32x16{};
    const char* kb[4];
#pragma unroll
    for (int dd = 0; dd < 4; ++dd) kb[dd] = K_lds + KB * SHM_K + KSWZ(r32, (dd * 16 + hi * 8) * 2);
#pragma unroll
    for (int d0 = 0; d0 < 8; ++d0) { const char* a = kb[d0 & 3] + (d0 >> 2) * 128;
        bf16x8 b0 = *reinterpret_cast<const bf16x8*>(a);
        bf16x8 b1 = *reinterpret_cast<const bf16x8*>(a + 32 * 256);
        p0 = __builtin_amdgcn_mfma_f32_32x32x16_bf16(b0, qr[d0], p0, 0, 0, 0);
        p1 = __builtin_amdgcn_mfma_f32_32x32x16_bf16(b1, qr[d0], p1, 0, 0, 0); }
}
template <int VB, bool SK>
__device__ __forceinline__ void pv_tile(f32x16* o, int vb0, bf16x8 pa0, bf16x8 pa1, bf16x8 pa2, bf16x8 pa3, bool act) {
    if (SK && !act) return;
#define TRRD(dst, off) asm volatile("ds_read_b64_tr_b16 %0, %1 offset:%2" : "=&v"(dst) : "v"(vb0), "i"(off) : "memory")
#define PV_D0(d0) do { s16x4 l0, l1, l2, l3, h0, h1, h2, h3; constexpr int b_ = VB * SHM_V + v_rd_off(d0, 0, 0);     \
        TRRD(l0, b_); TRRD(h0, b_ + 2048); TRRD(l1, b_ + 4096); TRRD(h1, b_ + 6144); TRRD(l2, b_ + 8192); TRRD(h2, b_ + 10240); TRRD(l3, b_ + 12288); TRRD(h3, b_ + 14336); \
        asm volatile("s_waitcnt lgkmcnt(0)" ::: "memory"); SBAR();                 \
        o[d0] = __builtin_amdgcn_mfma_f32_32x32x16_bf16(pa0, (bf16x8){l0[0], l0[1], l0[2], l0[3], h0[0], h0[1], h0[2], h0[3]}, o[d0], 0, 0, 0);   \
        o[d0] = __builtin_amdgcn_mfma_f32_32x32x16_bf16(pa1, (bf16x8){l1[0], l1[1], l1[2], l1[3], h1[0], h1[1], h1[2], h1[3]}, o[d0], 0, 0, 0);   \
        o[d0] = __builtin_amdgcn_mfma_f32_32x32x16_bf16(pa2, (bf16x8){l2[0], l2[1], l2[2], l2[3], h2[0], h2[1], h2[2], h2[3]}, o[d0], 0, 0, 0);   \
        o[d0] = __builtin_amdgcn_mfma_f32_32x32x16_bf16(pa3, (bf16x8){l3[0], l3[1], l3[2], l3[3], h3[0], h3[1], h3[2], h3[3]}, o[d0], 0, 0, 0); } while (0)
    PV_D0(0); PV_D0(1); PV_D0(2); PV_D0(3);
#undef PV_D0
#undef TRRD
}

template <class TIn, class TOut> struct BlockRef { const TIn* Q; const TIn* K; const TIn* V; TOut* O; int P0; };
template <class TIn> struct Seam {
    bf16x8 qr[8];
    bf16x8 st_v0, st_v1, st_k0, st_k1; f32x4 sf0, sf1, sf2, sf3;
    f32x4 tq[16];
};
__device__ __forceinline__ int swa_jlo(int P0, int W) { const int lowk = P0 - W + 1; return lowk > 0 ? lowk / KVBLK : 0; }
#define ROW(p, k0, rr) ((p) + (size_t)((k0) + (rr)) * D + sc)
#define VMW() asm volatile("s_waitcnt vmcnt(0)" ::: "memory")
#define VMWN(n) asm volatile("s_waitcnt vmcnt(%0)" :: "i"(n) : "memory")
#define SLOAD_H(Kp, Vp, k0) do { S.st_v0 = load8<TIn>(ROW(Vp, k0, sr)); S.st_v1 = load8<TIn>(ROW(Vp, k0, 32 + sr));              \
                         S.st_k0 = load8<TIn>(ROW(Kp, k0, sr)); S.st_k1 = load8<TIn>(ROW(Kp, k0, 32 + sr)); } while (0)
#define SWRITE_HK(bf) do { *(bf16x8*)(K_lds + (bf) * SHM_K + kws) = S.st_k0; *(bf16x8*)(K_lds + (bf) * SHM_K + kws + 32 * 256) = S.st_k1; } while (0)
#define SWRITE_HV(bf) do { *(bf16x8*)(V_lds + (bf) * SHM_V + vst0) = S.st_v0; *(bf16x8*)(V_lds + (bf) * SHM_V + vst1) = S.st_v1; } while (0)
#define SWRITE_H(bf) do { SWRITE_HV(bf); SWRITE_HK(bf); } while (0)
#define SLOAD_F(p, k0) do { S.sf0 = *(const f32x4*)ROW(p, k0, sr); S.sf1 = *(const f32x4*)(ROW(p, k0, sr) + 4);                \
                            S.sf2 = *(const f32x4*)ROW(p, k0, 32 + sr); S.sf3 = *(const f32x4*)(ROW(p, k0, 32 + sr) + 4); } while (0)
#define SWRITE_KF(bf) do { *(bf16x8*)(K_lds + (bf) * SHM_K + kws) = pack8(S.sf0, S.sf1); *(bf16x8*)(K_lds + (bf) * SHM_K + kws + 32 * 256) = pack8(S.sf2, S.sf3); } while (0)
#define SWRITE_VF(bf) do { *(bf16x8*)(V_lds + (bf) * SHM_V + vst0) = pack8(S.sf0, S.sf1); *(bf16x8*)(V_lds + (bf) * SHM_V + vst1) = pack8(S.sf2, S.sf3); } while (0)
template <class TIn, class TOut>
__device__ __forceinline__ void causal_swa_prime(const BlockRef<TIn, TOut>& cur, int W, char* lds, Seam<TIn>& S, const int tid_in) {
    constexpr bool F32 = same_t<TIn, float>::v;
    const int tid = tid_in, wid = __builtin_amdgcn_readfirstlane(tid >> 6), lane = tid & 63, r32 = lane & 31, hi = lane >> 5;
    const int sr = tid >> 4, sc = (tid & 15) * 8, kws = KSWZ(sr, sc * 2); char* K_lds = lds + 2 * SHM_V;
    const int kb0 = swa_jlo(cur.P0, W) * KVBLK;
    for (int d0 = 0; d0 < 8; ++d0) S.qr[d0] = load8<TIn>(cur.Q + (size_t)(wid * QBLK + r32) * D + d0 * 16 + hi * 8);
    if constexpr (F32) { SLOAD_F((const float*)cur.K, kb0); VMW(); SWRITE_KF(0); SBAR(); SLOAD_F((const float*)cur.V, kb0); }
    else { SLOAD_H(cur.K, cur.V, kb0); VMW(); SWRITE_HK(0); }
    __syncthreads();
}
template <class TIn, class TOut>
__device__ __forceinline__ void causal_swa_block(const BlockRef<TIn, TOut>& cur, const BlockRef<TIn, TOut>& nxt, int skv, int W, char* lds, Seam<TIn>& S, const int tid_in) {
    constexpr bool F32 = same_t<TIn, float>::v;
    const int tid = tid_in, wid = __builtin_amdgcn_readfirstlane(tid >> 6), lane = tid & 63, r32 = lane & 31, hi = lane >> 5;
    const int j_lo = swa_jlo(cur.P0, W);
    int j_hi = (cur.P0 + QB - 1) / KVBLK + 1; if (j_hi > skv / KVBLK) j_hi = skv / KVBLK;
    const int NT = j_hi - j_lo;
    const int kbn = swa_jlo(nxt.P0, W) * KVBLK;
    const int qlo = cur.P0 + wid * QBLK, qm = qlo + r32 - 4 * hi;
    char* V_lds = lds; char* K_lds = lds + 2 * SHM_V;
    float* ws = (float*)(lds + 2 * SHM_V + 2 * SHM_K) + wid * 64; float* li_l = ws, * al_l = ws + 32;
    float m_reg = -1e30f, l_reg = 0; f32x16 o[4] = {};
    const int sr = tid >> 4, sc = (tid & 15) * 8, vst0 = v_st(sr, sc), vst1 = v_st(32 + sr, sc), kws = KSWZ(sr, sc * 2);
    const int vb0 = (int)(uintptr_t)V_lds + v_rd_base(lane);
    const TIn* Kh = cur.K; const TIn* Vh = cur.V;
#define RESC(a) do { if (__any((a) < 1.f)) { if (hi == 0) al_l[r32] = (a); asm volatile("s_waitcnt lgkmcnt(0)" ::: "memory");              \
                     for (int d_ = 0; d_ < 4; ++d_) for (int r = 0; r < 16; ++r) o[d_][r] *= al_l[crow(r, hi)]; } } while (0)
#define KBASE(t) ((j_lo + (t)) * KVBLK)
#define ACT(t) (KBASE(t) <= qlo + QBLK - 1 && KBASE(t) + KVBLK - 1 >= qlo - W + 1)
#define MASKT(P0_, P1_, t) do { const int kb_ = KBASE(t); if ((!SK || ACT(t)) && (kb_ + KVBLK - 1 > qlo || kb_ <= qlo + QBLK - 1 - W)) mask_tile(P0_, P1_, qm - kb_, (unsigned)W); } while (0)
    constexpr int NQL = F32 ? 16 : 8;
    constexpr bool SK = WSKIP && !F32;
#define SEAM_K0() do { VMWN(NQL); if constexpr (F32) { SWRITE_KF(0); SBAR(); SLOAD_F((const float*)nxt.V, kbn); } else { SWRITE_HK(0); } SBAR(); } while (0)
    f32x16 pA0, pA1, pB0, pB1; float mnA, mnB, alA, alB; bf16x8 pa0, pa1, pa2, pa3;
    if constexpr (F32) { VMW(); SWRITE_VF(0); SBAR(); } else { SWRITE_HV(0); SBAR(); }
    if (NT > 1) { if constexpr (F32) SLOAD_F((const float*)Kh, KBASE(1)); else SLOAD_H(Kh, Vh, KBASE(1)); }
    SBAR(); qkt<0, SK>(pA0, pA1, K_lds, r32, hi, S.qr, ACT(0));
    if constexpr (F32) { if (NT > 1) { VMW(); SWRITE_KF(1); SBAR(); SLOAD_F((const float*)Vh, KBASE(1)); } }
    MASKT(pA0, pA1, 0); partialSM(pA0, pA1, m_reg, mnA, alA);
    if (NT > 1) { VMW(); if constexpr (F32) { SWRITE_VF(1); SBAR(); if (NT > 2) SLOAD_F((const float*)Kh, KBASE(2)); } else SWRITE_H(1); }
    __syncthreads();
#define HALF_STEP(PX0, PX1, mnX, alX, PY0, PY1, alY, t, KB, VB, SB) do {                                                      \
        SBAR(); qkt<KB, SK>(PX0, PX1, K_lds, r32, hi, S.qr, ACT(t));                                             \
        finishSM(PY0, PY1, alY, l_reg, pa0, pa1, pa2, pa3); SBAR();                                                           \
        if ((t) + 1 < NT) { if constexpr (F32) { VMW(); SWRITE_KF(SB); SBAR(); SLOAD_F((const float*)Vh, KBASE((t) + 1)); }  \
                            else { SLOAD_H(Kh, Vh, KBASE((t) + 1)); } SBAR(); }                                               \
        pv_tile<VB, SK>(o, vb0, pa0, pa1, pa2, pa3, ACT((t) - 1)); MASKT(PX0, PX1, (t)); partialSM(PX0, PX1, m_reg, mnX, alX);                                        \
        __syncthreads();                                                                                                      \
        if ((t) + 1 < NT) { VMW(); if constexpr (F32) { SWRITE_VF(SB); SBAR(); if ((t) + 2 < NT) SLOAD_F((const float*)Kh, KBASE((t) + 2)); } \
                            else { SWRITE_H(SB); } }                                                                          \
        RESC(alX); __syncthreads(); } while (0)
    for (int t = 1; t + 1 < NT; t += 2) {
        HALF_STEP(pB0, pB1, mnB, alB, pA0, pA1, alA, t, 1, 0, 0);
        HALF_STEP(pA0, pA1, mnA, alA, pB0, pB1, alB, t + 1, 0, 1, 1);
    }
    const bool even = (NT & 1) == 0;
    if (even) { SBAR(); qkt<1, SK>(pB0, pB1, K_lds, r32, hi, S.qr, ACT(NT - 1)); SBAR(); }
#define QROW(e) (nxt.Q + (size_t)(wid * QBLK + r32) * D + ((e) >> 1) * 16 + hi * 8 + ((e) & 1) * 4)
    if constexpr (F32) { SLOAD_F((const float*)nxt.K, kbn); SBAR();
#pragma unroll
        for (int e = 0; e < 8; ++e) S.tq[e] = *(const f32x4*)QROW(e); }
    else { SLOAD_H(nxt.K, nxt.V, kbn); SBAR();
#pragma unroll
        for (int d0 = 0; d0 < 8; ++d0) S.qr[d0] = load8<TIn>(nxt.Q + (size_t)(wid * QBLK + r32) * D + d0 * 16 + hi * 8); }
    SBAR();
    finishSM(pA0, pA1, alA, l_reg, pa0, pa1, pa2, pa3); SBAR();
    if constexpr (F32) {
#pragma unroll
        for (int e = 8; e < 16; ++e) S.tq[e] = *(const f32x4*)QROW(e); SBAR(); }
#undef QROW
    pv_tile<0, SK>(o, vb0, pa0, pa1, pa2, pa3, ACT(even ? NT - 2 : NT - 1));
    if (even) { MASKT(pB0, pB1, NT - 1); partialSM(pB0, pB1, m_reg, mnB, alB); __syncthreads(); RESC(alB);
        finishSM(pB0, pB1, alB, l_reg, pa0, pa1, pa2, pa3); SBAR(); pv_tile<1, SK>(o, vb0, pa0, pa1, pa2, pa3, ACT(NT - 1)); }
    SBAR(); SEAM_K0();
    if (hi == 0) li_l[r32] = l_reg; asm volatile("s_waitcnt lgkmcnt(0)" ::: "memory");
    float rli[16];
#pragma unroll
    for (int r = 0; r < 16; ++r) rli[r] = __builtin_amdgcn_rcpf(li_l[crow(r, hi)]);
    TOut* Ow = cur.O + (size_t)(wid * QBLK) * LDO;
#pragma unroll
    for (int r = 0; r < 16; ++r) { const int orow = crow(r, hi);
#pragma unroll
        for (int d0 = 0; d0 < 4; ++d0) { const float v = o[d0][r] * rli[r];
            if constexpr (same_t<TOut, float>::v) { Ow[(size_t)orow * LDO + d0 * 32 + r32] = v; }
            else { const float vn = __shfl_xor(v, 1);
                   if ((r32 & 1) == 0) *(unsigned*)(Ow + (size_t)orow * LDO + d0 * 32 + r32) = cvtpk(v, vn); } } }
    if constexpr (F32) {
#pragma unroll
        for (int d0 = 0; d0 < 8; ++d0) S.qr[d0] = pack8(S.tq[2 * d0], S.tq[2 * d0 + 1]); }
    __syncthreads();
#undef RESC
#undef KBASE
#undef ACT
#undef MASKT
#undef SEAM_K0
#undef HALF_STEP
}
#undef ROW
#undef VMW
#undef VMWN
#undef SLOAD_H
#undef SWRITE_HK
#undef SWRITE_HV
#undef SWRITE_H
#undef SLOAD_F
#undef SWRITE_KF
#undef SWRITE_VF


}

namespace attn2 {
typedef float f32x2v __attribute__((ext_vector_type(2))); typedef attn::f32x4 f32x4; typedef attn::bf16 abf; typedef attn::bf16x8 bf16x8; typedef attn::f32x16 f32x16; typedef attn::u32x4 u32x4; typedef attn::s16x4 s16x4;
constexpr int KOFF = 0, VOFF = 32768, XOFF = 98304, XWAVE = 6656, XBUF = 4 * XWAVE, SCOFF = XOFF + 2 * XBUF, LDS_BYTES = SCOFF + 8 * 256;
static_assert(LDS_BYTES <= 157696, "attention LDS");
constexpr int QB2 = 128, LDO = 4096;
struct Blk { const abf* Q; const abf* K; const abf* V0; const abf* V1; abf* O; int P0; };
#define A2_TRRD(dst, vb, off) asm volatile("ds_read_b64_tr_b16 %0, %1 offset:%2" : "=&v"(dst) : "v"(vb), "i"(off) : "memory")
#define A2_FR(L, H) ((bf16x8){L[0], L[1], L[2], L[3], H[0], H[1], H[2], H[3]})
#define A2_RDK(vb, d0, s) do { A2_TRRD(xl##s, vb, (d0) * 512 + (s) * 4096); A2_TRRD(xh##s, vb, (d0) * 512 + (s) * 4096 + 2048); A2_TRRD(yl##s, vb, ((d0) + 1) * 512 + (s) * 4096); A2_TRRD(yh##s, vb, ((d0) + 1) * 512 + (s) * 4096 + 2048); } while (0)
#define A2_STEPK(accx, accy, pa, s, NEXT) do { asm volatile("s_waitcnt lgkmcnt(12)" ::: "memory"); __builtin_amdgcn_sched_barrier(0); \
        accx = __builtin_amdgcn_mfma_f32_32x32x16_bf16(pa, A2_FR(xl##s, xh##s), accx, 0, 0, 0); accy = __builtin_amdgcn_mfma_f32_32x32x16_bf16(pa, A2_FR(yl##s, yh##s), accy, 0, 0, 0); \
        __builtin_amdgcn_sched_barrier(0); NEXT; __builtin_amdgcn_sched_barrier(0); } while (0)
#define A2_PAIR(accx, accy, NEXT0, NEXT1, NEXT2, NEXT3) do { A2_STEPK(accx, accy, pa0, 0, NEXT0); A2_STEPK(accx, accy, pa1, 1, NEXT1); A2_STEPK(accx, accy, pa2, 2, NEXT2); A2_STEPK(accx, accy, pa3, 3, NEXT3); } while (0)
#define A2_NONE do { asm volatile("s_waitcnt lgkmcnt(0)" ::: "memory"); } while (0)
__device__ __forceinline__ void pv256(f32x16* o, int vb0, bf16x8 pa0, bf16x8 pa1, bf16x8 pa2, bf16x8 pa3) {
    s16x4 xl0, xh0, xl1, xh1, xl2, xh2, xl3, xh3, yl0, yh0, yl1, yh1, yl2, yh2, yl3, yh3;
    const int va = vb0, vb = vb0 + 16384;
    asm volatile("s_waitcnt lgkmcnt(0)" ::: "memory");
    A2_RDK(va, 0, 0); A2_RDK(va, 0, 1); A2_RDK(va, 0, 2); A2_RDK(va, 0, 3);
    A2_PAIR(o[0], o[1], A2_RDK(va, 2, 0), A2_RDK(va, 2, 1), A2_RDK(va, 2, 2), A2_RDK(va, 2, 3));
    A2_PAIR(o[2], o[3], A2_RDK(vb, 0, 0), A2_RDK(vb, 0, 1), A2_RDK(vb, 0, 2), A2_RDK(vb, 0, 3));
    A2_PAIR(o[4], o[5], A2_RDK(vb, 2, 0), A2_RDK(vb, 2, 1), A2_RDK(vb, 2, 2), A2_RDK(vb, 2, 3));
    A2_PAIR(o[6], o[7], A2_NONE, A2_NONE, A2_NONE, A2_NONE);
}
#undef A2_TRRD
#undef A2_FR
#undef A2_RDK
#undef A2_STEPK
#undef A2_PAIR
#undef A2_NONE
__device__ __forceinline__ void pack_half(const f32x16& P, bf16x8& outA, bf16x8& outB) {
#define A2_PK4(B_, OUT) do { unsigned a0 = attn::cvtpk(P[B_ + 0], P[B_ + 1]), a1 = attn::cvtpk(P[B_ + 2], P[B_ + 3]); unsigned b0 = attn::cvtpk(P[B_ + 4], P[B_ + 5]), b1 = attn::cvtpk(P[B_ + 6], P[B_ + 7]); \
        auto r0 = __builtin_amdgcn_permlane32_swap(a0, b0, false, false); auto r1 = __builtin_amdgcn_permlane32_swap(a1, b1, false, false); \
        u32x4 w = {r0[0], r1[0], r0[1], r1[1]}; OUT = *reinterpret_cast<bf16x8*>(&w); } while (0)
    A2_PK4(0, outA); A2_PK4(8, outB);
#undef A2_PK4
}
__device__ __forceinline__ float half_rowsum(const f32x16& P) {
    float ps = ((P[0] + P[1]) + (P[2] + P[3])) + ((P[4] + P[5]) + (P[6] + P[7])) + (((P[8] + P[9]) + (P[10] + P[11])) + ((P[12] + P[13]) + (P[14] + P[15])));
    auto rr = __builtin_amdgcn_permlane32_swap(__float_as_uint(ps), __float_as_uint(ps), false, false);
    return __uint_as_float(rr[0]) + __uint_as_float(rr[1]);
}
__device__ __forceinline__ void block(const Blk& B, char* lds, const int tid) {
    const int wid = __builtin_amdgcn_readfirstlane(tid >> 6), lane = tid & 63, r32 = lane & 31, hi = lane >> 5;
    const bool isA = wid < 4; const int wa = wid & 3;
    const int NT = (B.P0 + QB2) / 64;
    char* K_lds = lds + KOFF; char* V_lds = lds + VOFF;
    char* X_l = lds + XOFF + wa * XWAVE;
    float* sc_l = (float*)(lds + SCOFF) + wid * 64;
    const int t2 = tid & 255, sr = t2 >> 4, sc = (t2 & 15) * 8;
    const int kws = KSWZ(sr, sc * 2), vst = attn::v_st(sr, sc);
    const unsigned goff = (unsigned)(sr * 128 + sc) * 2u;
#define A2_LD(base, rowbytes, i) (*(const bf16x8*)((const char*)(base) + (size_t)(rowbytes) + (size_t)(gof_ + (unsigned)(i) * 4096u)))
#define A2_FRESH() unsigned gof_ = goff; asm volatile("" : "+v"(gof_))
    const int vb0 = (int)(uintptr_t)V_lds + attn::v_rd_base(lane);
    const int qlo = B.P0 + wa * 32, qm = qlo + r32 - 4 * hi;
    constexpr float C2 = 1.4426950408889634f * attn::SCALE;
    if (isA) {
        float m_reg = -1e30f, l_reg = 0.f; bf16x8 qr[8]; bf16x8 st[4];
#pragma unroll
        for (int d0 = 0; d0 < 8; ++d0) qr[d0] = attn::load8<abf>(B.Q + (size_t)(wa * 32 + r32) * 128 + d0 * 16 + hi * 8);
        { A2_FRESH();
#pragma unroll
        for (int i = 0; i < 4; ++i) st[i] = A2_LD(B.K, 0, i); }
        asm volatile("s_waitcnt vmcnt(0)" ::: "memory");
#pragma unroll
        for (int i = 0; i < 4; ++i) *(bf16x8*)(K_lds + kws + i * 4096) = st[i];
        { A2_FRESH();
#pragma unroll
        for (int i = 0; i < 4; ++i) st[i] = A2_LD(B.K, 64 * 256, i); }
        asm volatile("s_waitcnt vmcnt(0)" ::: "memory");
#pragma unroll
        for (int i = 0; i < 4; ++i) *(bf16x8*)(K_lds + 16384 + kws + i * 4096) = st[i];
        __syncthreads();
        f32x16 p0, p1;
        attn::qkt<0, false>(p0, p1, K_lds, r32, hi, qr, true);
        for (int t = 0; t <= NT; ++t) {
            if (t < NT) {
                const int buf = t & 1, kb = t * 64; const bool more2 = t + 2 < NT;
                if (more2) { A2_FRESH();
#pragma unroll
                    for (int i = 0; i < 4; ++i) st[i] = A2_LD(B.K, (kb + 128) * 256, i);
                }
                if (kb + 63 > qlo) attn::mask_tile(p0, p1, qm - kb, 0x7fffffffu);
                f32x16 n0, n1;
                attn::qkt<0, false>(n0, n1, K_lds + (buf ^ 1) * 16384, r32, hi, qr, true);
                float pmax = fmaxf(p0[0], p1[0]);
#pragma unroll
                for (int r = 1; r < 16; ++r) pmax = fmaxf(pmax, fmaxf(p0[r], p1[r]));
                { auto rr = __builtin_amdgcn_permlane32_swap(__float_as_uint(pmax), __float_as_uint(pmax), false, false); pmax = fmaxf(__uint_as_float(rr[0]), __uint_as_float(rr[1])); }
                const bool keep = __all((pmax - m_reg) * attn::SCALE <= attn::THR);
                const float mn = keep ? m_reg : fmaxf(m_reg, pmax); const float alpha = __builtin_amdgcn_exp2f((m_reg - mn) * C2); m_reg = mn;
                const float mnL = -mn * C2;
                char* xl = X_l + buf * XBUF;
                *(f32x4*)(xl + lane * 16) = (f32x4){p1[0], p1[1], p1[2], p1[3]}; *(f32x4*)(xl + 1024 + lane * 16) = (f32x4){p1[4], p1[5], p1[6], p1[7]};
                *(f32x4*)(xl + 2048 + lane * 16) = (f32x4){p1[8], p1[9], p1[10], p1[11]}; *(f32x4*)(xl + 3072 + lane * 16) = (f32x4){p1[12], p1[13], p1[14], p1[15]};
                *(f32x2v*)(xl + 6144 + lane * 8) = (f32x2v){mnL, alpha};
#pragma unroll
                for (int r = 0; r < 16; ++r) p0[r] = __builtin_amdgcn_exp2f(fmaf(p0[r], C2, mnL));
                l_reg = l_reg * alpha + half_rowsum(p0);
                bf16x8 pa0, pa1; pack_half(p0, pa0, pa1);
                *(bf16x8*)(xl + 4096 + lane * 16) = pa0; *(bf16x8*)(xl + 5120 + lane * 16) = pa1;
                if (more2) {
                    asm volatile("s_waitcnt vmcnt(0)" ::: "memory");
#pragma unroll
                    for (int i = 0; i < 4; ++i) *(bf16x8*)(K_lds + buf * 16384 + kws + i * 4096) = st[i];
                }
                p0 = n0; p1 = n1;
            }
            __syncthreads();
        }
        *(float*)(X_l + 6144 + lane * 8) = l_reg;
        __syncthreads();
        __syncthreads();
    } else {
        f32x16 o[8] = {}; bf16x8 st[8]; float l_reg = 0.f;
        __syncthreads();
        for (int t = 0; t <= NT; ++t) {
            if (t < NT) { A2_FRESH();
#pragma unroll
                for (int i = 0; i < 4; ++i) { st[i] = A2_LD(B.V0, t * 64 * 256, i); st[4 + i] = A2_LD(B.V1, t * 64 * 256, i); }
            }
            if (t >= 1) {
                const int pb = (t - 1) & 1;
                const char* xl = X_l + pb * XBUF;
                f32x16 p1;
                { const f32x4 a = *(const f32x4*)(xl + lane * 16), b = *(const f32x4*)(xl + 1024 + lane * 16), c = *(const f32x4*)(xl + 2048 + lane * 16), d = *(const f32x4*)(xl + 3072 + lane * 16);
                  p1 = (f32x16){a[0], a[1], a[2], a[3], b[0], b[1], b[2], b[3], c[0], c[1], c[2], c[3], d[0], d[1], d[2], d[3]}; }
                const f32x2v ma = *(const f32x2v*)(xl + 6144 + lane * 8);
                const float mnL = ma.x, alpha = ma.y;
#pragma unroll
                for (int r = 0; r < 16; ++r) p1[r] = __builtin_amdgcn_exp2f(fmaf(p1[r], C2, mnL));
                l_reg = l_reg * alpha + half_rowsum(p1);
                bf16x8 pa2, pa3; pack_half(p1, pa2, pa3);
                const bf16x8 pa0 = *(const bf16x8*)(xl + 4096 + lane * 16), pa1 = *(const bf16x8*)(xl + 5120 + lane * 16);
                if (__any(alpha < 1.f)) {
                    if (hi == 0) sc_l[r32] = alpha;
                    asm volatile("s_waitcnt lgkmcnt(0)" ::: "memory");
                    float a16[16];
#pragma unroll
                    for (int r = 0; r < 16; ++r) a16[r] = sc_l[attn::crow(r, hi)];
#pragma unroll
                    for (int d0 = 0; d0 < 8; ++d0)
#pragma unroll
                        for (int r = 0; r < 16; ++r) o[d0][r] *= a16[r];
                }
                pv256(o, vb0 + pb * 32768, pa0, pa1, pa2, pa3);
            }
            if (t < NT) {
                asm volatile("s_waitcnt vmcnt(0)" ::: "memory");
                char* vd = V_lds + (t & 1) * 32768 + vst;
#pragma unroll
                for (int i = 0; i < 4; ++i) { *(bf16x8*)(vd + i * 4096) = st[i]; *(bf16x8*)(vd + 16384 + i * 4096) = st[4 + i]; }
            }
            __syncthreads();
        }
        __syncthreads();
        l_reg += *(const float*)(X_l + 6144 + lane * 8);
        if (hi == 0) sc_l[32 + r32] = l_reg;
        asm volatile("s_waitcnt lgkmcnt(0)" ::: "memory");
        float rli[16];
#pragma unroll
        for (int r = 0; r < 16; ++r) rli[r] = __builtin_amdgcn_rcpf(sc_l[32 + attn::crow(r, hi)]);
        abf* Ow = B.O + (size_t)(wa * 32) * LDO;
#pragma unroll
        for (int r = 0; r < 16; ++r) { const int orow = attn::crow(r, hi);
#pragma unroll
            for (int d0 = 0; d0 < 8; ++d0) { const float v = o[d0][r] * rli[r]; const float vn = __shfl_xor(v, 1);
                if ((r32 & 1) == 0) *(unsigned*)(Ow + (size_t)orow * LDO + d0 * 32 + r32) = attn::cvtpk(v, vn); } }
        __syncthreads();
    }
}
#undef A2_LD
#undef A2_FRESH
}

namespace attn3 {
#define A3_LAS __attribute__((address_space(3)))
typedef float f32x2v __attribute__((ext_vector_type(2))); typedef attn::f32x4 f32x4; typedef attn::bf16 abf; typedef attn::bf16x8 bf16x8; typedef attn::f32x16 f32x16; typedef attn::u32x4 u32x4; typedef attn::s16x4 s16x4;
constexpr int KOFF = 0, VOFF = 32768, SCOFF = 98304, LDS_BYTES = SCOFF + 8 * 256;
constexpr int QB3 = 256, LDO = 4096;
struct Blk { const abf* Q; const abf* K; const abf* V0; const abf* V1; abf* O; int P0; };
#define A3_TRRD(dst, vb, off) asm volatile("ds_read_b64_tr_b16 %0, %1 offset:%2" : "=&v"(dst) : "v"(vb), "i"(off) : "memory")
#define A3_FR(L, H) ((bf16x8){L[0], L[1], L[2], L[3], H[0], H[1], H[2], H[3]})
#define A3_RDK(vb, d0, s) do { A3_TRRD(xl##s, vb, (d0) * 512 + (s) * 4096); A3_TRRD(xh##s, vb, (d0) * 512 + (s) * 4096 + 2048); A3_TRRD(yl##s, vb, ((d0) + 1) * 512 + (s) * 4096); A3_TRRD(yh##s, vb, ((d0) + 1) * 512 + (s) * 4096 + 2048); } while (0)
#define A3_STEPK(accx, accy, pa, s, NEXT) do { asm volatile("s_waitcnt lgkmcnt(12)" ::: "memory"); __builtin_amdgcn_sched_barrier(0); \
        accx = __builtin_amdgcn_mfma_f32_32x32x16_bf16(pa, A3_FR(xl##s, xh##s), accx, 0, 0, 0); accy = __builtin_amdgcn_mfma_f32_32x32x16_bf16(pa, A3_FR(yl##s, yh##s), accy, 0, 0, 0); \
        __builtin_amdgcn_sched_barrier(0); NEXT; __builtin_amdgcn_sched_barrier(0); } while (0)
#define A3_PAIR(accx, accy, NEXT0, NEXT1, NEXT2, NEXT3) do { A3_STEPK(accx, accy, pa0, 0, NEXT0); A3_STEPK(accx, accy, pa1, 1, NEXT1); A3_STEPK(accx, accy, pa2, 2, NEXT2); A3_STEPK(accx, accy, pa3, 3, NEXT3); } while (0)
#define A3_NONE do { asm volatile("s_waitcnt lgkmcnt(0)" ::: "memory"); } while (0)
__device__ __forceinline__ void pv256(f32x16* o, int vb0, bf16x8 pa0, bf16x8 pa1, bf16x8 pa2, bf16x8 pa3) {
    s16x4 xl0, xh0, xl1, xh1, xl2, xh2, xl3, xh3, yl0, yh0, yl1, yh1, yl2, yh2, yl3, yh3;
    const int va = vb0, vb = vb0 + 16384;
    asm volatile("s_waitcnt lgkmcnt(0)" ::: "memory");
    A3_RDK(va, 0, 0); A3_RDK(va, 0, 1); A3_RDK(va, 0, 2); A3_RDK(va, 0, 3);
    A3_PAIR(o[0], o[1], A3_RDK(va, 2, 0), A3_RDK(va, 2, 1), A3_RDK(va, 2, 2), A3_RDK(va, 2, 3));
    A3_PAIR(o[2], o[3], A3_RDK(vb, 0, 0), A3_RDK(vb, 0, 1), A3_RDK(vb, 0, 2), A3_RDK(vb, 0, 3));
    A3_PAIR(o[4], o[5], A3_RDK(vb, 2, 0), A3_RDK(vb, 2, 1), A3_RDK(vb, 2, 2), A3_RDK(vb, 2, 3));
    A3_PAIR(o[6], o[7], A3_NONE, A3_NONE, A3_NONE, A3_NONE);
}
#undef A3_TRRD
#undef A3_FR
#undef A3_RDK
#undef A3_STEPK
#undef A3_PAIR
#undef A3_NONE
__device__ __forceinline__ float own_sum(const f32x16& P) { return ((P[0] + P[1]) + (P[2] + P[3])) + ((P[4] + P[5]) + (P[6] + P[7])) + (((P[8] + P[9]) + (P[10] + P[11])) + ((P[12] + P[13]) + (P[14] + P[15]))); }
__device__ __forceinline__ void pack_own(const f32x16& P, bf16x8& outA, bf16x8& outB) {
    u32x4 wa = {attn::cvtpk(P[0], P[1]), attn::cvtpk(P[2], P[3]), attn::cvtpk(P[4], P[5]), attn::cvtpk(P[6], P[7])}; outA = *reinterpret_cast<bf16x8*>(&wa);
    u32x4 wb = {attn::cvtpk(P[8], P[9]), attn::cvtpk(P[10], P[11]), attn::cvtpk(P[12], P[13]), attn::cvtpk(P[14], P[15])}; outB = *reinterpret_cast<bf16x8*>(&wb);
}
__device__ __forceinline__ float vmax3(float a, float b, float c) { float d; asm("v_max3_f32 %0, %1, %2, %3" : "=v"(d) : "v"(a), "v"(b), "v"(c)); return d; }
__device__ __forceinline__ void block(const Blk& B, char* lds, A3_LAS unsigned char* ldsl, const int tid) {
    const int wid = __builtin_amdgcn_readfirstlane(tid >> 6), lane = tid & 63, r32 = lane & 31, hi = lane >> 5;
    const int NT = (B.P0 + QB3) / 64;
    char* K_lds = lds + KOFF; char* V_lds = lds + VOFF;
    float* sc_l = (float*)(lds + SCOFF) + wid * 64;
    const int vb0 = (int)(uintptr_t)V_lds + attn::v_rd_base(lane);
    const int qlo = B.P0 + wid * 32, qm = qlo + r32 - 4 * hi;
    constexpr float C2 = 1.4426950408889634f * attn::SCALE;
    unsigned kso[2], vso[2];
#pragma unroll
    for (int i = 0; i < 2; ++i) { const int row = (2 * wid + i) * 4 + (lane >> 4); const int c = (lane & 15) ^ (row & 7); kso[i] = (unsigned)(row * 128 + c * 8) * 2u; }
#pragma unroll
    for (int q = 0; q < 2; ++q) { const int st = 2 * (2 * wid + q) + (lane >> 5), w16 = lane & 31; const int k = (st >> 2) * 8 + (w16 >> 2);
        const int c = (st & 3) * 32 + (w16 & 3) * 8; vso[q] = (unsigned)(k * 128 + c) * 2u; }
#define A3_STAGE(tile, buf) do { const size_t tb_ = (size_t)(tile) * (64 * 256); unsigned ko_[2] = {kso[0], kso[1]}, vo_[2] = {vso[0], vso[1]}; asm volatile("" : "+v"(ko_[0]), "+v"(ko_[1]), "+v"(vo_[0]), "+v"(vo_[1])); \
        _Pragma("unroll") for (int i_ = 0; i_ < 2; ++i_) __builtin_amdgcn_global_load_lds((const unsigned*)((const char*)B.K + tb_ + ko_[i_]), (A3_LAS unsigned*)(ldsl + KOFF + (buf) * 16384 + (2 * wid + i_) * 1024), 16, 0, 0); \
        _Pragma("unroll") for (int q_ = 0; q_ < 2; ++q_) { __builtin_amdgcn_global_load_lds((const unsigned*)((const char*)B.V0 + tb_ + vo_[q_]), (A3_LAS unsigned*)(ldsl + VOFF + (buf) * 32768 + (2 * wid + q_) * 1024), 16, 0, 0); \
            __builtin_amdgcn_global_load_lds((const unsigned*)((const char*)B.V1 + tb_ + vo_[q_]), (A3_LAS unsigned*)(ldsl + VOFF + (buf) * 32768 + 16384 + (2 * wid + q_) * 1024), 16, 0, 0); } } while (0)
    float m_reg = -1e30f, l_reg = 0.f; bf16x8 qr[8]; f32x16 o[8] = {};
#pragma unroll
    for (int d0 = 0; d0 < 8; ++d0) qr[d0] = attn::load8<abf>(B.Q + (size_t)(wid * 32 + r32) * 128 + d0 * 16 + hi * 8);
    A3_STAGE(0, 0);
    asm volatile("s_waitcnt vmcnt(0)" ::: "memory");
    __syncthreads();
    for (int t = 0; t < NT; ++t) {
        const int buf = t & 1, kb = t * 64;
        if (t + 1 < NT) A3_STAGE(t + 1, buf ^ 1);
        f32x16 p0, p1;
        attn::qkt<0, false>(p0, p1, K_lds + buf * 16384, r32, hi, qr, true);
        if (kb + 63 > qlo) attn::mask_tile(p0, p1, qm - kb, 0x7fffffffu);
        float pmax = fmaxf(p0[15], p1[15]);
        { float mb;
          asm("v_max3_f32 %0, %0, %2, %3\n\tv_max3_f32 %1, %10, %11, %12\n\tv_max3_f32 %0, %0, %4, %5\n\tv_max3_f32 %1, %1, %13, %14\n\tv_max3_f32 %0, %0, %6, %7\n\tv_max3_f32 %1, %1, %15, %16\n\tv_max3_f32 %0, %0, %8, %9\n\tv_max3_f32 %1, %1, %17, %18"
              : "+&v"(pmax), "=&v"(mb) : "v"(p0[0]), "v"(p0[1]), "v"(p0[2]), "v"(p0[3]), "v"(p0[4]), "v"(p0[5]), "v"(p0[6]), "v"(p0[7]),
                "v"(p1[0]), "v"(p1[1]), "v"(p1[2]), "v"(p1[3]), "v"(p1[4]), "v"(p1[5]), "v"(p1[6]), "v"(p1[7]), "v"(p1[8]));
          asm("v_max3_f32 %0, %0, %2, %3\n\tv_max3_f32 %1, %1, %9, %10\n\tv_max3_f32 %0, %0, %4, %5\n\tv_max3_f32 %1, %1, %11, %12\n\tv_max3_f32 %0, %0, %6, %7\n\tv_max3_f32 %1, %1, %13, %14\n\tv_max3_f32 %0, %0, %1, %8"
              : "+&v"(pmax), "+&v"(mb) : "v"(p0[8]), "v"(p0[9]), "v"(p0[10]), "v"(p0[11]), "v"(p0[12]), "v"(p0[13]), "v"(p0[14]),
                "v"(p1[9]), "v"(p1[10]), "v"(p1[11]), "v"(p1[12]), "v"(p1[13]), "v"(p1[14])); }
        { auto rr = __builtin_amdgcn_permlane32_swap(__float_as_uint(pmax), __float_as_uint(pmax), false, false); pmax = vmax3(__uint_as_float(rr[0]), __uint_as_float(rr[1]), __uint_as_float(rr[1])); }
        const bool keep = __all((pmax - m_reg) * attn::SCALE <= attn::THR);
        const float mn = keep ? m_reg : vmax3(m_reg, pmax, pmax); const float alpha = __builtin_amdgcn_exp2f((m_reg - mn) * C2); m_reg = mn;
        const float mnL = -mn * C2;
#pragma unroll
        for (int r = 0; r < 16; ++r) { p0[r] = __builtin_amdgcn_exp2f(fmaf(p0[r], C2, mnL)); p1[r] = __builtin_amdgcn_exp2f(fmaf(p1[r], C2, mnL)); }
        l_reg = l_reg * alpha + (own_sum(p0) + own_sum(p1));
        bf16x8 pa0, pa1, pa2, pa3; pack_own(p0, pa0, pa1); pack_own(p1, pa2, pa3);
        if (__any(alpha < 1.f)) {
            if (hi == 0) sc_l[r32] = alpha;
            asm volatile("s_waitcnt lgkmcnt(0)" ::: "memory");
            float a16[16];
#pragma unroll
            for (int r = 0; r < 16; ++r) a16[r] = sc_l[attn::crow(r, hi)];
#pragma unroll
            for (int d0 = 0; d0 < 8; ++d0)
#pragma unroll
                for (int r = 0; r < 16; ++r) o[d0][r] *= a16[r];
        }
        pv256(o, vb0 + buf * 32768, pa0, pa1, pa2, pa3);
        asm volatile("s_waitcnt vmcnt(0)" ::: "memory");
        __syncthreads();
    }
#undef A3_STAGE
    { auto rr = __builtin_amdgcn_permlane32_swap(__float_as_uint(l_reg), __float_as_uint(l_reg), false, false); l_reg = __uint_as_float(rr[0]) + __uint_as_float(rr[1]); }
    if (hi == 0) sc_l[32 + r32] = l_reg;
    asm volatile("s_waitcnt lgkmcnt(0)" ::: "memory");
    float rli[16];
#pragma unroll
    for (int r = 0; r < 16; ++r) rli[r] = __builtin_amdgcn_rcpf(sc_l[32 + attn::crow(r, hi)]);
    abf* Ow = B.O + (size_t)(wid * 32) * LDO;
#pragma unroll
    for (int r = 0; r < 16; ++r) { const int orow = attn::crow(r, hi);
#pragma unroll
        for (int d0 = 0; d0 < 8; ++d0) { const float v = o[d0][r] * rli[r]; const float vn = __shfl_xor(v, 1);
            if ((r32 & 1) == 0) *(unsigned*)(Ow + (size_t)orow * LDO + d0 * 32 + r32) = attn::cvtpk(v, vn); } }
    __syncthreads();
}
}
#define GAS __attribute__((address_space(1)))
#define LAS __attribute__((address_space(3)))
typedef unsigned short bf16;
typedef unsigned v4u __attribute__((ext_vector_type(4)));
typedef float f32x4 __attribute__((ext_vector_type(4)));
typedef short bf16x8 __attribute__((ext_vector_type(8)));
typedef GAS unsigned gu32;
typedef GAS unsigned long long gu64;
#define RLX_AGENT __ATOMIC_RELAXED, __HIP_MEMORY_SCOPE_AGENT
#define LDS_WAIT() asm volatile("s_waitcnt lgkmcnt(0)" ::: "memory")
#define VM_WAIT() asm volatile("s_waitcnt vmcnt(0)" ::: "memory")
__device__ __forceinline__ unsigned long long rt() { return __builtin_amdgcn_s_memrealtime(); }
__device__ __forceinline__ unsigned f2bf(float f) { unsigned u = __builtin_bit_cast(unsigned, f); return (u + 0x7fffu + ((u >> 16) & 1u)) >> 16; }
__device__ __forceinline__ unsigned pk2(float lo, float hi) { return f2bf(lo) | (f2bf(hi) << 16); }

#define XB_TMO      128
#define XB_XCNT(j)  (256  + 64 * (j))
#define XB_XSUB(j)  (1280 + 64 * (j))
#define XB_XGEN(j)  (2304 + 64 * (j))
#define XB_TOP      3328
#define XB_TOPGEN   3392
#define XCD_BAR_WORDS 3456
#define XB_SPIN_CAP (1u << 18)

__device__ __forceinline__ unsigned xb_ld(unsigned* p)              { return __hip_atomic_load(p, __ATOMIC_RELAXED, __HIP_MEMORY_SCOPE_AGENT); }
__device__ __forceinline__ unsigned xb_add(unsigned* p, unsigned v) { return __hip_atomic_fetch_add(p, v, __ATOMIC_RELAXED, __HIP_MEMORY_SCOPE_AGENT); }
__device__ __forceinline__ unsigned xb_xcc_id() { return (unsigned)__builtin_amdgcn_s_getreg((3 << 11) | 20) & 0xFu; }
#define XB_SPIN(cond, bar) do { unsigned _sp = 0; while (cond) { __builtin_amdgcn_s_sleep(1); \
    if ((++_sp & 255u) == 0u) { if (xb_ld(&(bar)[XB_TMO])) break; if (_sp > XB_SPIN_CAP) { atomicAdd(&(bar)[XB_TMO], 1u); break; } } } } while (0)

struct XcdBarrier {
    unsigned* bar; unsigned x;
    volatile LAS unsigned* st;
};

__device__ __forceinline__ XcdBarrier xcd_barrier_post(unsigned* bar, volatile LAS unsigned* st) {
    XcdBarrier b; b.bar = bar; b.x = xb_xcc_id(); b.st = st;
    if (threadIdx.x == 0) (void)xb_add(&bar[XB_XCNT(b.x)], 1u);
    return b;
}
__device__ __forceinline__ void xcd_barrier_complete(unsigned* bar, unsigned x, unsigned& nloc, unsigned& nx) {
    const unsigned G = gridDim.x * gridDim.y * gridDim.z;
    unsigned sum, cnt, mine, sp = 0u;
    for (;;) {
        sum = 0u; cnt = 0u; mine = 0u;
#pragma unroll
        for (unsigned j = 0; j < 16; ++j) { const unsigned c = xb_ld(&bar[XB_XCNT(j)]); sum += c; cnt += (c > 0u) ? 1u : 0u; mine = (j == x) ? c : mine; }
        if (sum == G) break;
        __builtin_amdgcn_s_sleep(1);
        if ((++sp & 255u) == 0u) { if (xb_ld(&bar[XB_TMO])) break; if (sp > XB_SPIN_CAP) { atomicAdd(&bar[XB_TMO], 1u); break; } }
    }
    nloc = mine > 0u ? mine : 1u; nx = cnt > 0u ? cnt : 1u;
}

__device__ __forceinline__ void xcd_barrier(const XcdBarrier& b, const int tid) {
    asm volatile("s_waitcnt vmcnt(0)" ::: "memory");
    __syncthreads();
    if (tid == 0) {
        unsigned* bar = b.bar;
        __builtin_amdgcn_s_waitcnt(0);
        unsigned nloc = b.st[0], nx = b.st[1];
        if (nloc == 0u) { xcd_barrier_complete(bar, b.x, nloc, nx); b.st[0] = nloc; b.st[1] = nx; }
        const unsigned old = xb_add(&bar[XB_XSUB(b.x)], 1u);
        const unsigned gen = old / nloc;
        if (old + 1u == (gen + 1u) * nloc) {
            __builtin_amdgcn_fence(__ATOMIC_RELEASE, "agent");
            asm volatile("s_waitcnt vmcnt(0)" ::: "memory");
            const unsigned og = xb_add(&bar[XB_TOP], 1u);
            const unsigned tg = og / nx;
            if (og + 1u == (tg + 1u) * nx) xb_add(&bar[XB_TOPGEN], 1u);
            else XB_SPIN(xb_ld(&bar[XB_TOPGEN]) == tg, bar);
            __builtin_amdgcn_fence(__ATOMIC_ACQUIRE, "agent");
            xb_add(&bar[XB_XGEN(b.x)], 1u);
            asm volatile("s_waitcnt vmcnt(0)" ::: "memory");
        } else {
            XB_SPIN(xb_ld(&bar[XB_XGEN(b.x)]) == gen, bar);
            __builtin_amdgcn_fence(__ATOMIC_ACQUIRE, "agent");
            asm volatile("s_waitcnt vmcnt(0)" ::: "memory");
        }
    }
    __syncthreads();
}

constexpr int NWAVES = 8;
#ifndef MK_ONE_LAUNCH
#define MK_ONE_LAUNCH 1
#endif
constexpr int NPHASE = 13;
constexpr int T = 8192, DM = 2048, NE = 32;
constexpr float EPS = 1e-5f;
constexpr size_t MiB = 1u << 20;
constexpr size_t WS_CTL = 0, CTL_ZERO_BYTES = 1 * MiB;
constexpr size_t WS_MODP = 1 * MiB;
constexpr size_t WS_MOD = 2 * MiB;
constexpr size_t WS_ROPE = 3 * MiB;
constexpr size_t WS_WRT = 4 * MiB;
constexpr size_t WS_TOPI = 5 * MiB;
constexpr size_t WS_TOPW = 5 * MiB + 256 * 1024;
constexpr size_t WS_TRANK = 5 * MiB + 512 * 1024;
constexpr size_t WS_ECNT = WS_CTL + 512 * 1024;
constexpr size_t WS_STOK = 6 * MiB;
constexpr size_t WS_WIN = 8 * MiB;
constexpr size_t WS_WAO = 72 * MiB, WS_WO = 88 * MiB;
constexpr size_t WS_WUP = 96 * MiB;
constexpr size_t WS_WDN = 608 * MiB;
constexpr size_t WS_H = 864 * MiB;
constexpr size_t WS_Q = 896 * MiB, WS_K = 928 * MiB, WS_V = 960 * MiB;
constexpr size_t WS_R = 992 * MiB;
constexpr size_t WS_OA = 1152 * MiB;
constexpr size_t WS_ON = 1216 * MiB;
constexpr size_t WS_TMP = 1280 * MiB;
constexpr size_t WS_MG = 1344 * MiB;
constexpr size_t WS_X1 = 1376 * MiB;
constexpr size_t WS_XS = 1440 * MiB;
constexpr size_t WS_ACT = 1600 * MiB;
constexpr size_t WS_YS = 1760 * MiB;
constexpr size_t WS_END = 1920 * MiB;
constexpr int CW_BAR = 4096;
constexpr int RING_OFF = 0, RING_BYTES = 131072;
constexpr int TOKTAB_OFF = 131072;
constexpr int LDSCTL_OFF = 157696, MISC_OFF = LDSCTL_OFF + 320, TILE_OFF = LDSCTL_OFF + 1024;
constexpr int LDS_BYTES = 163840;

typedef unsigned u32x2 __attribute__((ext_vector_type(2)));
typedef int i32x4 __attribute__((ext_vector_type(4)));
__device__ __forceinline__ int fresh_lane() { int l; asm volatile("v_mbcnt_lo_u32_b32 %0, -1, 0\n\tv_mbcnt_hi_u32_b32 %0, -1, %0" : "=v"(l)); return l; }
__device__ __forceinline__ float wave_sum(float v) {
#pragma unroll
    for (int o = 1; o < 64; o <<= 1) v += __shfl_xor(v, o);
    return v;
}
__device__ __forceinline__ float dot4(f32x4 a, f32x4 b) { return (a.x * b.x + a.y * b.y) + (a.z * b.z + a.w * b.w); }
__device__ __forceinline__ float bflo(unsigned w) { return __uint_as_float(w << 16); }
__device__ __forceinline__ float bfhi(unsigned w) { return __uint_as_float(w & 0xffff0000u); }
__device__ __forceinline__ u32x2 pack4(f32x4 v) { u32x2 w; w.x = pk2(v.x, v.y); w.y = pk2(v.z, v.w); return w; }
__device__ __forceinline__ f32x4 unpack4(u32x2 w) { return (f32x4){bflo(w.x), bfhi(w.x), bflo(w.y), bfhi(w.y)}; }
__device__ __forceinline__ float inv_freq(int i) {
    float r = 1.000000000e+00f;
    r = i == 1 ? 4.403665960e-01f : r; r = i == 2 ? 1.939227432e-01f : r; r = i == 3 ? 8.539710194e-02f : r; r = i == 4 ? 3.760603070e-02f : r;
    r = i == 5 ? 1.656043902e-02f : r; r = i == 6 ? 7.292664610e-03f : r; r = i == 7 ? 3.211445874e-03f : r; r = i == 8 ? 1.414213562e-03f : r;
    r = i == 9 ? 6.227723788e-04f : r; r = i == 10 ? 2.742481884e-04f : r; r = i == 11 ? 1.207697351e-04f : r; r = i == 12 ? 5.318296098e-05f : r;
    r = i == 13 ? 2.341999971e-05f : r; r = i == 14 ? 1.031338616e-05f : r; r = i == 15 ? 4.541670478e-06f : r;
    return r;
}

struct Args { const void* in[24]; float* out; unsigned char* ws; int ph_lo, ph_hi, li, pad; };
typedef const __attribute__((address_space(4))) unsigned long long* KP;
__device__ __forceinline__ KP kargs() { KP kp = (KP)__builtin_amdgcn_kernarg_segment_ptr(); asm volatile("" : "+s"(kp)); return kp; }
#define KIN(i) ((const void*)(const GAS char*)kp[(i)])
#define KWS() ((unsigned char*)(GAS unsigned char*)kp[25])
#define KOUT() ((float*)(GAS float*)kp[24])

struct ConvSrc { const float* W; bf16* WT; int N; int item; int ldk; int kfast; int tiled; int ktoff; int plain; };
__device__ __forceinline__ ConvSrc conv_decode(KP kp, unsigned char* ws, int it) {
    constexpr int I_IN = 32 * 256, I_SQ = 32 * 32, I_UP = 32 * 64, I_DN = 32 * 32;
    ConvSrc c; int r = it; c.ldk = 2048; c.kfast = 0; c.tiled = 32; c.ktoff = 0; c.plain = 0;
    if (r < I_IN) { c.W = (const float*)KIN(6); c.WT = (bf16*)(ws + WS_WIN); c.N = 16384; c.item = r; return c; } r -= I_IN;
    if (r < I_SQ) { c.W = (const float*)KIN(13); c.WT = (bf16*)(ws + WS_WAO); c.N = 2048; c.item = r; c.ldk = 4096; c.tiled = 64; return c; } r -= I_SQ;
    if (r < I_SQ) { c.W = (const float*)KIN(14); c.WT = (bf16*)(ws + WS_WAO); c.N = 2048; c.item = r; c.ldk = 4096; c.tiled = 64; c.ktoff = 32; return c; } r -= I_SQ;
    if (r < I_SQ) { c.W = (const float*)KIN(15); c.WT = (bf16*)(ws + WS_WO); c.N = 2048; c.item = r; return c; } r -= I_SQ;
    if (r < NE * I_UP) { const int e = r / I_UP; c.W = (const float*)KIN(19) + (size_t)e * 2048 * 4096; c.WT = (bf16*)(ws + WS_WUP) + (size_t)e * 4096 * 2048; c.N = 4096; c.item = r - e * I_UP; return c; } r -= NE * I_UP;
    { const int e = r / I_DN; c.W = (const float*)KIN(21) + (size_t)e * 2048 * 2048; c.WT = (bf16*)(ws + WS_WDN) + (size_t)e * 2048 * 2048; c.N = 2048; c.item = r - e * I_DN; c.plain = 1; return c; }
}
constexpr int CONV_DENSE_ITEMS = 32 * 256 + 3 * 32 * 32, CONV_UP_MID = CONV_DENSE_ITEMS + NE * 32 * 32, CONV_UP_END = CONV_DENSE_ITEMS + NE * 32 * 64, CONV_ALL_ITEMS = CONV_UP_END + NE * 32 * 32;
__device__ __forceinline__ void conv_load(const ConvSrc& c, int lane, f32x4 (&ra)[8], f32x4 (&rb)[8]) {
    const int nblk = c.N >> 6, kb = c.kfast ? (c.item & 31) : c.item / nblk, nb = c.kfast ? (c.item >> 5) : c.item - kb * nblk, k0 = kb * 64, n0 = nb * 64;
    const int n4 = (lane & 15) * 4, kq = lane >> 4;
#pragma unroll
    for (int i = 0; i < 8; ++i) { const int kp2 = 4 * i + kq; const float* p = c.W + (size_t)(k0 + 2 * kp2) * c.N + n0 + n4; ra[i] = __builtin_nontemporal_load((const GAS f32x4*)p); rb[i] = __builtin_nontemporal_load((const GAS f32x4*)(p + c.N)); }
}
__device__ __forceinline__ void conv_emit(const ConvSrc& c, int lane, LAS unsigned* P, const f32x4 (&ra)[8], const f32x4 (&rb)[8]) {
    const int nblk = c.N >> 6, kb = c.kfast ? (c.item & 31) : c.item / nblk, nb = c.kfast ? (c.item >> 5) : c.item - kb * nblk, k0 = kb * 64, n0 = nb * 64;
    const int n4 = (lane & 15) * 4, kq = lane >> 4;
#pragma unroll
    for (int i = 0; i < 8; ++i) { const int kp2 = 4 * i + kq; LAS unsigned* d = P + kp2 * 65 + n4;
        d[0] = pg8::cvt_pk_bf16(ra[i].x, rb[i].x); d[1] = pg8::cvt_pk_bf16(ra[i].y, rb[i].y); d[2] = pg8::cvt_pk_bf16(ra[i].z, rb[i].z); d[3] = pg8::cvt_pk_bf16(ra[i].w, rb[i].w); }
    LDS_WAIT(); asm volatile("" ::: "memory");
    const int cc = lane & 7;
#pragma unroll
    for (int jj = 0; jj < 8; ++jj) { const int n = (lane >> 3) + 8 * jj; const LAS unsigned* sp = P + (4 * cc) * 65 + n;
        v4u o; o.x = sp[0]; o.y = sp[65]; o.z = sp[130]; o.w = sp[195];
        bf16* dst = c.tiled ? c.WT + (size_t)((nb >> 2) * c.tiled + c.ktoff + kb) * 16384 + ((nb & 3) * 64 + n) * 64 + 8 * cc : c.WT + (size_t)(n0 + n) * c.ldk + k0 + 8 * cc;
        if (c.plain) *(GAS v4u*)dst = o; else __builtin_nontemporal_store(o, (GAS v4u*)dst); }
    LDS_WAIT(); asm volatile("" ::: "memory");
}
__device__ __forceinline__ void conv_run(KP kp, unsigned char* ws, LAS unsigned* P, int lane, int first, int it_hi, int step) {
    if (first >= it_hi) return;
    const int lastv = first + ((it_hi - 1 - first) / step) * step;
    f32x4 a0[8], b0[8], a1[8], b1[8];
    ConvSrc c0 = conv_decode(kp, ws, first), c1;
    conv_load(c0, lane, a0, b0);
    for (int it = first; it < it_hi; it += 2 * step) {
        c1 = conv_decode(kp, ws, min(it + step, lastv)); conv_load(c1, lane, a1, b1);
        conv_emit(c0, lane, P, a0, b0);
        c0 = conv_decode(kp, ws, min(it + 2 * step, lastv)); conv_load(c0, lane, a0, b0);
        conv_emit(c1, lane, P, a1, b1);
    }
}

__device__ __forceinline__ void phase0(KP kp, LAS unsigned char* lds, int wave, int bid, int G) {
    const int lane = fresh_lane(), tid = wave * 64 + lane;
    unsigned char* ws = KWS();
    { const int* pos = (const int*)KIN(2); float* rope = (float*)(ws + WS_ROPE);
      for (int i = bid * 512 + tid; i < T * 16; i += G * 512) { const int t = i >> 4, f = i & 15;
          const float ang = (float)pos[t] * inv_freq(f); double rev = (double)ang * 0.15915494309189535; rev -= __builtin_rint(rev);
          const float fr = (float)rev; rope[t * 32 + f] = __builtin_amdgcn_cosf(fr); rope[t * 32 + 16 + f] = __builtin_amdgcn_sinf(fr); } }
    { const float* wr = (const float*)KIN(17); float* wrt = (float*)(ws + WS_WRT);
      for (int i = bid * 512 + tid; i < NE * DM; i += G * 512) { const int e = i >> 11, c = i & 2047; wrt[i] = wr[c * NE + e]; } }
    for (int u = bid; u < 256; u += G) {
        const int nc = u & 15, kr = u >> 4, n0 = 768 * nc, k0 = 128 * kr;
        const float* cvec = (const float*)KIN(1); const float* wada = (const float*)KIN(3);
        f32x4 acc[3] = {(f32x4){0.f, 0.f, 0.f, 0.f}, (f32x4){0.f, 0.f, 0.f, 0.f}, (f32x4){0.f, 0.f, 0.f, 0.f}};
#pragma unroll 4
        for (int i = 0; i < 16; ++i) { const int k = k0 + wave + 8 * i; const float cv = cvec[k]; const float s = cv / (1.0f + __expf(-cv));
            const float* p = wada + (size_t)k * 12288 + n0 + 4 * lane;
#pragma unroll
            for (int q = 0; q < 3; ++q) acc[q] += s * *(const GAS f32x4*)(p + 256 * q); }
        LAS float* red = (LAS float*)lds;
#pragma unroll
        for (int q = 0; q < 3; ++q) *(LAS f32x4*)(red + wave * 768 + 256 * q + 4 * lane) = acc[q];
        __syncthreads();
        if (tid < 192) { f32x4 s = *(LAS f32x4*)(red + 4 * tid);
#pragma unroll
            for (int w = 1; w < 8; ++w) s += *(LAS f32x4*)(red + w * 768 + 4 * tid);
            *(GAS f32x4*)((float*)(ws + WS_MODP) + (size_t)kr * 12288 + n0 + 4 * tid) = s; }
        __syncthreads();
    }
    conv_run(kp, ws, (LAS unsigned*)(lds + wave * 8448), lane, bid * NWAVES + wave, CONV_DENSE_ITEMS, G * NWAVES);
}
__device__ __forceinline__ void conv_moe_share(KP kp, LAS unsigned char* lds, int wave, int bid, int G, int it_lo, int it_hi, int lds_off = 0) {
    const int lane = fresh_lane();
    conv_run(kp, KWS(), (LAS unsigned*)(lds + lds_off + wave * 8320), lane, it_lo + bid * NWAVES + wave, it_hi, G * NWAVES);
    __syncthreads();
}
__device__ __forceinline__ void conv_moe_range(KP kp, LAS unsigned char* lds, int wave, int lo, int hi) {
    const int lane = fresh_lane();
    conv_run(kp, KWS(), (LAS unsigned*)(lds + wave * 8320), lane, lo + wave, hi, NWAVES);
    __syncthreads();
}

__device__ __forceinline__ void phase1(KP kp, LAS unsigned char* lds, int wave, int bid, int G) {
    const int lane = fresh_lane(), tid = wave * 64 + lane;
    unsigned char* ws = KWS();
    LAS float* A1 = (LAS float*)lds; LAS float* B1 = A1 + 2048;
    const float* modp = (const float*)(ws + WS_MODP); const float* b_ada = (const float*)KIN(4); const float* n1g = (const float*)KIN(5);
    for (int c = tid; c < 2048; c += 512) { float sh = b_ada[c], sc = b_ada[2048 + c];
        for (int r = 0; r < 16; ++r) { sh += modp[r * 12288 + c]; sc += modp[r * 12288 + 2048 + c]; }
        A1[c] = n1g[c] * (1.0f + sc); B1[c] = sh; }
    { float* mod = (float*)(ws + WS_MOD);
      for (int n = bid * 512 + tid; n < 12288; n += G * 512) { float s = b_ada[n]; for (int r = 0; r < 16; ++r) s += modp[r * 12288 + n]; mod[n] = s; } }
    __syncthreads();
    const float* x = (const float*)KIN(0); bf16* H = (bf16*)(ws + WS_H);
    for (int m = bid * NWAVES + wave; m < T; m += G * NWAVES) {
        const GAS f32x4* xr = (const GAS f32x4*)(x + (size_t)m * DM) + lane;
        f32x4 v[8]; float s = 0.f;
#pragma unroll
        for (int j = 0; j < 8; ++j) { v[j] = xr[64 * j]; s += dot4(v[j], v[j]); }
        const float rstd = 1.0f / sqrtf(wave_sum(s) * (1.0f / DM) + EPS);
        GAS u32x2* o8 = (GAS u32x2*)(H + (size_t)m * DM) + lane;
#pragma unroll
        for (int j = 0; j < 8; ++j) { const f32x4 av = *(const LAS f32x4*)(A1 + 256 * j + 4 * lane), bv = *(const LAS f32x4*)(B1 + 256 * j + 4 * lane);
            o8[64 * j] = pack4(v[j] * rstd * av + bv); }
    }
}

__device__ __forceinline__ void phase4(KP kp, int wave, int bid, int G) {
    const int lane = fresh_lane();
    unsigned char* ws = KWS();
    const int gw = bid * NWAVES + wave, NGW = G * NWAVES;
    float lam;
    { const float* q1 = (const float*)KIN(8); const float* k1 = (const float*)KIN(9); const float* q2 = (const float*)KIN(10); const float* k2 = (const float*)KIN(11);
      const float s1 = wave_sum(q1[lane] * k1[lane] + q1[lane + 64] * k1[lane + 64]), s2 = wave_sum(q2[lane] * k2[lane] + q2[lane + 64] * k2[lane + 64]);
      lam = expf(s1) - expf(s2) + 0.2f; }
    const bf16* OA = (const bf16*)(ws + WS_OA); bf16* ON = (bf16*)(ws + WS_ON);
    const f32x4 sg = *(const GAS f32x4*)((const float*)KIN(12) + 4 * lane) * 0.8f;
    for (int it = gw; it < T * 8; it += NGW) { const int t = it >> 3, hd = it & 7;
        const bf16* o0 = OA + (size_t)t * 4096 + hd * 512 + 4 * lane;
        const f32x4 d = unpack4(*(const GAS u32x2*)o0) - lam * unpack4(*(const GAS u32x2*)(o0 + 256));
        const float rstd = 1.0f / sqrtf(wave_sum(dot4(d, d)) * (1.0f / 256.0f) + EPS);
        *(GAS u32x2*)(ON + (size_t)t * 4096 + hd * 256 + 4 * lane) = pack4(d * rstd * sg); }
    const bf16* R = (const bf16*)(ws + WS_R); bf16* CV = (bf16*)(ws + WS_ON) + 2048; const float* cw = (const float*)KIN(7);
    for (int it = gw; it < 2048; it += NGW) { const int tb = it >> 2, ch = (it & 3) * 512 + 8 * lane, t0 = tb * 16;
        f32x4 w0a = *(const GAS f32x4*)(cw + ch), w0b = *(const GAS f32x4*)(cw + ch + 4), w1a = *(const GAS f32x4*)(cw + 2048 + ch), w1b = *(const GAS f32x4*)(cw + 2048 + ch + 4),
              w2a = *(const GAS f32x4*)(cw + 4096 + ch), w2b = *(const GAS f32x4*)(cw + 4096 + ch + 4);
        f32x4 u1a = (f32x4){0.f, 0.f, 0.f, 0.f}, u1b = u1a, u2a = u1a, u2b = u1a;
        if (t0 > 0) {
            { const bf16* r = R + (size_t)(t0 - 1) * 10240 + ch; const v4u c = *(const GAS v4u*)(r + 2048), h = *(const GAS v4u*)(r + 4096);
              u1a = unpack4((u32x2){c.x, c.y}) * unpack4((u32x2){h.x, h.y}); u1b = unpack4((u32x2){c.z, c.w}) * unpack4((u32x2){h.z, h.w}); }
            { const bf16* r = R + (size_t)(t0 - 2) * 10240 + ch; const v4u c = *(const GAS v4u*)(r + 2048), h = *(const GAS v4u*)(r + 4096);
              u2a = unpack4((u32x2){c.x, c.y}) * unpack4((u32x2){h.x, h.y}); u2b = unpack4((u32x2){c.z, c.w}) * unpack4((u32x2){h.z, h.w}); }
        }
#pragma unroll 4
        for (int i = 0; i < 16; ++i) { const int t = t0 + i; const bf16* r = R + (size_t)t * 10240 + ch;
            const v4u b = *(const GAS v4u*)r, c = *(const GAS v4u*)(r + 2048), h = *(const GAS v4u*)(r + 4096);
            const f32x4 ua = unpack4((u32x2){c.x, c.y}) * unpack4((u32x2){h.x, h.y}), ub = unpack4((u32x2){c.z, c.w}) * unpack4((u32x2){h.z, h.w});
            const f32x4 ya = unpack4((u32x2){b.x, b.y}) * (w0a * u2a + w1a * u1a + w2a * ua), yb = unpack4((u32x2){b.z, b.w}) * (w0b * u2b + w1b * u1b + w2b * ub);
            const u32x2 pa = pack4(ya), pb = pack4(yb);
            *(GAS v4u*)(CV + (size_t)t * 4096 + ch) = (v4u){pa.x, pa.y, pb.x, pb.y};
            u2a = u1a; u2b = u1b; u1a = ua; u1b = ub; }
    }
}

typedef float f32x16 __attribute__((ext_vector_type(16)));
__device__ __forceinline__ float half_max(float v) { v = fmaxf(v, __shfl_xor(v, 1)); v = fmaxf(v, __shfl_xor(v, 2)); v = fmaxf(v, __shfl_xor(v, 4)); v = fmaxf(v, __shfl_xor(v, 8)); v = fmaxf(v, __shfl_xor(v, 16)); return v; }
__device__ __forceinline__ int half_min(int v) { v = min(v, __shfl_xor(v, 1)); v = min(v, __shfl_xor(v, 2)); v = min(v, __shfl_xor(v, 4)); v = min(v, __shfl_xor(v, 8)); v = min(v, __shfl_xor(v, 16)); return v; }
__device__ __forceinline__ void phase8(KP kp, LAS unsigned char* lds, int wave, int bid) {
    const int lane = fresh_lane(), tid = wave * 64 + lane;
    unsigned char* ws = KWS();
    LAS float* A2 = (LAS float*)lds; LAS float* B2 = A2 + 2048;
    LAS float* rs = (LAS float*)(lds + 16384);
    LAS int* eidx = (LAS int*)(lds + 16384 + 128);
    LAS float* part = (LAS float*)(lds + 20480);
    LAS float* lg = (LAS float*)(lds + 56320);
    const float* mod = (const float*)(ws + WS_MOD); const float* n2g = (const float*)KIN(16);
    for (int c = tid; c < 2048; c += 512) { A2[c] = n2g[c] * (1.0f + mod[4 * 2048 + c]); B2[c] = mod[3 * 2048 + c]; }
    __syncthreads();
    const float* X1 = (const float*)(ws + WS_X1); bf16* H = (bf16*)(ws + WS_H); const float* wrt = (const float*)(ws + WS_WRT); const float* br = (const float*)KIN(18);
    int* TOPI = (int*)(ws + WS_TOPI); float* TOPW = (float*)(ws + WS_TOPW);
#pragma unroll 2
    for (int q = 0; q < 4; ++q) {
        const int lt = 4 * wave + q, t = 32 * bid + lt;
        const GAS f32x4* xr = (const GAS f32x4*)(X1 + (size_t)t * DM) + lane;
        f32x4 v[8]; float s = 0.f;
#pragma unroll
        for (int j = 0; j < 8; ++j) { v[j] = xr[64 * j]; s += dot4(v[j], v[j]); }
        const float rstd = 1.0f / sqrtf(wave_sum(s) * (1.0f / DM) + EPS);
        if (lane == 0) rs[lt] = rstd;
        GAS u32x2* o8 = (GAS u32x2*)(H + (size_t)t * DM) + lane;
#pragma unroll
        for (int j = 0; j < 8; ++j) { const f32x4 av = *(const LAS f32x4*)(A2 + 256 * j + 4 * lane), bv = *(const LAS f32x4*)(B2 + 256 * j + 4 * lane);
            o8[64 * j] = pack4(v[j] * rstd * av + bv); }
    }
    __syncthreads();
    {
        const int i = lane & 31, hk = lane >> 5; const float rstd_i = rs[i];
        const float* xrow = X1 + (size_t)(32 * bid + i) * DM + 256 * wave + 16 * hk; const float* wrow = wrt + (size_t)i * DM + 256 * wave + 16 * hk;
        const LAS float* a2p = A2 + 256 * wave + 16 * hk; const LAS float* b2p = B2 + 256 * wave + 16 * hk;
        f32x16 acc = {0.f, 0.f, 0.f, 0.f, 0.f, 0.f, 0.f, 0.f, 0.f, 0.f, 0.f, 0.f, 0.f, 0.f, 0.f, 0.f};
#pragma unroll 2
        for (int kb = 0; kb < 8; ++kb) {
            f32x4 xv[4], wv[4];
#pragma unroll
            for (int q = 0; q < 4; ++q) { xv[q] = *(const GAS f32x4*)(xrow + 32 * kb + 4 * q); wv[q] = *(const GAS f32x4*)(wrow + 32 * kb + 4 * q); }
#pragma unroll
            for (int q = 0; q < 4; ++q) { const f32x4 av = *(const LAS f32x4*)(a2p + 32 * kb + 4 * q), bv = *(const LAS f32x4*)(b2p + 32 * kb + 4 * q); xv[q] = xv[q] * rstd_i * av + bv; }
#pragma unroll
            for (int q = 0; q < 4; ++q) {
                acc = __builtin_amdgcn_mfma_f32_32x32x2f32(xv[q].x, wv[q].x, acc, 0, 0, 0); acc = __builtin_amdgcn_mfma_f32_32x32x2f32(xv[q].y, wv[q].y, acc, 0, 0, 0);
                acc = __builtin_amdgcn_mfma_f32_32x32x2f32(xv[q].z, wv[q].z, acc, 0, 0, 0); acc = __builtin_amdgcn_mfma_f32_32x32x2f32(xv[q].w, wv[q].w, acc, 0, 0, 0); }
        }
#pragma unroll
        for (int r = 0; r < 16; ++r) part[(wave * 32 + (r & 3) + 8 * (r >> 2) + 4 * hk) * 33 + i] = acc[r];
    }
    __syncthreads();
#pragma unroll
    for (int o = tid; o < 1024; o += 512) { const int tok = o >> 5, e = o & 31; float s = br[e];
#pragma unroll
        for (int w = 0; w < 8; ++w) s += part[(w * 32 + tok) * 33 + e];
        lg[tok * 33 + e] = s; }
    __syncthreads();
#pragma unroll
    for (int p = 0; p < 2; ++p) {
        const int tok = 4 * wave + 2 * p + (lane >> 5), e = lane & 31;
        float v = lg[tok * 33 + e]; float tv[4]; int ti[4];
#pragma unroll
        for (int k = 0; k < 4; ++k) { const float m = half_max(v); const int idx = min(half_min(v == m ? e : 64), 31);     tv[k] = m; ti[k] = idx; v = (e == idx) ? -3.0e38f : v; }
        const float p1 = __expf(tv[1] - tv[0]), p2 = __expf(tv[2] - tv[0]), p3 = __expf(tv[3] - tv[0]); const float inv = 1.0f / (1.0f + p1 + p2 + p3);
        if (e == 0) { const int t = 32 * bid + tok;
            *(GAS i32x4*)(TOPI + t * 4) = (i32x4){ti[0], ti[1], ti[2], ti[3]}; *(GAS f32x4*)(TOPW + t * 4) = (f32x4){inv, p1 * inv, p2 * inv, p3 * inv};
            eidx[tok * 4 + 0] = ti[0]; eidx[tok * 4 + 1] = ti[1]; eidx[tok * 4 + 2] = ti[2]; eidx[tok * 4 + 3] = ti[3]; }
    }
    __syncthreads();
    LAS int* cbase = (LAS int*)(lds + 16384 + 1024);
    int rank = 0, em = 0;
    if (tid < 128) { em = eidx[tid]; for (int q = 0; q < tid; ++q) rank += (eidx[q] == em) ? 1 : 0; }
    if (tid < 32) { int cnt = 0; for (int q = 0; q < 128; ++q) cnt += (eidx[q] == tid) ? 1 : 0;
        cbase[tid] = cnt ? __hip_atomic_fetch_add((int*)(ws + WS_ECNT) + 16 * tid, cnt, __ATOMIC_RELAXED, __HIP_MEMORY_SCOPE_AGENT) : 0; }
    __syncthreads();
    if (tid < 128) { const int r = cbase[em] + rank; ((int*)(ws + WS_TRANK))[32 * bid * 4 + tid] = r; ((int*)(ws + WS_STOK))[em * 8192 + r] = 32 * bid + (tid >> 2); }
}

__device__ __forceinline__ void moe_tables(const int* ECNT, LAS unsigned char* lds, int tid) {
    LAS int* totp = (LAS int*)lds;
    LAS int* tile_e = (LAS int*)(lds + TILE_OFF); LAS int* ntl = tile_e + 160; LAS int* pstart = (LAS int*)(lds + TILE_OFF + 1024);
    if (tid < 32) { const int tot = ECNT[16 * tid]; totp[tid] = tot; ((LAS int*)(lds + TILE_OFF + 1280))[tid] = tot; }
    __syncthreads();
    if (tid == 0) { int ps = 0, nt = 0;
        for (int e = 0; e < NE; ++e) { const int c = totp[e]; const int npad = (c + 255) >> 8; pstart[e] = ps; for (int k = 0; k < npad; ++k) { if (nt < 160) tile_e[nt] = e; ++nt; } ps += npad * 256; }
        *ntl = nt < 160 ? nt : 160; }
    __syncthreads();
}

__device__ __forceinline__ void phase12(KP kp, LAS unsigned char* lds, int wave, int bid, int G) {
    const int lane = fresh_lane();
    unsigned char* ws = KWS();
    const float* X1 = (const float*)(ws + WS_X1); const bf16* YS = (const bf16*)(ws + WS_YS); const float* mod = (const float*)(ws + WS_MOD); const float* fg = (const float*)KIN(23);
    const int* TOPI = (const int*)(ws + WS_TOPI); const int* TRANK = (const int*)(ws + WS_TRANK); const float* TOPW = (const float*)(ws + WS_TOPW);
    const LAS int* pstart = (const LAS int*)(lds + TILE_OFF + 1024);
    for (int m = bid * NWAVES + wave; m < T; m += G * NWAVES) {
        const GAS f32x4* xr = (const GAS f32x4*)(X1 + (size_t)m * DM) + lane;
        const i32x4 te = *(const GAS i32x4*)(TOPI + m * 4), rk = *(const GAS i32x4*)(TRANK + m * 4); const f32x4 tw = *(const GAS f32x4*)(TOPW + m * 4);
        const i32x4 sl = (i32x4){pstart[te.x] + rk.x, pstart[te.y] + rk.y, pstart[te.z] + rk.z, pstart[te.w] + rk.w};
        const GAS u32x2* y0 = (const GAS u32x2*)(YS + (size_t)sl.x * DM) + lane; const GAS u32x2* y1 = (const GAS u32x2*)(YS + (size_t)sl.y * DM) + lane;
        const GAS u32x2* y2 = (const GAS u32x2*)(YS + (size_t)sl.z * DM) + lane; const GAS u32x2* y3 = (const GAS u32x2*)(YS + (size_t)sl.w * DM) + lane;
        f32x4 v[8]; float s = 0.f;
#pragma unroll
        for (int j = 0; j < 8; ++j) {
            const f32x4 mo = tw.x * unpack4(y0[64 * j]) + tw.y * unpack4(y1[64 * j]) + tw.z * unpack4(y2[64 * j]) + tw.w * unpack4(y3[64 * j]);
            const f32x4 g2 = *(const GAS f32x4*)(mod + 5 * 2048 + 256 * j + 4 * lane);
            v[j] = xr[64 * j] + g2 * mo; s += dot4(v[j], v[j]); }
        const float rstd = 1.0f / sqrtf(wave_sum(s) * (1.0f / DM) + EPS);
        GAS f32x4* o = (GAS f32x4*)(KOUT() + (size_t)m * DM) + lane;
#pragma unroll
        for (int j = 0; j < 8; ++j) o[64 * j] = v[j] * rstd * *(const GAS f32x4*)(fg + 256 * j + 4 * lane);
    }
}

__device__ __forceinline__ void phase3(KP kp, char* lds, LAS unsigned char* ldsl, int wave, int bid, int G) {
    typedef attn::bf16 abf;
    const int tid = wave * 64 + fresh_lane();
    unsigned char* ws = KWS();
    const abf* Qb = (const abf*)(ws + WS_Q); const abf* Kb = (const abf*)(ws + WS_K); const abf* Vb = (const abf*)(ws + WS_V); abf* OAp = (abf*)(ws + WS_OA);
    for (int L = bid; L < 256; L += G) {
        const int x = L & 7, s = L >> 3, j = 2 * x + (s >> 4), y = s & 15;
#pragma unroll 1
        for (int pass = 0; pass < 2; ++pass) {
            const int qb = (pass ^ (y & 1)) ? y : 31 - y;
            attn3::Blk B; B.Q = Qb + ((size_t)j * T + (size_t)qb * 256) * 128; B.K = Kb + (size_t)j * T * 128;
            B.V0 = Vb + (size_t)((j >> 1) * 2) * T * 128; B.V1 = B.V0 + (size_t)T * 128;
            B.O = OAp + (size_t)(qb * 256) * 4096 + j * 256; B.P0 = qb * 256;
            const int tid_p = wave * 64 + fresh_lane();
            attn3::block(B, lds, ldsl, tid_p);
            if (pass == 0) { conv_run(kargs(), KWS(), (LAS unsigned*)(ldsl + wave * 8320), fresh_lane(), CONV_DENSE_ITEMS + bid * NWAVES + wave, CONV_UP_END, G * NWAVES); __syncthreads(); }
        }
    }
}

__global__ void __launch_bounds__(NWAVES * 64, 2) mk_fwd(Args args) {
    extern __shared__ __attribute__((aligned(16))) unsigned char lds_raw[];
    LAS unsigned char* lds = (LAS unsigned char*)lds_raw;
    volatile LAS unsigned* MISC = (volatile LAS unsigned*)(lds + MISC_OFF);
    const int wave = __builtin_amdgcn_readfirstlane(threadIdx.x >> 6);
    const int G = gridDim.x, bid = blockIdx.x;
    const int lo = ((const __attribute__((address_space(4))) int*)__builtin_amdgcn_kernarg_segment_ptr())[52], hi = ((const __attribute__((address_space(4))) int*)__builtin_amdgcn_kernarg_segment_ptr())[53];
    XcdBarrier bar;
    { KP kp = kargs(); gu32* ctl = (gu32*)(KWS() + WS_CTL);
      const int tid = wave * 64 + fresh_lane();
      for (int u = tid; u < (LDS_BYTES - LDSCTL_OFF) / 4; u += NWAVES * 64) ((LAS unsigned*)(lds + LDSCTL_OFF))[u] = 0u;
      __syncthreads();
      bar.bar = (unsigned*)(ctl + CW_BAR); bar.x = 0; bar.st = nullptr;
      if (hi - lo > 1) bar = xcd_barrier_post((unsigned*)(ctl + CW_BAR), MISC + 8); }
#ifndef PH_MASK
#define PH_MASK 0x1FFF
#endif
#define IN(k) (((PH_MASK >> (k)) & 1) && lo <= (k) && (k) < hi)
#ifndef PH_DUP
#define PH_DUP 0
#endif
#define REP(k) for (int rep_ = 0; rep_ <= ((PH_DUP >> (k)) & 1); ++rep_)
#define REPBAR() do { if (rep_) xcd_barrier(bar, wave * 64 + fresh_lane()); } while (0)
#define NEXTPH(k) ((k) == 5 ? 7 : (k) == 8 ? 10 : (k) + 1)
#define SEAM(k) do { if (IN(k) && IN(NEXTPH(k))) xcd_barrier(bar, wave * 64 + fresh_lane()); } while (0)

    if (IN(0)) { REP(0) { REPBAR(); phase0(kargs(), lds, wave, bid, G); } SEAM(0); }
    if (IN(1)) { REP(1) { REPBAR(); phase1(kargs(), lds, wave, bid, G); } SEAM(1); }
    if (IN(2)) {
        REP(2) { REPBAR();
        KP kp = kargs(); unsigned char* ws = KWS();
        pg8::Gemm g{(const pg8::bf16_t*)(ws + WS_H), (const pg8::bf16_t*)(ws + WS_WIN), T, 16384, 2048, 0, 1};
        pg8::StaticOrder S; S.init(T, 16384, G, bid);
        pg8::EpiInProj E{(pg8::bf16_t*)(ws + WS_Q), (pg8::bf16_t*)(ws + WS_K), (pg8::bf16_t*)(ws + WS_V), (pg8::bf16_t*)(ws + WS_R), (const float*)(ws + WS_ROPE)};
        pg8::gemm_phase<pg8::EpiInProj, pg8::StaticOrder, true, true>(lds + RING_OFF, g, S, E, wave * 64 + fresh_lane());
        }
        SEAM(2);
    }
    if (IN(3)) { REP(3) { REPBAR(); phase3(kargs(), (char*)lds_raw + RING_OFF, lds + RING_OFF, wave, bid, G); } SEAM(3); }
    if (IN(4)) { REP(4) { REPBAR(); phase4(kargs(), wave, bid, G); } SEAM(4); }
    if (IN(5)) {
        REP(5) { REPBAR();
        KP kp = kargs(); unsigned char* ws = KWS();
        pg8::Gemm g{(const pg8::bf16_t*)(ws + WS_ON), (const pg8::bf16_t*)(ws + WS_WAO), T, 2048, 4096, 0, 1};
        pg8::StaticOrder S; S.init(T, 2048, G, bid);
        pg8::EpiMerge2 E{(pg8::bf16_t*)(ws + WS_MG), (const pg8::bf16_t*)(ws + WS_R)};
        pg8::gemm_phase<pg8::EpiMerge2, pg8::StaticOrder, true, true>(lds + RING_OFF, g, S, E, wave * 64 + fresh_lane());
        }
        SEAM(5);
    }
    if (IN(7)) {
        REP(7) { REPBAR();
        KP kp = kargs(); unsigned char* ws = KWS();
        pg8::Gemm g{(const pg8::bf16_t*)(ws + WS_MG), (const pg8::bf16_t*)(ws + WS_WO), T, 2048, 2048, 0, 1};
        pg8::StaticOrder S; S.init(T, 2048, G, bid);
        pg8::EpiResid E{(const float*)KIN(0), (float*)(ws + WS_X1), (const float*)(ws + WS_MOD) + 2 * 2048};
        pg8::gemm_phase<pg8::EpiResid, pg8::StaticOrder, true, true>(lds + RING_OFF, g, S, E, wave * 64 + fresh_lane());
        }
        SEAM(7);
    }
    if (IN(8)) { REP(8) { REPBAR(); phase8(kargs(), lds, wave, bid); } SEAM(8); }
    if (IN(10)) {
        REP(10) { REPBAR();
        KP kp = kargs(); unsigned char* ws = KWS();
        moe_tables((const int*)(ws + WS_ECNT), lds, wave * 64 + fresh_lane());
        const LAS int* tile_e = (const LAS int*)(lds + TILE_OFF); const int nTiles = tile_e[160];
        pg8::Gemm g{(const pg8::bf16_t*)(ws + WS_H), (const pg8::bf16_t*)(ws + WS_WUP), nTiles * 256, 4096, 2048, (size_t)4096 * 2048 * 2, 1};
        pg8::MoeOrder<true> S; S.init(nTiles, 4096, G, bid, tile_e); S.tab = (const LAS int*)(lds + TOKTAB_OFF);
        { const int tid = wave * 64 + fresh_lane(); const int* STOK = (const int*)(ws + WS_STOK); LAS int* tab = (LAS int*)(lds + TOKTAB_OFF);
          const LAS int* pstart = (const LAS int*)(lds + TILE_OFF + 1024); const LAS int* etot = (const LAS int*)(lds + TILE_OFF + 1280);
          for (int i = 0; i < 10; ++i) { pg8::Unit u; if (!S.next(i, u)) break;
              if (tid < 256) { const int rr = u.pm * 256 + tid - pstart[u.e]; const bool valid = rr < etot[u.e]; tab[i * 256 + tid] = valid ? STOK[u.e * 8192 + rr] : 0; } }
          __syncthreads(); }
        pg8::EpiSwiglu E{(pg8::bf16_t*)(ws + WS_ACT), (const float*)KIN(20)};
        const int slot = (bid >> 3) & 7;
        if (slot > 0) { S.i0 = 0; S.imax = slot; pg8::gemm_phase<pg8::EpiSwiglu, pg8::MoeOrder<true>, true, true>(lds + RING_OFF, g, S, E, wave * 64 + fresh_lane()); }
        {
          constexpr int CONV_D = 68; const int nwg = nTiles * 16, rem = nwg - (nwg / G) * G; const long I = CONV_ALL_ITEMS - CONV_UP_END;
          const long Sl = I + (long)CONV_D * rem, Sh = Sl - (long)CONV_D * G;
          const long P0 = bid < rem ? bid * Sh : rem * Sh + (bid - rem) * Sl, P1 = P0 + (bid < rem ? Sh : Sl);
          conv_moe_range(kargs(), lds, wave, CONV_UP_END + (int)(P0 / G), CONV_UP_END + (int)(P1 / G)); }
        S.i0 = slot; S.imax = 1 << 30;
        pg8::gemm_phase<pg8::EpiSwiglu, pg8::MoeOrder<true>, true, true>(lds + RING_OFF, g, S, E, wave * 64 + fresh_lane());
        }
        SEAM(10);
    }
    if (IN(11)) {
        REP(11) { REPBAR();
        KP kp = kargs(); unsigned char* ws = KWS();
        if (!IN(10)) moe_tables((const int*)(ws + WS_ECNT), lds, wave * 64 + fresh_lane());
        const LAS int* tile_e = (const LAS int*)(lds + TILE_OFF); const int nTiles = tile_e[160];
        pg8::Gemm g{(const pg8::bf16_t*)(ws + WS_ACT), (const pg8::bf16_t*)(ws + WS_WDN), nTiles * 256, 2048, 2048, (size_t)2048 * 2048 * 2, 1};
        pg8::MoeOrder<false> S; S.init(nTiles, 2048, G, bid, tile_e);
        pg8::EpiDown E{(pg8::bf16_t*)(ws + WS_YS), (const float*)KIN(22)};
        pg8::gemm_phase<pg8::EpiDown, pg8::MoeOrder<false>, true, true>(lds + RING_OFF, g, S, E, wave * 64 + fresh_lane());
        }
        SEAM(11);
    }
    if (IN(12)) { REP(12) { REPBAR(); if (!IN(11)) { KP kp = kargs(); moe_tables((const int*)(KWS() + WS_ECNT), lds, wave * 64 + fresh_lane()); } phase12(kargs(), lds, wave, bid, G); } }
#undef IN
#undef SEAM
}

extern "C" void kernel_launch(void* const* d_in, const int* in_sizes, int n_in, void* d_out, int out_size, void* d_ws, size_t ws_size, hipStream_t stream) {
    static int grid = 0;
    if (grid == 0) {
        if (n_in != 24 || out_size != T * DM || ws_size < WS_END) { fprintf(stderr, "kernel_launch: unexpected shapes (n_in %d, out %d, ws %zu)\n", n_in, out_size, ws_size); grid = -1; return; }
        if (hipFuncSetAttribute((const void*)mk_fwd, hipFuncAttributeMaxDynamicSharedMemorySize, LDS_BYTES) != hipSuccess) { fprintf(stderr, "kernel_launch: hipFuncSetAttribute failed\n"); grid = -1; return; }
        int per_cu = 0;
        if (hipOccupancyMaxActiveBlocksPerMultiprocessor(&per_cu, (const void*)mk_fwd, NWAVES * 64, LDS_BYTES) != hipSuccess || per_cu < 1) fprintf(stderr, "kernel_launch: occupancy query reports %d\n", per_cu);
        (void)hipGetLastError();
        grid = 256;
    }
    if (grid < 0) return;
    if (hipMemsetAsync((char*)d_ws + WS_CTL, 0, CTL_ZERO_BYTES, stream) != hipSuccess) { fprintf(stderr, "kernel_launch: memset failed\n"); return; }
    Args a{};
    for (int i = 0; i < 24; ++i) a.in[i] = d_in[i];
    a.out = (float*)d_out; a.ws = (unsigned char*)d_ws;
#if MK_ONE_LAUNCH
    a.ph_lo = 0; a.ph_hi = NPHASE; a.li = 0; a.pad = 0;
    hipLaunchKernelGGL(mk_fwd, dim3(grid), dim3(NWAVES * 64), LDS_BYTES, stream, a);
#else
    for (int p = 0; p < NPHASE; ++p) { a.ph_lo = p; a.ph_hi = p + 1; a.li = p; a.pad = 0;
        hipLaunchKernelGGL(mk_fwd, dim3(grid), dim3(NWAVES * 64), LDS_BYTES, stream, a); }
#endif
}
```

```cpp
#include <hip/hip_runtime.h>
#include <hip/hip_bf16.h>
#include <cstdio>
#include <cstdint>
namespace pg8 {
#define PG8_LAS __attribute__((address_space(3)))
typedef unsigned short bf16_t;
typedef short bf16x8 __attribute__((ext_vector_type(8)));
typedef float f32x4 __attribute__((ext_vector_type(4)));
typedef unsigned u32x4 __attribute__((ext_vector_type(4)));
constexpr int BM = 256, BK = 64, HALF = 128, HTB = HALF * BK * 2  , STAGE_BYTES = 8 * HTB, NXCD = 8, WGM = 8;

__host__ __device__ __forceinline__ int lds_byte(int r, int c) { const int st = (r >> 4) * 2 + (c >> 5), rr = r & 15, cc = c & 31, ob = rr * 64 + cc * 2; return st * 1024 + (ob ^ (((ob >> 9) & 1) << 5)); }
__host__ __device__ __forceinline__ void stage_rc(int b, int& R, int& C) { const int st = b / 1024, sb = b % 1024, swz = sb ^ (((sb >> 9) & 1) << 5); R = (st >> 1) * 16 + swz / 64; C = (st & 1) * 32 + (swz % 64) / 2; }
__host__ __device__ __forceinline__ int perm32(int rho) { const int n = rho >> 4, i = rho & 15; return 8 * (i >> 2) + 4 * n + (i & 3); }

struct Unit { int pm, pn, e; };
struct Gemm { const bf16_t* A; const bf16_t* Bt; int M, N, K; size_t estride; int btiled; };

struct StaticOrder {
    int nM, nN, nwg, G, c, i0 = 0, imax = 1 << 30;
    __host__ __device__ void init(int M, int N, int G_, int c_) { nM = M / BM; nN = N / BM; nwg = nM * nN; G = G_; c = c_; }
    __host__ __device__ bool next(int i, Unit& u) const {
        if (i + i0 >= imax) return false; const long L = (long)(i + i0) * G + c; if (L >= nwg) return false;
        int wgid = (int)L; { const int q = nwg / NXCD, r = nwg % NXCD, xcd = wgid % NXCD, off = wgid / NXCD; wgid = (xcd < r ? xcd * (q + 1) : r * (q + 1) + (xcd - r) * q) + off; }
        const int nig = WGM * nN, gid = wgid / nig, fm = gid * WGM, gsz = (nM - fm) < WGM ? (nM - fm) : WGM;
        u.pm = fm + ((wgid % nig) % gsz); u.pn = (wgid % nig) / gsz; u.e = 0; return true;
    }
    static constexpr bool GATHER = false;
    __device__ __forceinline__ int row_tok(int, int) const { return 0; }
    __device__ __forceinline__ void a_ready(const Unit&) const {}
    __device__ __forceinline__ void done(const Unit&) const {}
};


typedef unsigned u32x2 __attribute__((ext_vector_type(2)));
constexpr int T_ROWS = 8192, R_LD = 10240;
__device__ __forceinline__ unsigned cvt_pk_bf16(float lo, float hi) { unsigned r; asm volatile("v_cvt_pk_bf16_f32 %0, %1, %2" : "=v"(r) : "v"(lo), "v"(hi)); return r; }
__device__ __forceinline__ u32x2 pk4(f32x4 v) { u32x2 w; w.x = cvt_pk_bf16(v[0], v[1]); w.y = cvt_pk_bf16(v[2], v[3]); return w; }
__device__ __forceinline__ float bf_lo(unsigned w) { return __uint_as_float(w << 16); }
__device__ __forceinline__ float bf_hi(unsigned w) { return __uint_as_float(w & 0xffff0000u); }
__device__ __forceinline__ float sigm(float x) { return __builtin_amdgcn_rcpf(1.0f + __expf(-x)); }
__device__ __forceinline__ f32x4 sig4(u32x2 g) { return (f32x4){sigm(bf_lo(g.x)), sigm(bf_hi(g.x)), sigm(bf_lo(g.y)), sigm(bf_hi(g.y))}; }

struct EpiInProj {
    static constexpr bool PERM = true, AFTER_DRAIN = false, HAS_MID = false;
    bf16_t* Q; bf16_t* K; bf16_t* V; bf16_t* R; const float* rope;
    __device__ __forceinline__ void operator()(const f32x4 (&acc)[2][2][4][2], const Unit& u, int wr, int wc, int fr, int fq) const {
        const int row0 = u.pm * BM + wr * 64 + fr; const int pn = u.pn;
        if (pn < 16) {
            bf16_t* base = (pn < 8) ? Q : K; const int hp = (pn & 7) * 2; const float sgn = (fq >= 2) ? 1.0f : -1.0f;
#pragma unroll
            for (int ai = 0; ai < 2; ++ai)
#pragma unroll
                for (int m = 0; m < 4; ++m) { const int row = row0 + ai * HALF + m * 16;
                    f32x4 cs0 = (f32x4){1.f, 1.f, 1.f, 1.f}, cs1 = cs0, sn0 = (f32x4){0.f, 0.f, 0.f, 0.f}, sn1 = sn0;
                    if (wc == 0) { const float* rp = rope + (size_t)row * 32 + 8 * (fq & 1); cs0 = *(const f32x4*)rp; cs1 = *(const f32x4*)(rp + 4); sn0 = *(const f32x4*)(rp + 16) * sgn; sn1 = *(const f32x4*)(rp + 20) * sgn; }
#pragma unroll
                    for (int bj = 0; bj < 2; ++bj) { f32x4 v0 = acc[ai][bj][m][0], v1 = acc[ai][bj][m][1];
                        if (wc == 0) { f32x4 p0, p1;
#pragma unroll
                            for (int i = 0; i < 4; ++i) { p0[i] = __shfl_xor(v0[i], 32); p1[i] = __shfl_xor(v1[i], 32); }
                            v0 = v0 * cs0 + p0 * sn0; v1 = v1 * cs1 + p1 * sn1; }
                        u32x4 w; w.x = cvt_pk_bf16(v0[0], v0[1]); w.y = cvt_pk_bf16(v0[2], v0[3]); w.z = cvt_pk_bf16(v1[0], v1[1]); w.w = cvt_pk_bf16(v1[2], v1[3]);
                        *(u32x4*)(base + ((size_t)(hp + bj) * T_ROWS + row) * 128 + wc * 32 + 8 * fq) = w; } }
        } else if (pn < 24) {
            const int hv = (pn - 16) * 2;
#pragma unroll
            for (int ai = 0; ai < 2; ++ai)
#pragma unroll
                for (int m = 0; m < 4; ++m) { const int row = row0 + ai * HALF + m * 16;
#pragma unroll
                    for (int bj = 0; bj < 2; ++bj) { const f32x4 v0 = acc[ai][bj][m][0], v1 = acc[ai][bj][m][1];
                        u32x4 w; w.x = cvt_pk_bf16(v0[0], v0[1]); w.y = cvt_pk_bf16(v0[2], v0[3]); w.z = cvt_pk_bf16(v1[0], v1[1]); w.w = cvt_pk_bf16(v1[2], v1[3]);
                        *(u32x4*)(V + ((size_t)(hv + bj) * T_ROWS + row) * 128 + wc * 32 + 8 * fq) = w; } }
        } else {
            const int col0 = (pn - 24) * BM + wc * 32 + 8 * fq;
#pragma unroll
            for (int ai = 0; ai < 2; ++ai)
#pragma unroll
                for (int m = 0; m < 4; ++m) { const int row = row0 + ai * HALF + m * 16;
#pragma unroll
                    for (int bj = 0; bj < 2; ++bj) { const f32x4 v0 = acc[ai][bj][m][0], v1 = acc[ai][bj][m][1];
                        u32x4 w; w.x = cvt_pk_bf16(v0[0], v0[1]); w.y = cvt_pk_bf16(v0[2], v0[3]); w.z = cvt_pk_bf16(v1[0], v1[1]); w.w = cvt_pk_bf16(v1[2], v1[3]);
                        *(u32x4*)(R + (size_t)row * R_LD + col0 + bj * HALF) = w; } }
        }
    }
};
struct EpiGate {
    static constexpr bool PERM = false, AFTER_DRAIN = false, HAS_MID = false;
    float* C; const bf16_t* G;
    __device__ __forceinline__ void operator()(const f32x4 (&acc)[2][2][4][2], const Unit& u, int wr, int wc, int fr, int fq) const {
        const int row0 = u.pm * BM + wr * 64 + fr, col0 = u.pn * BM + wc * 32 + 4 * fq;
#pragma unroll
        for (int ai = 0; ai < 2; ++ai)
#pragma unroll
            for (int m = 0; m < 4; ++m) { const int row = row0 + ai * HALF + m * 16;
#pragma unroll
                for (int bj = 0; bj < 2; ++bj)
#pragma unroll
                    for (int n = 0; n < 2; ++n) { const int col = col0 + bj * HALF + n * 16;
                        const u32x2 g = *(const u32x2*)(G + (size_t)row * R_LD + col);
                        *(f32x4*)(C + (size_t)row * 2048 + col) = acc[ai][bj][m][n] * sig4(g); } }
    }
};
struct EpiMerge {
    static constexpr bool PERM = false, AFTER_DRAIN = false, HAS_MID = false;
    const float* Tm; bf16_t* O; const bf16_t* G;
    __device__ __forceinline__ void operator()(const f32x4 (&acc)[2][2][4][2], const Unit& u, int wr, int wc, int fr, int fq) const {
        const int row0 = u.pm * BM + wr * 64 + fr, col0 = u.pn * BM + wc * 32 + 4 * fq;
#pragma unroll
        for (int ai = 0; ai < 2; ++ai)
#pragma unroll
            for (int m = 0; m < 4; ++m) { const int row = row0 + ai * HALF + m * 16;
#pragma unroll
                for (int bj = 0; bj < 2; ++bj)
#pragma unroll
                    for (int n = 0; n < 2; ++n) { const int col = col0 + bj * HALF + n * 16;
                        const u32x2 g = *(const u32x2*)(G + (size_t)row * R_LD + col);
                        const f32x4 tv = *(const f32x4*)(Tm + (size_t)row * 2048 + col);
                        *(u32x2*)(O + (size_t)row * 2048 + col) = pk4(tv + acc[ai][bj][m][n] * sig4(g)); } }
    }
};
struct EpiMerge2 {
    static constexpr bool PERM = true, AFTER_DRAIN = false, HAS_MID = true;
    bf16_t* O; const bf16_t* R;
    static __device__ __forceinline__ float ex(float x) { return __expf(fminf(-x, 60.f)); }
    __device__ __forceinline__ void mid(f32x4 (&acc)[2][2][4][2], const Unit& u, int wr, int wc, int fr, int fq) const {
        const int row0 = u.pm * BM + wr * 64 + fr, col0 = u.pn * BM + wc * 32 + 8 * fq;
        const bf16_t* rp0 = R + (size_t)row0 * R_LD + col0;
#pragma unroll
        for (int ai = 0; ai < 2; ++ai)
#pragma unroll
            for (int m = 0; m < 4; ++m) {
                int off = (ai * HALF + m * 16) * R_LD; asm volatile("" : "+s"(off) :: "memory");
                const bf16_t* rp = rp0 + off;
#pragma unroll
                for (int bj = 0; bj < 2; ++bj) {
                    const u32x4 ga = *(const u32x4*)(rp + 6144 + bj * HALF), gc = *(const u32x4*)(rp + 8192 + bj * HALF);
                    f32x4 r0, r1;
                    r0[0] = (1.0f + ex(bf_lo(gc.x))) * __builtin_amdgcn_rcpf(1.0f + ex(bf_lo(ga.x))); r0[1] = (1.0f + ex(bf_hi(gc.x))) * __builtin_amdgcn_rcpf(1.0f + ex(bf_hi(ga.x)));
                    r0[2] = (1.0f + ex(bf_lo(gc.y))) * __builtin_amdgcn_rcpf(1.0f + ex(bf_lo(ga.y))); r0[3] = (1.0f + ex(bf_hi(gc.y))) * __builtin_amdgcn_rcpf(1.0f + ex(bf_hi(ga.y)));
                    r1[0] = (1.0f + ex(bf_lo(gc.z))) * __builtin_amdgcn_rcpf(1.0f + ex(bf_lo(ga.z))); r1[1] = (1.0f + ex(bf_hi(gc.z))) * __builtin_amdgcn_rcpf(1.0f + ex(bf_hi(ga.z)));
                    r1[2] = (1.0f + ex(bf_lo(gc.w))) * __builtin_amdgcn_rcpf(1.0f + ex(bf_lo(ga.w))); r1[3] = (1.0f + ex(bf_hi(gc.w))) * __builtin_amdgcn_rcpf(1.0f + ex(bf_hi(ga.w)));
                    acc[ai][bj][m][0] *= r0; acc[ai][bj][m][1] *= r1; }
                asm volatile("" : "+v"(acc[ai][0][m][0]), "+v"(acc[ai][0][m][1]), "+v"(acc[ai][1][m][0]), "+v"(acc[ai][1][m][1]) :: "memory"); }
    }
    __device__ __forceinline__ void operator()(const f32x4 (&acc)[2][2][4][2], const Unit& u, int wr, int wc, int fr, int fq) const {
        const int row0 = u.pm * BM + wr * 64 + fr, col0 = u.pn * BM + wc * 32 + 8 * fq;
#pragma unroll
        for (int ai = 0; ai < 2; ++ai)
#pragma unroll
            for (int m = 0; m < 4; ++m) { const int row = row0 + ai * HALF + m * 16;
#pragma unroll
                for (int bj = 0; bj < 2; ++bj) { const int col = col0 + bj * HALF;
                    const u32x4 gc = *(const u32x4*)(R + (size_t)row * R_LD + 8192 + col);
                    f32x4 s0, s1;
                    s0[0] = __builtin_amdgcn_rcpf(1.0f + ex(bf_lo(gc.x))); s0[1] = __builtin_amdgcn_rcpf(1.0f + ex(bf_hi(gc.x))); s0[2] = __builtin_amdgcn_rcpf(1.0f + ex(bf_lo(gc.y))); s0[3] = __builtin_amdgcn_rcpf(1.0f + ex(bf_hi(gc.y)));
                    s1[0] = __builtin_amdgcn_rcpf(1.0f + ex(bf_lo(gc.z))); s1[1] = __builtin_amdgcn_rcpf(1.0f + ex(bf_hi(gc.z))); s1[2] = __builtin_amdgcn_rcpf(1.0f + ex(bf_lo(gc.w))); s1[3] = __builtin_amdgcn_rcpf(1.0f + ex(bf_hi(gc.w)));
                    const f32x4 v0 = acc[ai][bj][m][0] * s0, v1 = acc[ai][bj][m][1] * s1;
                    u32x4 w; w.x = cvt_pk_bf16(v0[0], v0[1]); w.y = cvt_pk_bf16(v0[2], v0[3]); w.z = cvt_pk_bf16(v1[0], v1[1]); w.w = cvt_pk_bf16(v1[2], v1[3]);
                    *(u32x4*)(O + (size_t)row * 2048 + col) = w; } }
    }
};
struct EpiResid {
    static constexpr bool PERM = false, AFTER_DRAIN = false, HAS_MID = false;
    const float* X; float* O; const float* gate;
    __device__ __forceinline__ void operator()(const f32x4 (&acc)[2][2][4][2], const Unit& u, int wr, int wc, int fr, int fq) const {
        const int row0 = u.pm * BM + wr * 64 + fr, col0 = u.pn * BM + wc * 32 + 4 * fq;
        f32x4 gv[2][2];
#pragma unroll
        for (int bj = 0; bj < 2; ++bj)
#pragma unroll
            for (int n = 0; n < 2; ++n) gv[bj][n] = *(const f32x4*)(gate + col0 + bj * HALF + n * 16);
#pragma unroll
        for (int ai = 0; ai < 2; ++ai)
#pragma unroll
            for (int m = 0; m < 4; ++m) { const int row = row0 + ai * HALF + m * 16;
#pragma unroll
                for (int bj = 0; bj < 2; ++bj)
#pragma unroll
                    for (int n = 0; n < 2; ++n) { const size_t off = (size_t)row * 2048 + col0 + bj * HALF + n * 16;
                        *(f32x4*)(O + off) = *(const f32x4*)(X + off) + gv[bj][n] * acc[ai][bj][m][n]; } }
    }
};
__device__ __forceinline__ float swiglu1(float g, float l) { g = fminf(g, 7.0f); l = fminf(fmaxf(l, -7.0f), 7.0f); return g * sigm(1.702f * g) * (l + 1.0f); }
struct EpiSwiglu {
    static constexpr bool PERM = true, AFTER_DRAIN = false, HAS_MID = false;
    bf16_t* O; const float* bias;
    __device__ __forceinline__ void operator()(const f32x4 (&acc)[2][2][4][2], const Unit& u, int wr, int wc, int fr, int fq) const {
        const int row0 = u.pm * BM + wr * 64 + fr, col0 = u.pn * BM + wc * 32 + 8 * fq; const float* bb = bias + (size_t)u.e * 4096;
        f32x4 bv[2][2];
#pragma unroll
        for (int bj = 0; bj < 2; ++bj)
#pragma unroll
            for (int n = 0; n < 2; ++n) bv[bj][n] = *(const f32x4*)(bb + col0 + bj * HALF + 4 * n);
#pragma unroll
        for (int ai = 0; ai < 2; ++ai)
#pragma unroll
            for (int m = 0; m < 4; ++m) { const int row = row0 + ai * HALF + m * 16;
#pragma unroll
                for (int bj = 0; bj < 2; ++bj) { const f32x4 v0 = acc[ai][bj][m][0] + bv[bj][0], v1 = acc[ai][bj][m][1] + bv[bj][1];
                    u32x2 w; w.x = cvt_pk_bf16(swiglu1(v0[0], v0[1]), swiglu1(v0[2], v0[3])); w.y = cvt_pk_bf16(swiglu1(v1[0], v1[1]), swiglu1(v1[2], v1[3]));
                    *(u32x2*)(O + (size_t)row * 2048 + ((col0 + bj * HALF) >> 1)) = w; } }
    }
};
struct EpiDown {
    static constexpr bool PERM = true, AFTER_DRAIN = false, HAS_MID = false;
    bf16_t* O; const float* bias;
    __device__ __forceinline__ void operator()(const f32x4 (&acc)[2][2][4][2], const Unit& u, int wr, int wc, int fr, int fq) const {
        const int row0 = u.pm * BM + wr * 64 + fr, col0 = u.pn * BM + wc * 32 + 8 * fq; const float* bb = bias + (size_t)u.e * 2048;
        f32x4 bv[2][2];
#pragma unroll
        for (int bj = 0; bj < 2; ++bj)
#pragma unroll
            for (int n = 0; n < 2; ++n) bv[bj][n] = *(const f32x4*)(bb + col0 + bj * HALF + 4 * n);
#pragma unroll
        for (int ai = 0; ai < 2; ++ai)
#pragma unroll
            for (int m = 0; m < 4; ++m) { const int row = row0 + ai * HALF + m * 16;
#pragma unroll
                for (int bj = 0; bj < 2; ++bj) { const f32x4 v0 = acc[ai][bj][m][0] + bv[bj][0], v1 = acc[ai][bj][m][1] + bv[bj][1];
                    u32x4 w; w.x = cvt_pk_bf16(v0[0], v0[1]); w.y = cvt_pk_bf16(v0[2], v0[3]); w.z = cvt_pk_bf16(v1[0], v1[1]); w.w = cvt_pk_bf16(v1[2], v1[3]);
                    *(u32x4*)(O + (size_t)row * 2048 + col0 + bj * HALF) = w; } }
    }
};
template <bool GATHER_> struct MoeOrder {
    static constexpr bool GATHER = GATHER_;
    int nM, nN, nwg, G, c, i0 = 0, imax = 1 << 30; const PG8_LAS int* tile_e; const PG8_LAS int* tab = nullptr;
    __device__ __forceinline__ int row_tok(int ui, int r) const { return tab[(ui + i0) * 256 + r]; }
    __device__ __forceinline__ void init(int nTiles, int N, int G_, int c_, const PG8_LAS int* te) { nM = nTiles; nN = N / BM; nwg = nM * nN; G = G_; c = c_; tile_e = te; }
    __device__ __forceinline__ bool next(int i, Unit& u) const {
        if (i + i0 >= imax) return false; const long L = (long)(i + i0) * G + c; if (L >= nwg) return false;
        int wgid = (int)L; { const int q = nwg / NXCD, r = nwg % NXCD, xcd = wgid % NXCD, off = wgid / NXCD; wgid = (xcd < r ? xcd * (q + 1) : r * (q + 1) + (xcd - r) * q) + off; }
        const int tq = wgid / nN, e = tile_e[tq], ft = tile_e[256 + e] >> 8, gsz = (tile_e[320 + e] + 255) >> 8, idx = wgid - ft * nN;
        u.pm = ft + idx % gsz; u.pn = idx / gsz; u.e = e; return true;
    }
    __device__ __forceinline__ void a_ready(const Unit&) const {}
    __device__ __forceinline__ void done(const Unit&) const {}
};
template <class Epi, class Sched, bool ALIGN_EPI = false, bool SP2 = false>
__device__ __forceinline__ void gemm_phase(PG8_LAS unsigned char* lds, const Gemm g, const Sched& S, const Epi& E, const int tid_in) {
    const int tid = tid_in, wid = __builtin_amdgcn_readfirstlane(tid >> 6), lane = tid & 63, wr = wid >> 2, wc = wid & 3, fr = lane & 15, fq = lane >> 4;
    const int K = g.K, nt = K / BK, LDB = g.btiled ? 64 : K;
    unsigned voffA[2], voffB[2]; unsigned vc[2][2] = {{0u, 0u}, {0u, 0u}}, vn[2][2] = {{0u, 0u}, {0u, 0u}}; int gR[2], gC[2];
#pragma unroll
    for (int i = 0; i < 2; ++i) { int R, C; stage_rc(tid * 16 + i * 8192, R, C); const int Rb = Epi::PERM ? ((R & ~31) + perm32(R & 31)) : R;
        voffA[i] = (unsigned)(R * K + C) * 2u; voffB[i] = (unsigned)(Rb * LDB + C) * 2u; gR[i] = R; gC[i] = C * 2; }
    const size_t kstep = (size_t)(BK * 2);
    const size_t hstep = (size_t)HALF * K * 2;
    const size_t tstep = 2 * hstep; const size_t kstepB = g.btiled ? (size_t)32768 : kstep, hstepB = g.btiled ? (size_t)16384 : hstep;
    const unsigned ldsw = (unsigned)wid * 1024u;
    const int aoff = lds_byte(wr * 64 + fr, fq * 8), boff = lds_byte(wc * 32 + fr, fq * 8);
#define PG8_SA(b, h) (((b) * 2 + (h)) * HTB)
#define PG8_SB(b, h) ((4 + (b) * 2 + (h)) * HTB)
#define PG8_STAGE(bufoff, gbase, voff) do { _Pragma("unroll") for (int _i = 0; _i < 2; ++_i) \
        __builtin_amdgcn_global_load_lds((const unsigned*)((const char*)(gbase) + (voff)[_i]), (PG8_LAS unsigned*)(lds + (bufoff) + ldsw + _i * 8192), 16, 0, 0); } while (0)
#define PG8_STAGE_A(bufoff, base, h, isnext) do { if constexpr (Sched::GATHER) { unsigned vv_[2] = {(isnext) ? vn[h][0] : vc[h][0], (isnext) ? vn[h][1] : vc[h][1]}; PG8_STAGE(bufoff, base, vv_); } else { PG8_STAGE(bufoff, (base) + (h) * hstep, voffA); } } while (0)
#define PG8_GFILL(dst, uidx) do { _Pragma("unroll") for (int h_ = 0; h_ < 2; ++h_) _Pragma("unroll") for (int i_ = 0; i_ < 2; ++i_) dst[h_][i_] = (unsigned)S.row_tok((uidx), h_ * HALF + gR[i_]) * (unsigned)(K * 2) + (unsigned)gC[i_]; } while (0)
#define PG8_LDA(dst, b, h) do { _Pragma("unroll") for (int m = 0; m < 4; ++m) _Pragma("unroll") for (int k = 0; k < 2; ++k) dst[m][k] = *(const PG8_LAS bf16x8*)(lds + PG8_SA(b, h) + aoff + m * 2048 + k * 1024); } while (0)
#define PG8_LDB(dst, b, h) do { _Pragma("unroll") for (int n = 0; n < 2; ++n) _Pragma("unroll") for (int k = 0; k < 2; ++k) dst[n][k] = *(const PG8_LAS bf16x8*)(lds + PG8_SB(b, h) + boff + n * 2048 + k * 1024); } while (0)
#define PG8_MMA(ai, bj, At, Bt) do { __builtin_amdgcn_s_setprio(1); _Pragma("unroll") for (int m = 0; m < 4; ++m) _Pragma("unroll") for (int n = 0; n < 2; ++n) _Pragma("unroll") for (int k = 0; k < 2; ++k) \
        acc[ai][bj][m][n] = __builtin_amdgcn_mfma_f32_16x16x32_bf16(Bt[n][k], At[m][k], acc[ai][bj][m][n], 0, 0, 0); __builtin_amdgcn_s_setprio(0); } while (0)
#define PG8_WAIT_V(n) asm volatile("s_waitcnt vmcnt(" #n ")" ::: "memory")
#define PG8_WAIT_L(n) asm volatile("s_waitcnt lgkmcnt(" #n ")" ::: "memory")
#define PG8_BAR __builtin_amdgcn_s_barrier()
#define PG8_SCHED __builtin_amdgcn_sched_barrier(0)
    Unit cur, nxt; int ui = 0;
    if (!S.next(0, cur)) return;
    f32x4 acc[2][2][4][2];
#pragma unroll
    for (int a = 0; a < 2; ++a)
#pragma unroll
        for (int b = 0; b < 2; ++b)
#pragma unroll
            for (int m = 0; m < 4; ++m)
#pragma unroll
                for (int n = 0; n < 2; ++n) acc[a][b][m][n] = (f32x4){0.f, 0.f, 0.f, 0.f};
    bf16x8 At[4][2], B0[2][2], B1[2][2];
    const char* cA = (const char*)g.A + (Sched::GATHER ? (size_t)0 : (size_t)cur.pm * tstep); if constexpr (Sched::GATHER) PG8_GFILL(vc, 0); const char* cB = (const char*)g.Bt + (size_t)cur.pn * tstep + (size_t)cur.e * g.estride;
    S.a_ready(cur);
    if constexpr (SP2) {
        PG8_STAGE(PG8_SB(0, 0), cB, voffB); PG8_STAGE(PG8_SB(0, 1), cB + hstepB, voffB); PG8_STAGE_A(PG8_SA(0, 0), cA, 0, false); PG8_STAGE_A(PG8_SA(0, 1), cA, 1, false);
        if (wr == 1) PG8_BAR;
        PG8_WAIT_V(2); PG8_BAR;
        PG8_STAGE(PG8_SB(1, 0), cB + kstepB, voffB); PG8_STAGE_A(PG8_SA(1, 0), cA + kstep, 0, false); PG8_STAGE(PG8_SB(1, 1), cB + hstepB + kstepB, voffB);
        PG8_WAIT_V(6); PG8_BAR;
    } else {
        PG8_STAGE(PG8_SB(0, 0), cB, voffB); PG8_STAGE_A(PG8_SA(0, 0), cA, 0, false); PG8_STAGE(PG8_SB(0, 1), cB + hstepB, voffB); PG8_STAGE_A(PG8_SA(0, 1), cA, 1, false);
        if (wr == 1) PG8_BAR;
        PG8_WAIT_V(4); PG8_BAR;
        PG8_STAGE(PG8_SB(1, 0), cB + kstepB, voffB); PG8_STAGE_A(PG8_SA(1, 0), cA + kstep, 0, false); PG8_STAGE(PG8_SB(1, 1), cB + hstepB + kstepB, voffB);
        PG8_WAIT_V(6); PG8_BAR;
    }
    for (;;) {
        const bool has_next = S.next(ui + 1, nxt);
        const char* nA = (has_next && !Sched::GATHER) ? (const char*)g.A + (size_t)nxt.pm * tstep : cA; if constexpr (Sched::GATHER) { if (has_next) PG8_GFILL(vn, ui + 1); else { vn[0][0] = vc[0][0]; vn[0][1] = vc[0][1]; vn[1][0] = vc[1][0]; vn[1][1] = vc[1][1]; } } const char* nB = has_next ? (const char*)g.Bt + (size_t)nxt.pn * tstep + (size_t)nxt.e * g.estride : cB;
        for (int seg = 0; seg < (Epi::HAS_MID ? 2 : 1); ++seg) {
        if constexpr (Epi::HAS_MID) { if (seg == 1) E.mid(acc, cur, wr, wc, fr, fq); }
        for (int t = (Epi::HAS_MID && seg == 1) ? nt / 2 : 0; t < ((Epi::HAS_MID && seg == 0) ? nt / 2 : nt); t += 2) {
            const bool last = (t == nt - 2);
            const char* a1 = cA + (size_t)(t + 1) * kstep;
            const char* a2 = last ? nA : cA + (size_t)(t + 2) * kstep; const char* b2 = last ? nB : cB + (size_t)(t + 2) * kstepB;
            const char* a3 = a2 + kstep; const char* b3 = b2 + kstepB;
            if (last && has_next) S.a_ready(nxt);
            if constexpr (SP2) {
            PG8_LDB(B0, 0, 0); PG8_LDB(B1, 0, 1); PG8_SCHED; PG8_LDA(At, 0, 0); PG8_STAGE_A(PG8_SA(1, 1), a1, 1, false);
            PG8_WAIT_V(8); PG8_WAIT_L(0); PG8_BAR; PG8_MMA(0, 0, At, B0); PG8_MMA(0, 1, At, B1); PG8_BAR; PG8_SCHED;
            PG8_LDA(At, 0, 1); PG8_STAGE(PG8_SB(0, 0), b2, voffB); PG8_STAGE(PG8_SB(0, 1), b2 + hstepB, voffB); PG8_STAGE_A(PG8_SA(0, 0), a2, 0, last);
            PG8_WAIT_V(8); PG8_WAIT_L(0); PG8_BAR; PG8_MMA(1, 0, At, B0); PG8_MMA(1, 1, At, B1); PG8_BAR; PG8_SCHED;
            PG8_LDB(B0, 1, 0); PG8_LDB(B1, 1, 1); PG8_SCHED; PG8_LDA(At, 1, 0); PG8_STAGE_A(PG8_SA(0, 1), a2, 1, last);
            PG8_WAIT_V(8); PG8_WAIT_L(0); PG8_BAR; PG8_MMA(0, 0, At, B0); PG8_MMA(0, 1, At, B1); PG8_BAR; PG8_SCHED;
            PG8_LDA(At, 1, 1); PG8_STAGE(PG8_SB(1, 0), b3, voffB); PG8_STAGE(PG8_SB(1, 1), b3 + hstepB, voffB); PG8_STAGE_A(PG8_SA(1, 0), a3, 0, last);
            PG8_WAIT_V(8); PG8_WAIT_L(0); PG8_BAR; PG8_MMA(1, 0, At, B0); PG8_MMA(1, 1, At, B1); PG8_BAR; PG8_SCHED;
            } else {
            PG8_LDB(B0, 0, 0); PG8_SCHED; PG8_LDA(At, 0, 0); PG8_STAGE_A(PG8_SA(1, 1), a1, 1, false);
            PG8_WAIT_L(8); PG8_BAR; PG8_WAIT_L(0); PG8_MMA(0, 0, At, B0); PG8_BAR; PG8_SCHED;
            PG8_LDB(B1, 0, 1); PG8_STAGE(PG8_SB(0, 0), b2, voffB);
            PG8_BAR; PG8_WAIT_L(0); PG8_MMA(0, 1, At, B1); PG8_BAR;
            PG8_LDA(At, 0, 1); PG8_STAGE_A(PG8_SA(0, 0), a2, 0, last);
            PG8_BAR; PG8_WAIT_L(0); PG8_MMA(1, 0, At, B0); PG8_BAR; PG8_SCHED;
            PG8_STAGE(PG8_SB(0, 1), b2 + hstepB, voffB);
            PG8_WAIT_V(6); PG8_BAR; PG8_MMA(1, 1, At, B1); PG8_BAR;
            PG8_LDB(B0, 1, 0); PG8_SCHED; PG8_LDA(At, 1, 0); PG8_STAGE_A(PG8_SA(0, 1), a2, 1, last);
            PG8_WAIT_L(8); PG8_BAR; PG8_WAIT_L(0); PG8_MMA(0, 0, At, B0); PG8_BAR; PG8_SCHED;
            PG8_LDB(B1, 1, 1); PG8_STAGE(PG8_SB(1, 0), b3, voffB);
            PG8_BAR; PG8_WAIT_L(0); PG8_MMA(0, 1, At, B1); PG8_BAR;
            PG8_LDA(At, 1, 1); PG8_STAGE_A(PG8_SA(1, 0), a3, 0, last);
            PG8_BAR; PG8_WAIT_L(0); PG8_MMA(1, 0, At, B0); PG8_BAR; PG8_SCHED;
            PG8_STAGE(PG8_SB(1, 1), b3 + hstepB, voffB);
            PG8_WAIT_V(6); PG8_BAR; PG8_MMA(1, 1, At, B1); PG8_BAR;
            }
        }
        }
        if constexpr (ALIGN_EPI) { if (wr == 0) PG8_BAR; }
        if constexpr (!Epi::AFTER_DRAIN) { E(acc, cur, wr, wc, fr, fq); S.done(cur); }
        if (!has_next) break;
#pragma unroll
        for (int a = 0; a < 2; ++a)
#pragma unroll
            for (int b = 0; b < 2; ++b)
#pragma unroll
                for (int m = 0; m < 4; ++m)
#pragma unroll
                    for (int n = 0; n < 2; ++n) acc[a][b][m][n] = (f32x4){0.f, 0.f, 0.f, 0.f};
        cur = nxt; cA = nA; cB = nB; ++ui; if constexpr (Sched::GATHER) { vc[0][0] = vn[0][0]; vc[0][1] = vn[0][1]; vc[1][0] = vn[1][0]; vc[1][1] = vn[1][1]; }
        if constexpr (ALIGN_EPI) { if (wr == 1) PG8_BAR; }
    }
    PG8_WAIT_V(0);
    if constexpr (!ALIGN_EPI) { if (wr == 0) PG8_BAR; }
    PG8_BAR;
    if constexpr (Epi::AFTER_DRAIN) { E.fused(acc, cur, wr, wc, fr, fq, lds, wid, lane); S.done(cur); }
#undef PG8_SA
#undef PG8_SB
#undef PG8_STAGE
#undef PG8_STAGE_A
#undef PG8_GFILL
#undef PG8_LDA
#undef PG8_LDB
#undef PG8_MMA
#undef PG8_WAIT_V
#undef PG8_WAIT_L
#undef PG8_BAR
#undef PG8_SCHED
}
}

namespace attn {
constexpr int D = 128; constexpr float THR = 8.f; constexpr bool WSKIP = false; constexpr int LDO = 4096;
constexpr float SCALE = 0.08838834764831845f;
constexpr int NW = 8, QBLK = 32, KVBLK = 64, QB = NW * QBLK;
constexpr int SHM_V = KVBLK * D * 2, SHM_K = KVBLK * D * 2;
constexpr int LDS_BYTES = 2 * SHM_V + 2 * SHM_K + NW * 64 * 4;
static_assert(D == 128, "geometry");

using bf16 = __hip_bfloat16;
typedef short bf16x8 __attribute__((ext_vector_type(8)));
typedef short s16x4 __attribute__((ext_vector_type(4)));
typedef float f32x16 __attribute__((ext_vector_type(16)));
typedef float f32x4 __attribute__((ext_vector_type(4)));
typedef unsigned u32x4 __attribute__((ext_vector_type(4)));
template <class A, class Bt> struct same_t { static constexpr bool v = false; };
template <class A> struct same_t<A, A> { static constexpr bool v = true; };

#define KSWZ(row, colB) ((row) * 256 + ((colB) ^ (((row) & 7) << 4)))
#define SBAR() __builtin_amdgcn_sched_barrier(0)
__device__ __forceinline__ int v_st(int k, int c) { const int kk = (k & ~0xC) | ((k & 4) << 1) | ((k & 8) >> 1); return ((kk >> 3) * 4 + (c >> 5)) * 512 + ((kk & 7) * 32 + (c & 31)) * 2; }
__device__ __forceinline__ int v_rd_base(int lane) { return ((lane & 3) << 3) | (((lane >> 2) & 3) << 6) | (((lane >> 4) & 1) << 5) | (((lane >> 5) & 1) << 8); }
constexpr int v_rd_off(int d0, int ks, int half) { return d0 * 512 + ks * 4096 + half * 2048; }
__device__ __forceinline__ int crow(int r, int hi) { return (r & 3) + 8 * (r >> 2) + 4 * hi; }
__device__ __forceinline__ unsigned cvtpk(float lo, float hi) {
    unsigned r; asm volatile("v_cvt_pk_bf16_f32 %0, %1, %2" : "=v"(r) : "v"(lo), "v"(hi)); return r;
}
__device__ __forceinline__ bf16x8 pack8(f32x4 a, f32x4 b) {
    u32x4 w = {cvtpk(a[0], a[1]), cvtpk(a[2], a[3]), cvtpk(b[0], b[1]), cvtpk(b[2], b[3])};
    return *reinterpret_cast<bf16x8*>(&w);
}
template <class T> __device__ __forceinline__ bf16x8 load8(const T* p) {
    if constexpr (same_t<T, float>::v) { return pack8(*(const f32x4*)p, *(const f32x4*)(p + 4)); }
    else { return *reinterpret_cast<const bf16x8*>(p); }
}
__device__ __forceinline__ void mask_tile(f32x16& p0, f32x16& p1, int dq, unsigned W) {
    const float NEG = -__builtin_inff();
#pragma unroll
    for (int r = 0; r < 16; ++r) {
        const int c = (r & 3) + 8 * (r >> 2);
        if ((unsigned)(dq - c) >= W) p0[r] = NEG;
        if ((unsigned)(dq - c - 32) >= W) p1[r] = NEG;
    }
}
__device__ __forceinline__ void partialSM(f32x16& p0, f32x16& p1, float& m_reg, float& mn, float& alpha) {
    float pmax = p0[0]; for (int r = 1; r < 16; ++r) pmax = fmaxf(pmax, p0[r]); for (int r = 0; r < 16; ++r) pmax = fmaxf(pmax, p1[r]);
    { auto rr = __builtin_amdgcn_permlane32_swap(__float_as_uint(pmax), __float_as_uint(pmax), false, false);
      pmax = fmaxf(__uint_as_float(rr[0]), __uint_as_float(rr[1])); }
    constexpr float C2 = 1.4426950408889634f * SCALE;
    if (__builtin_expect(__all((pmax - m_reg) * SCALE <= THR), 1)) { mn = m_reg; alpha = 1.f; }
    else { mn = fmaxf(m_reg, pmax); alpha = __builtin_amdgcn_exp2f((m_reg - mn) * C2); m_reg = mn; }
    const float mnL = -mn * C2;
    for (int r = 0; r < 16; ++r) p0[r] = fmaf(p0[r], C2, mnL); for (int r = 0; r < 16; ++r) p1[r] = fmaf(p1[r], C2, mnL);
    for (int r = 0; r < 16; ++r) p0[r] = __builtin_amdgcn_exp2f(p0[r]);
}
__device__ __forceinline__ void finishSM(f32x16& p0, f32x16& p1, float alpha, float& l_reg, bf16x8& pa0, bf16x8& pa1, bf16x8& pa2, bf16x8& pa3) {
    for (int r = 0; r < 16; ++r) p1[r] = __builtin_amdgcn_exp2f(p1[r]);
    float ps = 0; for (int r = 0; r < 16; ++r) ps += p0[r]; for (int r = 0; r < 16; ++r) ps += p1[r];
    { auto rr = __builtin_amdgcn_permlane32_swap(__float_as_uint(ps), __float_as_uint(ps), false, false);
      ps = __uint_as_float(rr[0]) + __uint_as_float(rr[1]); }
    l_reg = l_reg * alpha + ps;
#define PK4(P, B_, OUT) do { unsigned a0 = cvtpk(P[B_+0], P[B_+1]), a1 = cvtpk(P[B_+2], P[B_+3]);                          \
        unsigned b0 = cvtpk(P[B_+4], P[B_+5]), b1 = cvtpk(P[B_+6], P[B_+7]);                                             \
        auto r0 = __builtin_amdgcn_permlane32_swap(a0, b0, false, false); auto r1 = __builtin_amdgcn_permlane32_swap(a1, b1, false, false); \
        u32x4 w = {r0[0], r1[0], r0[1], r1[1]}; OUT = *reinterpret_cast<bf16x8*>(&w); } while (0)
    PK4(p0, 0, pa0); PK4(p0, 8, pa1); PK4(p1, 0, pa2); PK4(p1, 8, pa3);
#undef PK4
}
template <int KB, bool SK>
__device__ __forceinline__ void qkt(f32x16& p0, f32x16& p1, const char* K_lds, int r32, int hi, const bf16x8* qr, bool act) {
    if (SK && !act) { const float NEG = -__builtin_inff();
#pragma unroll
        for (int r = 0; r < 16; ++r) { p0[r] = NEG; p1[r] = NEG; } return; }
    p0 = f32x16{}; p1 = f32x16{};
    const char* kb[4];
#pragma unroll
    for (int dd = 0; dd < 4; ++dd) kb[dd] = K_lds + KB * SHM_K + KSWZ(r32, (dd * 16 + hi * 8) * 2);
#pragma unroll
    for (int d0 = 0; d0 < 8; ++d0) { const char* a = kb[d0 & 3] + (d0 >> 2) * 128;
        bf16x8 b0 = *reinterpret_cast<const bf16x8*>(a);
        bf16x8 b1 = *reinterpret_cast<const bf16x8*>(a + 32 * 256);
        p0 = __builtin_amdgcn_mfma_f32_32x32x16_bf16(b0, qr[d0], p0, 0, 0, 0);
        p1 = __builtin_amdgcn_mfma_f32_32x32x16_bf16(b1, qr[d0], p1, 0, 0, 0); }
}
template <int VB, bool SK>
__device__ __forceinline__ void pv_tile(f32x16* o, int vb0, bf16x8 pa0, bf16x8 pa1, bf16x8 pa2, bf16x8 pa3, bool act) {
    if (SK && !act) return;
#define TRRD(dst, off) asm volatile("ds_read_b64_tr_b16 %0, %1 offset:%2" : "=&v"(dst) : "v"(vb0), "i"(off) : "memory")
#define PV_D0(d0) do { s16x4 l0, l1, l2, l3, h0, h1, h2, h3; constexpr int b_ = VB * SHM_V + v_rd_off(d0, 0, 0);     \
        TRRD(l0, b_); TRRD(h0, b_ + 2048); TRRD(l1, b_ + 4096); TRRD(h1, b_ + 6144); TRRD(l2, b_ + 8192); TRRD(h2, b_ + 10240); TRRD(l3, b_ + 12288); TRRD(h3, b_ + 14336); \
        asm volatile("s_waitcnt lgkmcnt(0)" ::: "memory"); SBAR();                 \
        o[d0] = __builtin_amdgcn_mfma_f32_32x32x16_bf16(pa0, (bf16x8){l0[0], l0[1], l0[2], l0[3], h0[0], h0[1], h0[2], h0[3]}, o[d0], 0, 0, 0);   \
        o[d0] = __builtin_amdgcn_mfma_f32_32x32x16_bf16(pa1, (bf16x8){l1[0], l1[1], l1[2], l1[3], h1[0], h1[1], h1[2], h1[3]}, o[d0], 0, 0, 0);   \
        o[d0] = __builtin_amdgcn_mfma_f32_32x32x16_bf16(pa2, (bf16x8){l2[0], l2[1], l2[2], l2[3], h2[0], h2[1], h2[2], h2[3]}, o[d0], 0, 0, 0);   \
        o[d0] = __builtin_amdgcn_mfma_f32_32x32x16_bf16(pa3, (bf16x8){l3[0], l3[1], l3[2], l3[3], h3[0], h3[1], h3[2], h3[3]}, o[d0], 0, 0, 0); } while (0)
    PV_D0(0); PV_D0(1); PV_D0(2); PV_D0(3);
#undef PV_D0
#undef TRRD
}

template <class TIn, class TOut> struct BlockRef { const TIn* Q; const TIn* K; const TIn* V; TOut* O; int P0; };
template <class TIn> struct Seam {
    bf16x8 qr[8];
    bf16x8 st_v0, st_v1, st_k0, st_k1; f32x4 sf0, sf1, sf2, sf3;
    f32x4 tq[16];
};
__device__ __forceinline__ int swa_jlo(int P0, int W) { const int lowk = P0 - W + 1; return lowk > 0 ? lowk / KVBLK : 0; }
#define ROW(p, k0, rr) ((p) + (size_t)((k0) + (rr)) * D + sc)
#define VMW() asm volatile("s_waitcnt vmcnt(0)" ::: "memory")
#define VMWN(n) asm volatile("s_waitcnt vmcnt(%0)" :: "i"(n) : "memory")
#define SLOAD_H(Kp, Vp, k0) do { S.st_v0 = load8<TIn>(ROW(Vp, k0, sr)); S.st_v1 = load8<TIn>(ROW(Vp, k0, 32 + sr));              \
                         S.st_k0 = load8<TIn>(ROW(Kp, k0, sr)); S.st_k1 = load8<TIn>(ROW(Kp, k0, 32 + sr)); } while (0)
#define SWRITE_HK(bf) do { *(bf16x8*)(K_lds + (bf) * SHM_K + kws) = S.st_k0; *(bf16x8*)(K_lds + (bf) * SHM_K + kws + 32 * 256) = S.st_k1; } while (0)
#define SWRITE_HV(bf) do { *(bf16x8*)(V_lds + (bf) * SHM_V + vst0) = S.st_v0; *(bf16x8*)(V_lds + (bf) * SHM_V + vst1) = S.st_v1; } while (0)
#define SWRITE_H(bf) do { SWRITE_HV(bf); SWRITE_HK(bf); } while (0)
#define SLOAD_F(p, k0) do { S.sf0 = *(const f32x4*)ROW(p, k0, sr); S.sf1 = *(const f32x4*)(ROW(p, k0, sr) + 4);                \
                            S.sf2 = *(const f32x4*)ROW(p, k0, 32 + sr); S.sf3 = *(const f32x4*)(ROW(p, k0, 32 + sr) + 4); } while (0)
#define SWRITE_KF(bf) do { *(bf16x8*)(K_lds + (bf) * SHM_K + kws) = pack8(S.sf0, S.sf1); *(bf16x8*)(K_lds + (bf) * SHM_K + kws + 32 * 256) = pack8(S.sf2, S.sf3); } while (0)
#define SWRITE_VF(bf) do { *(bf16x8*)(V_lds + (bf) * SHM_V + vst0) = pack8(S.sf0, S.sf1); *(bf16x8*)(V_lds + (bf) * SHM_V + vst1) = pack8(S.sf2, S.sf3); } while (0)
template <class TIn, class TOut>
__device__ __forceinline__ void causal_swa_prime(const BlockRef<TIn, TOut>& cur, int W, char* lds, Seam<TIn>& S, const int tid_in) {
    constexpr bool F32 = same_t<TIn, float>::v;
    const int tid = tid_in, wid = __builtin_amdgcn_readfirstlane(tid >> 6), lane = tid & 63, r32 = lane & 31, hi = lane >> 5;
    const int sr = tid >> 4, sc = (tid & 15) * 8, kws = KSWZ(sr, sc * 2); char* K_lds = lds + 2 * SHM_V;
    const int kb0 = swa_jlo(cur.P0, W) * KVBLK;
    for (int d0 = 0; d0 < 8; ++d0) S.qr[d0] = load8<TIn>(cur.Q + (size_t)(wid * QBLK + r32) * D + d0 * 16 + hi * 8);
    if constexpr (F32) { SLOAD_F((const float*)cur.K, kb0); VMW(); SWRITE_KF(0); SBAR(); SLOAD_F((const float*)cur.V, kb0); }
    else { SLOAD_H(cur.K, cur.V, kb0); VMW(); SWRITE_HK(0); }
    __syncthreads();
}
template <class TIn, class TOut>
__device__ __forceinline__ void causal_swa_block(const BlockRef<TIn, TOut>& cur, const BlockRef<TIn, TOut>& nxt, int skv, int W, char* lds, Seam<TIn>& S, const int tid_in) {
    constexpr bool F32 = same_t<TIn, float>::v;
    const int tid = tid_in, wid = __builtin_amdgcn_readfirstlane(tid >> 6), lane = tid & 63, r32 = lane & 31, hi = lane >> 5;
    const int j_lo = swa_jlo(cur.P0, W);
    int j_hi = (cur.P0 + QB - 1) / KVBLK + 1; if (j_hi > skv / KVBLK) j_hi = skv / KVBLK;
    const int NT = j_hi - j_lo;
    const int kbn = swa_jlo(nxt.P0, W) * KVBLK;
    const int qlo = cur.P0 + wid * QBLK, qm = qlo + r32 - 4 * hi;
    char* V_lds = lds; char* K_lds = lds + 2 * SHM_V;
    float* ws = (float*)(lds + 2 * SHM_V + 2 * SHM_K) + wid * 64; float* li_l = ws, * al_l = ws + 32;
    float m_reg = -1e30f, l_reg = 0; f32x16 o[4] = {};
    const int sr = tid >> 4, sc = (tid & 15) * 8, vst0 = v_st(sr, sc), vst1 = v_st(32 + sr, sc), kws = KSWZ(sr, sc * 2);
    const int vb0 = (int)(uintptr_t)V_lds + v_rd_base(lane);
    const TIn* Kh = cur.K; const TIn* Vh = cur.V;
#define RESC(a) do { if (__any((a) < 1.f)) { if (hi == 0) al_l[r32] = (a); asm volatile("s_waitcnt lgkmcnt(0)" ::: "memory");              \
                     for (int d_ = 0; d_ < 4; ++d_) for (int r = 0; r < 16; ++r) o[d_][r] *= al_l[crow(r, hi)]; } } while (0)
#define KBASE(t) ((j_lo + (t)) * KVBLK)
#define ACT(t) (KBASE(t) <= qlo + QBLK - 1 && KBASE(t) + KVBLK - 1 >= qlo - W + 1)
#define MASKT(P0_, P1_, t) do { const int kb_ = KBASE(t); if ((!SK || ACT(t)) && (kb_ + KVBLK - 1 > qlo || kb_ <= qlo + QBLK - 1 - W)) mask_tile(P0_, P1_, qm - kb_, (unsigned)W); } while (0)
    constexpr int NQL = F32 ? 16 : 8;
    constexpr bool SK = WSKIP && !F32;
#define SEAM_K0() do { VMWN(NQL); if constexpr (F32) { SWRITE_KF(0); SBAR(); SLOAD_F((const float*)nxt.V, kbn); } else { SWRITE_HK(0); } SBAR(); } while (0)
    f32x16 pA0, pA1, pB0, pB1; float mnA, mnB, alA, alB; bf16x8 pa0, pa1, pa2, pa3;
    if constexpr (F32) { VMW(); SWRITE_VF(0); SBAR(); } else { SWRITE_HV(0); SBAR(); }
    if (NT > 1) { if constexpr (F32) SLOAD_F((const float*)Kh, KBASE(1)); else SLOAD_H(Kh, Vh, KBASE(1)); }
    SBAR(); qkt<0, SK>(pA0, pA1, K_lds, r32, hi, S.qr, ACT(0));
    if constexpr (F32) { if (NT > 1) { VMW(); SWRITE_KF(1); SBAR(); SLOAD_F((const float*)Vh, KBASE(1)); } }
    MASKT(pA0, pA1, 0); partialSM(pA0, pA1, m_reg, mnA, alA);
    if (NT > 1) { VMW(); if constexpr (F32) { SWRITE_VF(1); SBAR(); if (NT > 2) SLOAD_F((const float*)Kh, KBASE(2)); } else SWRITE_H(1); }
    __syncthreads();
#define HALF_STEP(PX0, PX1, mnX, alX, PY0, PY1, alY, t, KB, VB, SB) do {                                                      \
        SBAR(); qkt<KB, SK>(PX0, PX1, K_lds, r32, hi, S.qr, ACT(t));                                             \
        finishSM(PY0, PY1, alY, l_reg, pa0, pa1, pa2, pa3); SBAR();                                                           \
        if ((t) + 1 < NT) { if constexpr (F32) { VMW(); SWRITE_KF(SB); SBAR(); SLOAD_F((const float*)Vh, KBASE((t) + 1)); }  \
                            else { SLOAD_H(Kh, Vh, KBASE((t) + 1)); } SBAR(); }                                               \
        pv_tile<VB, SK>(o, vb0, pa0, pa1, pa2, pa3, ACT((t) - 1)); MASKT(PX0, PX1, (t)); partialSM(PX0, PX1, m_reg, mnX, alX);                                        \
        __syncthreads();                                                                                                      \
        if ((t) + 1 < NT) { VMW(); if constexpr (F32) { SWRITE_VF(SB); SBAR(); if ((t) + 2 < NT) SLOAD_F((const float*)Kh, KBASE((t) + 2)); } \
                            else { SWRITE_H(SB); } }                                                                          \
        RESC(alX); __syncthreads(); } while (0)
    for (int t = 1; t + 1 < NT; t += 2) {
        HALF_STEP(pB0, pB1, mnB, alB, pA0, pA1, alA, t, 1, 0, 0);
        HALF_STEP(pA0, pA1, mnA, alA, pB0, pB1, alB, t + 1, 0, 1, 1);
    }
    const bool even = (NT & 1) == 0;
    if (even) { SBAR(); qkt<1, SK>(pB0, pB1, K_lds, r32, hi, S.qr, ACT(NT - 1)); SBAR(); }
#define QROW(e) (nxt.Q + (size_t)(wid * QBLK + r32) * D + ((e) >> 1) * 16 + hi * 8 + ((e) & 1) * 4)
    if constexpr (F32) { SLOAD_F((const float*)nxt.K, kbn); SBAR();
#pragma unroll
        for (int e = 0; e < 8; ++e) S.tq[e] = *(const f32x4*)QROW(e); }
    else { SLOAD_H(nxt.K, nxt.V, kbn); SBAR();
#pragma unroll
        for (int d0 = 0; d0 < 8; ++d0) S.qr[d0] = load8<TIn>(nxt.Q + (size_t)(wid * QBLK + r32) * D + d0 * 16 + hi * 8); }
    SBAR();
    finishSM(pA0, pA1, alA, l_reg, pa0, pa1, pa2, pa3); SBAR();
    if constexpr (F32) {
#pragma unroll
        for (int e = 8; e < 16; ++e) S.tq[e] = *(const f32x4*)QROW(e); SBAR(); }
#undef QROW
    pv_tile<0, SK>(o, vb0, pa0, pa1, pa2, pa3, ACT(even ? NT - 2 : NT - 1));
    if (even) { MASKT(pB0, pB1, NT - 1); partialSM(pB0, pB1, m_reg, mnB, alB); __syncthreads(); RESC(alB);
        finishSM(pB0, pB1, alB, l_reg, pa0, pa1, pa2, pa3); SBAR(); pv_tile<1, SK>(o, vb0, pa0, pa1, pa2, pa3, ACT(NT - 1)); }
    SBAR(); SEAM_K0();
    if (hi == 0) li_l[r32] = l_reg; asm volatile("s_waitcnt lgkmcnt(0)" ::: "memory");
    float rli[16];
#pragma unroll
    for (int r = 0; r < 16; ++r) rli[r] = __builtin_amdgcn_rcpf(li_l[crow(r, hi)]);
    TOut* Ow = cur.O + (size_t)(wid * QBLK) * LDO;
#pragma unroll
    for (int r = 0; r < 16; ++r) { const int orow = crow(r, hi);
#pragma unroll
        for (int d0 = 0; d0 < 4; ++d0) { const float v = o[d0][r] * rli[r];
            if constexpr (same_t<TOut, float>::v) { Ow[(size_t)orow * LDO + d0 * 32 + r32] = v; }
            else { const float vn = __shfl_xor(v, 1);
                   if ((r32 & 1) == 0) *(unsigned*)(Ow + (size_t)orow * LDO + d0 * 32 + r32) = cvtpk(v, vn); } } }
    if constexpr (F32) {
#pragma unroll
        for (int d0 = 0; d0 < 8; ++d0) S.qr[d0] = pack8(S.tq[2 * d0], S.tq[2 * d0 + 1]); }
    __syncthreads();
#undef RESC
#undef KBASE
#undef ACT
#undef MASKT
#undef SEAM_K0
#undef HALF_STEP
}
#undef ROW
#undef VMW
#undef VMWN
#undef SLOAD_H
#undef SWRITE_HK
#undef SWRITE_HV
#undef SWRITE_H
#undef SLOAD_F
#undef SWRITE_KF
#undef SWRITE_VF


}

namespace attn2 {
typedef float f32x2v __attribute__((ext_vector_type(2))); typedef attn::f32x4 f32x4; typedef attn::bf16 abf; typedef attn::bf16x8 bf16x8; typedef attn::f32x16 f32x16; typedef attn::u32x4 u32x4; typedef attn::s16x4 s16x4;
constexpr int KOFF = 0, VOFF = 32768, XOFF = 98304, XWAVE = 6656, XBUF = 4 * XWAVE, SCOFF = XOFF + 2 * XBUF, LDS_BYTES = SCOFF + 8 * 256;
static_assert(LDS_BYTES <= 157696, "attention LDS");
constexpr int QB2 = 128, LDO = 4096;
struct Blk { const abf* Q; const abf* K; const abf* V0; const abf* V1; abf* O; int P0; };
#define A2_TRRD(dst, vb, off) asm volatile("ds_read_b64_tr_b16 %0, %1 offset:%2" : "=&v"(dst) : "v"(vb), "i"(off) : "memory")
#define A2_FR(L, H) ((bf16x8){L[0], L[1], L[2], L[3], H[0], H[1], H[2], H[3]})
#define A2_RDK(vb, d0, s) do { A2_TRRD(xl##s, vb, (d0) * 512 + (s) * 4096); A2_TRRD(xh##s, vb, (d0) * 512 + (s) * 4096 + 2048); A2_TRRD(yl##s, vb, ((d0) + 1) * 512 + (s) * 4096); A2_TRRD(yh##s, vb, ((d0) + 1) * 512 + (s) * 4096 + 2048); } while (0)
#define A2_STEPK(accx, accy, pa, s, NEXT) do { asm volatile("s_waitcnt lgkmcnt(12)" ::: "memory"); __builtin_amdgcn_sched_barrier(0); \
        accx = __builtin_amdgcn_mfma_f32_32x32x16_bf16(pa, A2_FR(xl##s, xh##s), accx, 0, 0, 0); accy = __builtin_amdgcn_mfma_f32_32x32x16_bf16(pa, A2_FR(yl##s, yh##s), accy, 0, 0, 0); \
        __builtin_amdgcn_sched_barrier(0); NEXT; __builtin_amdgcn_sched_barrier(0); } while (0)
#define A2_PAIR(accx, accy, NEXT0, NEXT1, NEXT2, NEXT3) do { A2_STEPK(accx, accy, pa0, 0, NEXT0); A2_STEPK(accx, accy, pa1, 1, NEXT1); A2_STEPK(accx, accy, pa2, 2, NEXT2); A2_STEPK(accx, accy, pa3, 3, NEXT3); } while (0)
#define A2_NONE do { asm volatile("s_waitcnt lgkmcnt(0)" ::: "memory"); } while (0)
__device__ __forceinline__ void pv256(f32x16* o, int vb0, bf16x8 pa0, bf16x8 pa1, bf16x8 pa2, bf16x8 pa3) {
    s16x4 xl0, xh0, xl1, xh1, xl2, xh2, xl3, xh3, yl0, yh0, yl1, yh1, yl2, yh2, yl3, yh3;
    const int va = vb0, vb = vb0 + 16384;
    asm volatile("s_waitcnt lgkmcnt(0)" ::: "memory");
    A2_RDK(va, 0, 0); A2_RDK(va, 0, 1); A2_RDK(va, 0, 2); A2_RDK(va, 0, 3);
    A2_PAIR(o[0], o[1], A2_RDK(va, 2, 0), A2_RDK(va, 2, 1), A2_RDK(va, 2, 2), A2_RDK(va, 2, 3));
    A2_PAIR(o[2], o[3], A2_RDK(vb, 0, 0), A2_RDK(vb, 0, 1), A2_RDK(vb, 0, 2), A2_RDK(vb, 0, 3));
    A2_PAIR(o[4], o[5], A2_RDK(vb, 2, 0), A2_RDK(vb, 2, 1), A2_RDK(vb, 2, 2), A2_RDK(vb, 2, 3));
    A2_PAIR(o[6], o[7], A2_NONE, A2_NONE, A2_NONE, A2_NONE);
}
#undef A2_TRRD
#undef A2_FR
#undef A2_RDK
#undef A2_STEPK
#undef A2_PAIR
#undef A2_NONE
__device__ __forceinline__ void pack_half(const f32x16& P, bf16x8& outA, bf16x8& outB) {
#define A2_PK4(B_, OUT) do { unsigned a0 = attn::cvtpk(P[B_ + 0], P[B_ + 1]), a1 = attn::cvtpk(P[B_ + 2], P[B_ + 3]); unsigned b0 = attn::cvtpk(P[B_ + 4], P[B_ + 5]), b1 = attn::cvtpk(P[B_ + 6], P[B_ + 7]); \
        auto r0 = __builtin_amdgcn_permlane32_swap(a0, b0, false, false); auto r1 = __builtin_amdgcn_permlane32_swap(a1, b1, false, false); \
        u32x4 w = {r0[0], r1[0], r0[1], r1[1]}; OUT = *reinterpret_cast<bf16x8*>(&w); } while (0)
    A2_PK4(0, outA); A2_PK4(8, outB);
#undef A2_PK4
}
__device__ __forceinline__ float half_rowsum(const f32x16& P) {
    float ps = ((P[0] + P[1]) + (P[2] + P[3])) + ((P[4] + P[5]) + (P[6] + P[7])) + (((P[8] + P[9]) + (P[10] + P[11])) + ((P[12] + P[13]) + (P[14] + P[15])));
    auto rr = __builtin_amdgcn_permlane32_swap(__float_as_uint(ps), __float_as_uint(ps), false, false);
    return __uint_as_float(rr[0]) + __uint_as_float(rr[1]);
}
__device__ __forceinline__ void block(const Blk& B, char* lds, const int tid) {
    const int wid = __builtin_amdgcn_readfirstlane(tid >> 6), lane = tid & 63, r32 = lane & 31, hi = lane >> 5;
    const bool isA = wid < 4; const int wa = wid & 3;
    const int NT = (B.P0 + QB2) / 64;
    char* K_lds = lds + KOFF; char* V_lds = lds + VOFF;
    char* X_l = lds + XOFF + wa * XWAVE;
    float* sc_l = (float*)(lds + SCOFF) + wid * 64;
    const int t2 = tid & 255, sr = t2 >> 4, sc = (t2 & 15) * 8;
    const int kws = KSWZ(sr, sc * 2), vst = attn::v_st(sr, sc);
    const unsigned goff = (unsigned)(sr * 128 + sc) * 2u;
#define A2_LD(base, rowbytes, i) (*(const bf16x8*)((const char*)(base) + (size_t)(rowbytes) + (size_t)(gof_ + (unsigned)(i) * 4096u)))
#define A2_FRESH() unsigned gof_ = goff; asm volatile("" : "+v"(gof_))
    const int vb0 = (int)(uintptr_t)V_lds + attn::v_rd_base(lane);
    const int qlo = B.P0 + wa * 32, qm = qlo + r32 - 4 * hi;
    constexpr float C2 = 1.4426950408889634f * attn::SCALE;
    if (isA) {
        float m_reg = -1e30f, l_reg = 0.f; bf16x8 qr[8]; bf16x8 st[4];
#pragma unroll
        for (int d0 = 0; d0 < 8; ++d0) qr[d0] = attn::load8<abf>(B.Q + (size_t)(wa * 32 + r32) * 128 + d0 * 16 + hi * 8);
        { A2_FRESH();
#pragma unroll
        for (int i = 0; i < 4; ++i) st[i] = A2_LD(B.K, 0, i); }
        asm volatile("s_waitcnt vmcnt(0)" ::: "memory");
#pragma unroll
        for (int i = 0; i < 4; ++i) *(bf16x8*)(K_lds + kws + i * 4096) = st[i];
        { A2_FRESH();
#pragma unroll
        for (int i = 0; i < 4; ++i) st[i] = A2_LD(B.K, 64 * 256, i); }
        asm volatile("s_waitcnt vmcnt(0)" ::: "memory");
#pragma unroll
        for (int i = 0; i < 4; ++i) *(bf16x8*)(K_lds + 16384 + kws + i * 4096) = st[i];
        __syncthreads();
        f32x16 p0, p1;
        attn::qkt<0, false>(p0, p1, K_lds, r32, hi, qr, true);
        for (int t = 0; t <= NT; ++t) {
            if (t < NT) {
                const int buf = t & 1, kb = t * 64; const bool more2 = t + 2 < NT;
                if (more2) { A2_FRESH();
#pragma unroll
                    for (int i = 0; i < 4; ++i) st[i] = A2_LD(B.K, (kb + 128) * 256, i);
                }
                if (kb + 63 > qlo) attn::mask_tile(p0, p1, qm - kb, 0x7fffffffu);
                f32x16 n0, n1;
                attn::qkt<0, false>(n0, n1, K_lds + (buf ^ 1) * 16384, r32, hi, qr, true);
                float pmax = fmaxf(p0[0], p1[0]);
#pragma unroll
                for (int r = 1; r < 16; ++r) pmax = fmaxf(pmax, fmaxf(p0[r], p1[r]));
                { auto rr = __builtin_amdgcn_permlane32_swap(__float_as_uint(pmax), __float_as_uint(pmax), false, false); pmax = fmaxf(__uint_as_float(rr[0]), __uint_as_float(rr[1])); }
                const bool keep = __all((pmax - m_reg) * attn::SCALE <= attn::THR);
                const float mn = keep ? m_reg : fmaxf(m_reg, pmax); const float alpha = __builtin_amdgcn_exp2f((m_reg - mn) * C2); m_reg = mn;
                const float mnL = -mn * C2;
                char* xl = X_l + buf * XBUF;
                *(f32x4*)(xl + lane * 16) = (f32x4){p1[0], p1[1], p1[2], p1[3]}; *(f32x4*)(xl + 1024 + lane * 16) = (f32x4){p1[4], p1[5], p1[6], p1[7]};
                *(f32x4*)(xl + 2048 + lane * 16) = (f32x4){p1[8], p1[9], p1[10], p1[11]}; *(f32x4*)(xl + 3072 + lane * 16) = (f32x4){p1[12], p1[13], p1[14], p1[15]};
                *(f32x2v*)(xl + 6144 + lane * 8) = (f32x2v){mnL, alpha};
#pragma unroll
                for (int r = 0; r < 16; ++r) p0[r] = __builtin_amdgcn_exp2f(fmaf(p0[r], C2, mnL));
                l_reg = l_reg * alpha + half_rowsum(p0);
                bf16x8 pa0, pa1; pack_half(p0, pa0, pa1);
                *(bf16x8*)(xl + 4096 + lane * 16) = pa0; *(bf16x8*)(xl + 5120 + lane * 16) = pa1;
                if (more2) {
                    asm volatile("s_waitcnt vmcnt(0)" ::: "memory");
#pragma unroll
                    for (int i = 0; i < 4; ++i) *(bf16x8*)(K_lds + buf * 16384 + kws + i * 4096) = st[i];
                }
                p0 = n0; p1 = n1;
            }
            __syncthreads();
        }
        *(float*)(X_l + 6144 + lane * 8) = l_reg;
        __syncthreads();
        __syncthreads();
    } else {
        f32x16 o[8] = {}; bf16x8 st[8]; float l_reg = 0.f;
        __syncthreads();
        for (int t = 0; t <= NT; ++t) {
            if (t < NT) { A2_FRESH();
#pragma unroll
                for (int i = 0; i < 4; ++i) { st[i] = A2_LD(B.V0, t * 64 * 256, i); st[4 + i] = A2_LD(B.V1, t * 64 * 256, i); }
            }
            if (t >= 1) {
                const int pb = (t - 1) & 1;
                const char* xl = X_l + pb * XBUF;
                f32x16 p1;
                { const f32x4 a = *(const f32x4*)(xl + lane * 16), b = *(const f32x4*)(xl + 1024 + lane * 16), c = *(const f32x4*)(xl + 2048 + lane * 16), d = *(const f32x4*)(xl + 3072 + lane * 16);
                  p1 = (f32x16){a[0], a[1], a[2], a[3], b[0], b[1], b[2], b[3], c[0], c[1], c[2], c[3], d[0], d[1], d[2], d[3]}; }
                const f32x2v ma = *(const f32x2v*)(xl + 6144 + lane * 8);
                const float mnL = ma.x, alpha = ma.y;
#pragma unroll
                for (int r = 0; r < 16; ++r) p1[r] = __builtin_amdgcn_exp2f(fmaf(p1[r], C2, mnL));
                l_reg = l_reg * alpha + half_rowsum(p1);
                bf16x8 pa2, pa3; pack_half(p1, pa2, pa3);
                const bf16x8 pa0 = *(const bf16x8*)(xl + 4096 + lane * 16), pa1 = *(const bf16x8*)(xl + 5120 + lane * 16);
                if (__any(alpha < 1.f)) {
                    if (hi == 0) sc_l[r32] = alpha;
                    asm volatile("s_waitcnt lgkmcnt(0)" ::: "memory");
                    float a16[16];
#pragma unroll
                    for (int r = 0; r < 16; ++r) a16[r] = sc_l[attn::crow(r, hi)];
#pragma unroll
                    for (int d0 = 0; d0 < 8; ++d0)
#pragma unroll
                        for (int r = 0; r < 16; ++r) o[d0][r] *= a16[r];
                }
                pv256(o, vb0 + pb * 32768, pa0, pa1, pa2, pa3);
            }
            if (t < NT) {
                asm volatile("s_waitcnt vmcnt(0)" ::: "memory");
                char* vd = V_lds + (t & 1) * 32768 + vst;
#pragma unroll
                for (int i = 0; i < 4; ++i) { *(bf16x8*)(vd + i * 4096) = st[i]; *(bf16x8*)(vd + 16384 + i * 4096) = st[4 + i]; }
            }
            __syncthreads();
        }
        __syncthreads();
        l_reg += *(const float*)(X_l + 6144 + lane * 8);
        if (hi == 0) sc_l[32 + r32] = l_reg;
        asm volatile("s_waitcnt lgkmcnt(0)" ::: "memory");
        float rli[16];
#pragma unroll
        for (int r = 0; r < 16; ++r) rli[r] = __builtin_amdgcn_rcpf(sc_l[32 + attn::crow(r, hi)]);
        abf* Ow = B.O + (size_t)(wa * 32) * LDO;
#pragma unroll
        for (int r = 0; r < 16; ++r) { const int orow = attn::crow(r, hi);
#pragma unroll
            for (int d0 = 0; d0 < 8; ++d0) { const float v = o[d0][r] * rli[r]; const float vn = __shfl_xor(v, 1);
                if ((r32 & 1) == 0) *(unsigned*)(Ow + (size_t)orow * LDO + d0 * 32 + r32) = attn::cvtpk(v, vn); } }
        __syncthreads();
    }
}
#undef A2_LD
#undef A2_FRESH
}

namespace attn3 {
#define A3_LAS __attribute__((address_space(3)))
typedef float f32x2v __attribute__((ext_vector_type(2))); typedef attn::f32x4 f32x4; typedef attn::bf16 abf; typedef attn::bf16x8 bf16x8; typedef attn::f32x16 f32x16; typedef attn::u32x4 u32x4; typedef attn::s16x4 s16x4;
constexpr int KOFF = 0, VOFF = 32768, SCOFF = 98304, LDS_BYTES = SCOFF + 8 * 256;
constexpr int QB3 = 256, LDO = 4096;
struct Blk { const abf* Q; const abf* K; const abf* V0; const abf* V1; abf* O; int P0; };
#define A3_TRRD(dst, vb, off) asm volatile("ds_read_b64_tr_b16 %0, %1 offset:%2" : "=&v"(dst) : "v"(vb), "i"(off) : "memory")
#define A3_FR(L, H) ((bf16x8){L[0], L[1], L[2], L[3], H[0], H[1], H[2], H[3]})
#define A3_RDK(vb, d0, s) do { A3_TRRD(xl##s, vb, (d0) * 512 + (s) * 4096); A3_TRRD(xh##s, vb, (d0) * 512 + (s) * 4096 + 2048); A3_TRRD(yl##s, vb, ((d0) + 1) * 512 + (s) * 4096); A3_TRRD(yh##s, vb, ((d0) + 1) * 512 + (s) * 4096 + 2048); } while (0)
#define A3_STEPK(accx, accy, pa, s, NEXT) do { asm volatile("s_waitcnt lgkmcnt(12)" ::: "memory"); __builtin_amdgcn_sched_barrier(0); \
        accx = __builtin_amdgcn_mfma_f32_32x32x16_bf16(pa, A3_FR(xl##s, xh##s), accx, 0, 0, 0); accy = __builtin_amdgcn_mfma_f32_32x32x16_bf16(pa, A3_FR(yl##s, yh##s), accy, 0, 0, 0); \
        __builtin_amdgcn_sched_barrier(0); NEXT; __builtin_amdgcn_sched_barrier(0); } while (0)
#define A3_PAIR(accx, accy, NEXT0, NEXT1, NEXT2, NEXT3) do { A3_STEPK(accx, accy, pa0, 0, NEXT0); A3_STEPK(accx, accy, pa1, 1, NEXT1); A3_STEPK(accx, accy, pa2, 2, NEXT2); A3_STEPK(accx, accy, pa3, 3, NEXT3); } while (0)
#define A3_NONE do { asm volatile("s_waitcnt lgkmcnt(0)" ::: "memory"); } while (0)
__device__ __forceinline__ void pv256(f32x16* o, int vb0, bf16x8 pa0, bf16x8 pa1, bf16x8 pa2, bf16x8 pa3) {
    s16x4 xl0, xh0, xl1, xh1, xl2, xh2, xl3, xh3, yl0, yh0, yl1, yh1, yl2, yh2, yl3, yh3;
    const int va = vb0, vb = vb0 + 16384;
    asm volatile("s_waitcnt lgkmcnt(0)" ::: "memory");
    A3_RDK(va, 0, 0); A3_RDK(va, 0, 1); A3_RDK(va, 0, 2); A3_RDK(va, 0, 3);
    A3_PAIR(o[0], o[1], A3_RDK(va, 2, 0), A3_RDK(va, 2, 1), A3_RDK(va, 2, 2), A3_RDK(va, 2, 3));
    A3_PAIR(o[2], o[3], A3_RDK(vb, 0, 0), A3_RDK(vb, 0, 1), A3_RDK(vb, 0, 2), A3_RDK(vb, 0, 3));
    A3_PAIR(o[4], o[5], A3_RDK(vb, 2, 0), A3_RDK(vb, 2, 1), A3_RDK(vb, 2, 2), A3_RDK(vb, 2, 3));
    A3_PAIR(o[6], o[7], A3_NONE, A3_NONE, A3_NONE, A3_NONE);
}
#undef A3_TRRD
#undef A3_FR
#undef A3_RDK
#undef A3_STEPK
#undef A3_PAIR
#undef A3_NONE
__device__ __forceinline__ float own_sum(const f32x16& P) { return ((P[0] + P[1]) + (P[2] + P[3])) + ((P[4] + P[5]) + (P[6] + P[7])) + (((P[8] + P[9]) + (P[10] + P[11])) + ((P[12] + P[13]) + (P[14] + P[15]))); }
__device__ __forceinline__ void pack_own(const f32x16& P, bf16x8& outA, bf16x8& outB) {
    u32x4 wa = {attn::cvtpk(P[0], P[1]), attn::cvtpk(P[2], P[3]), attn::cvtpk(P[4], P[5]), attn::cvtpk(P[6], P[7])}; outA = *reinterpret_cast<bf16x8*>(&wa);
    u32x4 wb = {attn::cvtpk(P[8], P[9]), attn::cvtpk(P[10], P[11]), attn::cvtpk(P[12], P[13]), attn::cvtpk(P[14], P[15])}; outB = *reinterpret_cast<bf16x8*>(&wb);
}
__device__ __forceinline__ float vmax3(float a, float b, float c) { float d; asm("v_max3_f32 %0, %1, %2, %3" : "=v"(d) : "v"(a), "v"(b), "v"(c)); return d; }
__device__ __forceinline__ void block(const Blk& B, char* lds, A3_LAS unsigned char* ldsl, const int tid) {
    const int wid = __builtin_amdgcn_readfirstlane(tid >> 6), lane = tid & 63, r32 = lane & 31, hi = lane >> 5;
    const int NT = (B.P0 + QB3) / 64;
    char* K_lds = lds + KOFF; char* V_lds = lds + VOFF;
    float* sc_l = (float*)(lds + SCOFF) + wid * 64;
    const int vb0 = (int)(uintptr_t)V_lds + attn::v_rd_base(lane);
    const int qlo = B.P0 + wid * 32, qm = qlo + r32 - 4 * hi;
    constexpr float C2 = 1.4426950408889634f * attn::SCALE;
    unsigned kso[2], vso[2];
#pragma unroll
    for (int i = 0; i < 2; ++i) { const int row = (2 * wid + i) * 4 + (lane >> 4); const int c = (lane & 15) ^ (row & 7); kso[i] = (unsigned)(row * 128 + c * 8) * 2u; }
#pragma unroll
    for (int q = 0; q < 2; ++q) { const int st = 2 * (2 * wid + q) + (lane >> 5), w16 = lane & 31; const int k = (st >> 2) * 8 + (w16 >> 2);
        const int c = (st & 3) * 32 + (w16 & 3) * 8; vso[q] = (unsigned)(k * 128 + c) * 2u; }
#define A3_STAGE(tile, buf) do { const size_t tb_ = (size_t)(tile) * (64 * 256); unsigned ko_[2] = {kso[0], kso[1]}, vo_[2] = {vso[0], vso[1]}; asm volatile("" : "+v"(ko_[0]), "+v"(ko_[1]), "+v"(vo_[0]), "+v"(vo_[1])); \
        _Pragma("unroll") for (int i_ = 0; i_ < 2; ++i_) __builtin_amdgcn_global_load_lds((const unsigned*)((const char*)B.K + tb_ + ko_[i_]), (A3_LAS unsigned*)(ldsl + KOFF + (buf) * 16384 + (2 * wid + i_) * 1024), 16, 0, 0); \
        _Pragma("unroll") for (int q_ = 0; q_ < 2; ++q_) { __builtin_amdgcn_global_load_lds((const unsigned*)((const char*)B.V0 + tb_ + vo_[q_]), (A3_LAS unsigned*)(ldsl + VOFF + (buf) * 32768 + (2 * wid + q_) * 1024), 16, 0, 0); \
            __builtin_amdgcn_global_load_lds((const unsigned*)((const char*)B.V1 + tb_ + vo_[q_]), (A3_LAS unsigned*)(ldsl + VOFF + (buf) * 32768 + 16384 + (2 * wid + q_) * 1024), 16, 0, 0); } } while (0)
    float m_reg = -1e30f, l_reg = 0.f; bf16x8 qr[8]; f32x16 o[8] = {};
#pragma unroll
    for (int d0 = 0; d0 < 8; ++d0) qr[d0] = attn::load8<abf>(B.Q + (size_t)(wid * 32 + r32) * 128 + d0 * 16 + hi * 8);
    A3_STAGE(0, 0);
    asm volatile("s_waitcnt vmcnt(0)" ::: "memory");
    __syncthreads();
    for (int t = 0; t < NT; ++t) {
        const int buf = t & 1, kb = t * 64;
        if (t + 1 < NT) A3_STAGE(t + 1, buf ^ 1);
        f32x16 p0, p1;
        attn::qkt<0, false>(p0, p1, K_lds + buf * 16384, r32, hi, qr, true);
        if (kb + 63 > qlo) attn::mask_tile(p0, p1, qm - kb, 0x7fffffffu);
        float pmax = fmaxf(p0[15], p1[15]);
        { float mb;
          asm("v_max3_f32 %0, %0, %2, %3\n\tv_max3_f32 %1, %10, %11, %12\n\tv_max3_f32 %0, %0, %4, %5\n\tv_max3_f32 %1, %1, %13, %14\n\tv_max3_f32 %0, %0, %6, %7\n\tv_max3_f32 %1, %1, %15, %16\n\tv_max3_f32 %0, %0, %8, %9\n\tv_max3_f32 %1, %1, %17, %18"
              : "+&v"(pmax), "=&v"(mb) : "v"(p0[0]), "v"(p0[1]), "v"(p0[2]), "v"(p0[3]), "v"(p0[4]), "v"(p0[5]), "v"(p0[6]), "v"(p0[7]),
                "v"(p1[0]), "v"(p1[1]), "v"(p1[2]), "v"(p1[3]), "v"(p1[4]), "v"(p1[5]), "v"(p1[6]), "v"(p1[7]), "v"(p1[8]));
          asm("v_max3_f32 %0, %0, %2, %3\n\tv_max3_f32 %1, %1, %9, %10\n\tv_max3_f32 %0, %0, %4, %5\n\tv_max3_f32 %1, %1, %11, %12\n\tv_max3_f32 %0, %0, %6, %7\n\tv_max3_f32 %1, %1, %13, %14\n\tv_max3_f32 %0, %0, %1, %8"
              : "+&v"(pmax), "+&v"(mb) : "v"(p0[8]), "v"(p0[9]), "v"(p0[10]), "v"(p0[11]), "v"(p0[12]), "v"(p0[13]), "v"(p0[14]),
                "v"(p1[9]), "v"(p1[10]), "v"(p1[11]), "v"(p1[12]), "v"(p1[13]), "v"(p1[14])); }
        { auto rr = __builtin_amdgcn_permlane32_swap(__float_as_uint(pmax), __float_as_uint(pmax), false, false); pmax = vmax3(__uint_as_float(rr[0]), __uint_as_float(rr[1]), __uint_as_float(rr[1])); }
        const bool keep = __all((pmax - m_reg) * attn::SCALE <= attn::THR);
        const float mn = keep ? m_reg : vmax3(m_reg, pmax, pmax); const float alpha = __builtin_amdgcn_exp2f((m_reg - mn) * C2); m_reg = mn;
        const float mnL = -mn * C2;
#pragma unroll
        for (int r = 0; r < 16; ++r) { p0[r] = __builtin_amdgcn_exp2f(fmaf(p0[r], C2, mnL)); p1[r] = __builtin_amdgcn_exp2f(fmaf(p1[r], C2, mnL)); }
        l_reg = l_reg * alpha + (own_sum(p0) + own_sum(p1));
        bf16x8 pa0, pa1, pa2, pa3; pack_own(p0, pa0, pa1); pack_own(p1, pa2, pa3);
        if (__any(alpha < 1.f)) {
            if (hi == 0) sc_l[r32] = alpha;
            asm volatile("s_waitcnt lgkmcnt(0)" ::: "memory");
            float a16[16];
#pragma unroll
            for (int r = 0; r < 16; ++r) a16[r] = sc_l[attn::crow(r, hi)];
#pragma unroll
            for (int d0 = 0; d0 < 8; ++d0)
#pragma unroll
                for (int r = 0; r < 16; ++r) o[d0][r] *= a16[r];
        }
        pv256(o, vb0 + buf * 32768, pa0, pa1, pa2, pa3);
        asm volatile("s_waitcnt vmcnt(0)" ::: "memory");
        __syncthreads();
    }
#undef A3_STAGE
    { auto rr = __builtin_amdgcn_permlane32_swap(__float_as_uint(l_reg), __float_as_uint(l_reg), false, false); l_reg = __uint_as_float(rr[0]) + __uint_as_float(rr[1]); }
    if (hi == 0) sc_l[32 + r32] = l_reg;
    asm volatile("s_waitcnt lgkmcnt(0)" ::: "memory");
    float rli[16];
#pragma unroll
    for (int r = 0; r < 16; ++r) rli[r] = __builtin_amdgcn_rcpf(sc_l[32 + attn::crow(r, hi)]);
    abf* Ow = B.O + (size_t)(wid * 32) * LDO;
#pragma unroll
    for (int r = 0; r < 16; ++r) { const int orow = attn::crow(r, hi);
#pragma unroll
        for (int d0 = 0; d0 < 8; ++d0) { const float v = o[d0][r] * rli[r]; const float vn = __shfl_xor(v, 1);
            if ((r32 & 1) == 0) *(unsigned*)(Ow + (size_t)orow * LDO + d0 * 32 + r32) = attn::cvtpk(v, vn); } }
    __syncthreads();
}
}
#define GAS __attribute__((address_space(1)))
#define LAS __attribute__((address_space(3)))
typedef unsigned short bf16;
typedef unsigned v4u __attribute__((ext_vector_type(4)));
typedef float f32x4 __attribute__((ext_vector_type(4)));
typedef short bf16x8 __attribute__((ext_vector_type(8)));
typedef GAS unsigned gu32;
typedef GAS unsigned long long gu64;
#define RLX_AGENT __ATOMIC_RELAXED, __HIP_MEMORY_SCOPE_AGENT
#define LDS_WAIT() asm volatile("s_waitcnt lgkmcnt(0)" ::: "memory")
#define VM_WAIT() asm volatile("s_waitcnt vmcnt(0)" ::: "memory")
__device__ __forceinline__ unsigned long long rt() { return __builtin_amdgcn_s_memrealtime(); }
__device__ __forceinline__ unsigned f2bf(float f) { unsigned u = __builtin_bit_cast(unsigned, f); return (u + 0x7fffu + ((u >> 16) & 1u)) >> 16; }
__device__ __forceinline__ unsigned pk2(float lo, float hi) { return f2bf(lo) | (f2bf(hi) << 16); }

#define XB_TMO      128
#define XB_XCNT(j)  (256  + 64 * (j))
#define XB_XSUB(j)  (1280 + 64 * (j))
#define XB_XGEN(j)  (2304 + 64 * (j))
#define XB_TOP      3328
#define XB_TOPGEN   3392
#define XCD_BAR_WORDS 3456
#define XB_SPIN_CAP (1u << 18)

__device__ __forceinline__ unsigned xb_ld(unsigned* p)              { return __hip_atomic_load(p, __ATOMIC_RELAXED, __HIP_MEMORY_SCOPE_AGENT); }
__device__ __forceinline__ unsigned xb_add(unsigned* p, unsigned v) { return __hip_atomic_fetch_add(p, v, __ATOMIC_RELAXED, __HIP_MEMORY_SCOPE_AGENT); }
__device__ __forceinline__ unsigned xb_xcc_id() { return (unsigned)__builtin_amdgcn_s_getreg((3 << 11) | 20) & 0xFu; }
#define XB_SPIN(cond, bar) do { unsigned _sp = 0; while (cond) { __builtin_amdgcn_s_sleep(1); \
    if ((++_sp & 255u) == 0u) { if (xb_ld(&(bar)[XB_TMO])) break; if (_sp > XB_SPIN_CAP) { atomicAdd(&(bar)[XB_TMO], 1u); break; } } } } while (0)

struct XcdBarrier {
    unsigned* bar; unsigned x;
    volatile LAS unsigned* st;
};

__device__ __forceinline__ XcdBarrier xcd_barrier_post(unsigned* bar, volatile LAS unsigned* st) {
    XcdBarrier b; b.bar = bar; b.x = xb_xcc_id(); b.st = st;
    if (threadIdx.x == 0) (void)xb_add(&bar[XB_XCNT(b.x)], 1u);
    return b;
}
__device__ __forceinline__ void xcd_barrier_complete(unsigned* bar, unsigned x, unsigned& nloc, unsigned& nx) {
    const unsigned G = gridDim.x * gridDim.y * gridDim.z;
    unsigned sum, cnt, mine, sp = 0u;
    for (;;) {
        sum = 0u; cnt = 0u; mine = 0u;
#pragma unroll
        for (unsigned j = 0; j < 16; ++j) { const unsigned c = xb_ld(&bar[XB_XCNT(j)]); sum += c; cnt += (c > 0u) ? 1u : 0u; mine = (j == x) ? c : mine; }
        if (sum == G) break;
        __builtin_amdgcn_s_sleep(1);
        if ((++sp & 255u) == 0u) { if (xb_ld(&bar[XB_TMO])) break; if (sp > XB_SPIN_CAP) { atomicAdd(&bar[XB_TMO], 1u); break; } }
    }
    nloc = mine > 0u ? mine : 1u; nx = cnt > 0u ? cnt : 1u;
}

__device__ __forceinline__ void xcd_barrier(const XcdBarrier& b, const int tid) {
    asm volatile("s_waitcnt vmcnt(0)" ::: "memory");
    __syncthreads();
    if (tid == 0) {
        unsigned* bar = b.bar;
        __builtin_amdgcn_s_waitcnt(0);
        unsigned nloc = b.st[0], nx = b.st[1];
        if (nloc == 0u) { xcd_barrier_complete(bar, b.x, nloc, nx); b.st[0] = nloc; b.st[1] = nx; }
        const unsigned old = xb_add(&bar[XB_XSUB(b.x)], 1u);
        const unsigned gen = old / nloc;
        if (old + 1u == (gen + 1u) * nloc) {
            __builtin_amdgcn_fence(__ATOMIC_RELEASE, "agent");
            asm volatile("s_waitcnt vmcnt(0)" ::: "memory");
            const unsigned og = xb_add(&bar[XB_TOP], 1u);
            const unsigned tg = og / nx;
            if (og + 1u == (tg + 1u) * nx) xb_add(&bar[XB_TOPGEN], 1u);
            else XB_SPIN(xb_ld(&bar[XB_TOPGEN]) == tg, bar);
            __builtin_amdgcn_fence(__ATOMIC_ACQUIRE, "agent");
            xb_add(&bar[XB_XGEN(b.x)], 1u);
            asm volatile("s_waitcnt vmcnt(0)" ::: "memory");
        } else {
            XB_SPIN(xb_ld(&bar[XB_XGEN(b.x)]) == gen, bar);
            __builtin_amdgcn_fence(__ATOMIC_ACQUIRE, "agent");
            asm volatile("s_waitcnt vmcnt(0)" ::: "memory");
        }
    }
    __syncthreads();
}

constexpr int NWAVES = 8;
#ifndef MK_ONE_LAUNCH
#define MK_ONE_LAUNCH 1
#endif
constexpr int NPHASE = 13;
constexpr int T = 8192, DM = 2048, NE = 32;
constexpr float EPS = 1e-5f;
constexpr size_t MiB = 1u << 20;
constexpr size_t WS_CTL = 0, CTL_ZERO_BYTES = 1 * MiB;
constexpr size_t WS_MODP = 1 * MiB;
constexpr size_t WS_MOD = 2 * MiB;
constexpr size_t WS_ROPE = 3 * MiB;
constexpr size_t WS_WRT = 4 * MiB;
constexpr size_t WS_TOPI = 5 * MiB;
constexpr size_t WS_TOPW = 5 * MiB + 256 * 1024;
constexpr size_t WS_TRANK = 5 * MiB + 512 * 1024;
constexpr size_t WS_ECNT = WS_CTL + 512 * 1024;
constexpr size_t WS_STOK = 6 * MiB;
constexpr size_t WS_WIN = 8 * MiB;
constexpr size_t WS_WAO = 72 * MiB, WS_WO = 88 * MiB;
constexpr size_t WS_WUP = 96 * MiB;
constexpr size_t WS_WDN = 608 * MiB;
constexpr size_t WS_H = 864 * MiB;
constexpr size_t WS_Q = 896 * MiB, WS_K = 928 * MiB, WS_V = 960 * MiB;
constexpr size_t WS_R = 992 * MiB;
constexpr size_t WS_OA = 1152 * MiB;
constexpr size_t WS_ON = 1216 * MiB;
constexpr size_t WS_TMP = 1280 * MiB;
constexpr size_t WS_MG = 1344 * MiB;
constexpr size_t WS_X1 = 1376 * MiB;
constexpr size_t WS_XS = 1440 * MiB;
constexpr size_t WS_ACT = 1600 * MiB;
constexpr size_t WS_YS = 1760 * MiB;
constexpr size_t WS_END = 1920 * MiB;
constexpr int CW_BAR = 4096;
constexpr int RING_OFF = 0, RING_BYTES = 131072;
constexpr int TOKTAB_OFF = 131072;
constexpr int LDSCTL_OFF = 157696, MISC_OFF = LDSCTL_OFF + 320, TILE_OFF = LDSCTL_OFF + 1024;
constexpr int LDS_BYTES = 163840;

typedef unsigned u32x2 __attribute__((ext_vector_type(2)));
typedef int i32x4 __attribute__((ext_vector_type(4)));
__device__ __forceinline__ int fresh_lane() { int l; asm volatile("v_mbcnt_lo_u32_b32 %0, -1, 0\n\tv_mbcnt_hi_u32_b32 %0, -1, %0" : "=v"(l)); return l; }
__device__ __forceinline__ float wave_sum(float v) {
#pragma unroll
    for (int o = 1; o < 64; o <<= 1) v += __shfl_xor(v, o);
    return v;
}
__device__ __forceinline__ float dot4(f32x4 a, f32x4 b) { return (a.x * b.x + a.y * b.y) + (a.z * b.z + a.w * b.w); }
__device__ __forceinline__ float bflo(unsigned w) { return __uint_as_float(w << 16); }
__device__ __forceinline__ float bfhi(unsigned w) { return __uint_as_float(w & 0xffff0000u); }
__device__ __forceinline__ u32x2 pack4(f32x4 v) { u32x2 w; w.x = pk2(v.x, v.y); w.y = pk2(v.z, v.w); return w; }
__device__ __forceinline__ f32x4 unpack4(u32x2 w) { return (f32x4){bflo(w.x), bfhi(w.x), bflo(w.y), bfhi(w.y)}; }
__device__ __forceinline__ float inv_freq(int i) {
    float r = 1.000000000e+00f;
    r = i == 1 ? 4.403665960e-01f : r; r = i == 2 ? 1.939227432e-01f : r; r = i == 3 ? 8.539710194e-02f : r; r = i == 4 ? 3.760603070e-02f : r;
    r = i == 5 ? 1.656043902e-02f : r; r = i == 6 ? 7.292664610e-03f : r; r = i == 7 ? 3.211445874e-03f : r; r = i == 8 ? 1.414213562e-03f : r;
    r = i == 9 ? 6.227723788e-04f : r; r = i == 10 ? 2.742481884e-04f : r; r = i == 11 ? 1.207697351e-04f : r; r = i == 12 ? 5.318296098e-05f : r;
    r = i == 13 ? 2.341999971e-05f : r; r = i == 14 ? 1.031338616e-05f : r; r = i == 15 ? 4.541670478e-06f : r;
    return r;
}

struct Args { const void* in[24]; float* out; unsigned char* ws; int ph_lo, ph_hi, li, pad; };
typedef const __attribute__((address_space(4))) unsigned long long* KP;
__device__ __forceinline__ KP kargs() { KP kp = (KP)__builtin_amdgcn_kernarg_segment_ptr(); asm volatile("" : "+s"(kp)); return kp; }
#define KIN(i) ((const void*)(const GAS char*)kp[(i)])
#define KWS() ((unsigned char*)(GAS unsigned char*)kp[25])
#define KOUT() ((float*)(GAS float*)kp[24])

struct ConvSrc { const float* W; bf16* WT; int N; int item; int ldk; int kfast; int tiled; int ktoff; };
__device__ __forceinline__ ConvSrc conv_decode(KP kp, unsigned char* ws, int it) {
    constexpr int I_IN = 32 * 256, I_SQ = 32 * 32, I_UP = 32 * 64, I_DN = 32 * 32;
    ConvSrc c; int r = it; c.ldk = 2048; c.kfast = 0; c.tiled = 32; c.ktoff = 0;
    if (r < I_IN) { c.W = (const float*)KIN(6); c.WT = (bf16*)(ws + WS_WIN); c.N = 16384; c.item = r; return c; } r -= I_IN;
    if (r < I_SQ) { c.W = (const float*)KIN(13); c.WT = (bf16*)(ws + WS_WAO); c.N = 2048; c.item = r; c.ldk = 4096; c.tiled = 64; return c; } r -= I_SQ;
    if (r < I_SQ) { c.W = (const float*)KIN(14); c.WT = (bf16*)(ws + WS_WAO); c.N = 2048; c.item = r; c.ldk = 4096; c.tiled = 64; c.ktoff = 32; return c; } r -= I_SQ;
    if (r < I_SQ) { c.W = (const float*)KIN(15); c.WT = (bf16*)(ws + WS_WO); c.N = 2048; c.item = r; return c; } r -= I_SQ;
    if (r < NE * I_UP) { const int e = r / I_UP; c.W = (const float*)KIN(19) + (size_t)e * 2048 * 4096; c.WT = (bf16*)(ws + WS_WUP) + (size_t)e * 4096 * 2048; c.N = 4096; c.item = r - e * I_UP; return c; } r -= NE * I_UP;
    { const int e = r / I_DN; c.W = (const float*)KIN(21) + (size_t)e * 2048 * 2048; c.WT = (bf16*)(ws + WS_WDN) + (size_t)e * 2048 * 2048; c.N = 2048; c.item = r - e * I_DN; return c; }
}
constexpr int CONV_DENSE_ITEMS = 32 * 256 + 3 * 32 * 32, CONV_UP_MID = CONV_DENSE_ITEMS + NE * 32 * 32, CONV_UP_END = CONV_DENSE_ITEMS + NE * 32 * 64, CONV_ALL_ITEMS = CONV_UP_END + NE * 32 * 32;
__device__ __forceinline__ void conv_load(const ConvSrc& c, int lane, f32x4 (&ra)[8], f32x4 (&rb)[8]) {
    const int nblk = c.N >> 6, kb = c.kfast ? (c.item & 31) : c.item / nblk, nb = c.kfast ? (c.item >> 5) : c.item - kb * nblk, k0 = kb * 64, n0 = nb * 64;
    const int n4 = (lane & 15) * 4, kq = lane >> 4;
#pragma unroll
    for (int i = 0; i < 8; ++i) { const int kp2 = 4 * i + kq; const float* p = c.W + (size_t)(k0 + 2 * kp2) * c.N + n0 + n4; ra[i] = __builtin_nontemporal_load((const GAS f32x4*)p); rb[i] = __builtin_nontemporal_load((const GAS f32x4*)(p + c.N)); }
}
__device__ __forceinline__ void conv_emit(const ConvSrc& c, int lane, LAS unsigned* P, const f32x4 (&ra)[8], const f32x4 (&rb)[8]) {
    const int nblk = c.N >> 6, kb = c.kfast ? (c.item & 31) : c.item / nblk, nb = c.kfast ? (c.item >> 5) : c.item - kb * nblk, k0 = kb * 64, n0 = nb * 64;
    const int n4 = (lane & 15) * 4, kq = lane >> 4;
#pragma unroll
    for (int i = 0; i < 8; ++i) { const int kp2 = 4 * i + kq; LAS unsigned* d = P + kp2 * 65 + n4;
        d[0] = pg8::cvt_pk_bf16(ra[i].x, rb[i].x); d[1] = pg8::cvt_pk_bf16(ra[i].y, rb[i].y); d[2] = pg8::cvt_pk_bf16(ra[i].z, rb[i].z); d[3] = pg8::cvt_pk_bf16(ra[i].w, rb[i].w); }
    LDS_WAIT(); asm volatile("" ::: "memory");
    const int cc = lane & 7;
#pragma unroll
    for (int jj = 0; jj < 8; ++jj) { const int n = (lane >> 3) + 8 * jj; const LAS unsigned* sp = P + (4 * cc) * 65 + n;
        v4u o; o.x = sp[0]; o.y = sp[65]; o.z = sp[130]; o.w = sp[195];
        bf16* dst = c.tiled ? c.WT + (size_t)((nb >> 2) * c.tiled + c.ktoff + kb) * 16384 + ((nb & 3) * 64 + n) * 64 + 8 * cc : c.WT + (size_t)(n0 + n) * c.ldk + k0 + 8 * cc;
        __builtin_nontemporal_store(o, (GAS v4u*)dst); }
    LDS_WAIT(); asm volatile("" ::: "memory");
}
__device__ __forceinline__ void conv_run(KP kp, unsigned char* ws, LAS unsigned* P, int lane, int first, int it_hi, int step) {
    if (first >= it_hi) return;
    const int lastv = first + ((it_hi - 1 - first) / step) * step;
    f32x4 a0[8], b0[8], a1[8], b1[8];
    ConvSrc c0 = conv_decode(kp, ws, first), c1;
    conv_load(c0, lane, a0, b0);
    for (int it = first; it < it_hi; it += 2 * step) {
        c1 = conv_decode(kp, ws, min(it + step, lastv)); conv_load(c1, lane, a1, b1);
        conv_emit(c0, lane, P, a0, b0);
        c0 = conv_decode(kp, ws, min(it + 2 * step, lastv)); conv_load(c0, lane, a0, b0);
        conv_emit(c1, lane, P, a1, b1);
    }
}

__device__ __forceinline__ void phase0(KP kp, LAS unsigned char* lds, int wave, int bid, int G) {
    const int lane = fresh_lane(), tid = wave * 64 + lane;
    unsigned char* ws = KWS();
    { const int* pos = (const int*)KIN(2); float* rope = (float*)(ws + WS_ROPE);
      for (int i = bid * 512 + tid; i < T * 16; i += G * 512) { const int t = i >> 4, f = i & 15;
          const float ang = (float)pos[t] * inv_freq(f); double rev = (double)ang * 0.15915494309189535; rev -= __builtin_rint(rev);
          const float fr = (float)rev; rope[t * 32 + f] = __builtin_amdgcn_cosf(fr); rope[t * 32 + 16 + f] = __builtin_amdgcn_sinf(fr); } }
    { const float* wr = (const float*)KIN(17); float* wrt = (float*)(ws + WS_WRT);
      for (int i = bid * 512 + tid; i < NE * DM; i += G * 512) { const int e = i >> 11, c = i & 2047; wrt[i] = wr[c * NE + e]; } }
    for (int u = bid; u < 256; u += G) {
        const int nc = u & 15, kr = u >> 4, n0 = 768 * nc, k0 = 128 * kr;
        const float* cvec = (const float*)KIN(1); const float* wada = (const float*)KIN(3);
        f32x4 acc[3] = {(f32x4){0.f, 0.f, 0.f, 0.f}, (f32x4){0.f, 0.f, 0.f, 0.f}, (f32x4){0.f, 0.f, 0.f, 0.f}};
#pragma unroll 4
        for (int i = 0; i < 16; ++i) { const int k = k0 + wave + 8 * i; const float cv = cvec[k]; const float s = cv / (1.0f + __expf(-cv));
            const float* p = wada + (size_t)k * 12288 + n0 + 4 * lane;
#pragma unroll
            for (int q = 0; q < 3; ++q) acc[q] += s * *(const GAS f32x4*)(p + 256 * q); }
        LAS float* red = (LAS float*)lds;
#pragma unroll
        for (int q = 0; q < 3; ++q) *(LAS f32x4*)(red + wave * 768 + 256 * q + 4 * lane) = acc[q];
        __syncthreads();
        if (tid < 192) { f32x4 s = *(LAS f32x4*)(red + 4 * tid);
#pragma unroll
            for (int w = 1; w < 8; ++w) s += *(LAS f32x4*)(red + w * 768 + 4 * tid);
            *(GAS f32x4*)((float*)(ws + WS_MODP) + (size_t)kr * 12288 + n0 + 4 * tid) = s; }
        __syncthreads();
    }
    conv_run(kp, ws, (LAS unsigned*)(lds + wave * 8448), lane, bid * NWAVES + wave, 32 * 256, G * NWAVES);
}
__device__ __forceinline__ void conv_moe_share(KP kp, LAS unsigned char* lds, int wave, int bid, int G, int it_lo, int it_hi, int lds_off = 0) {
    const int lane = fresh_lane();
    conv_run(kp, KWS(), (LAS unsigned*)(lds + lds_off + wave * 8320), lane, it_lo + bid * NWAVES + wave, it_hi, G * NWAVES);
    __syncthreads();
}
__device__ __forceinline__ void conv_moe_range(KP kp, LAS unsigned char* lds, int wave, int lo, int hi) {
    const int lane = fresh_lane();
    conv_run(kp, KWS(), (LAS unsigned*)(lds + wave * 8320), lane, lo + wave, hi, NWAVES);
    __syncthreads();
}

__device__ __forceinline__ void phase1(KP kp, LAS unsigned char* lds, int wave, int bid, int G) {
    const int lane = fresh_lane(), tid = wave * 64 + lane;
    unsigned char* ws = KWS();
    LAS float* A1 = (LAS float*)lds; LAS float* B1 = A1 + 2048;
    const float* modp = (const float*)(ws + WS_MODP); const float* b_ada = (const float*)KIN(4); const float* n1g = (const float*)KIN(5);
    for (int c = tid; c < 2048; c += 512) { float sh = b_ada[c], sc = b_ada[2048 + c];
        for (int r = 0; r < 16; ++r) { sh += modp[r * 12288 + c]; sc += modp[r * 12288 + 2048 + c]; }
        A1[c] = n1g[c] * (1.0f + sc); B1[c] = sh; }
    { float* mod = (float*)(ws + WS_MOD);
      for (int n = bid * 512 + tid; n < 12288; n += G * 512) { float s = b_ada[n]; for (int r = 0; r < 16; ++r) s += modp[r * 12288 + n]; mod[n] = s; } }
    __syncthreads();
    const float* x = (const float*)KIN(0); bf16* H = (bf16*)(ws + WS_H);
    for (int m = bid * NWAVES + wave; m < T; m += G * NWAVES) {
        const GAS f32x4* xr = (const GAS f32x4*)(x + (size_t)m * DM) + lane;
        f32x4 v[8]; float s = 0.f;
#pragma unroll
        for (int j = 0; j < 8; ++j) { v[j] = xr[64 * j]; s += dot4(v[j], v[j]); }
        const float rstd = 1.0f / sqrtf(wave_sum(s) * (1.0f / DM) + EPS);
        GAS u32x2* o8 = (GAS u32x2*)(H + (size_t)m * DM) + lane;
#pragma unroll
        for (int j = 0; j < 8; ++j) { const f32x4 av = *(const LAS f32x4*)(A1 + 256 * j + 4 * lane), bv = *(const LAS f32x4*)(B1 + 256 * j + 4 * lane);
            o8[64 * j] = pack4(v[j] * rstd * av + bv); }
    }
}

__device__ __forceinline__ void phase4(KP kp, int wave, int bid, int G) {
    const int lane = fresh_lane();
    unsigned char* ws = KWS();
    const int gw = bid * NWAVES + wave, NGW = G * NWAVES;
    float lam;
    { const float* q1 = (const float*)KIN(8); const float* k1 = (const float*)KIN(9); const float* q2 = (const float*)KIN(10); const float* k2 = (const float*)KIN(11);
      const float s1 = wave_sum(q1[lane] * k1[lane] + q1[lane + 64] * k1[lane + 64]), s2 = wave_sum(q2[lane] * k2[lane] + q2[lane + 64] * k2[lane + 64]);
      lam = expf(s1) - expf(s2) + 0.2f; }
    const bf16* OA = (const bf16*)(ws + WS_OA); bf16* ON = (bf16*)(ws + WS_ON);
    const f32x4 sg = *(const GAS f32x4*)((const float*)KIN(12) + 4 * lane) * 0.8f;
    for (int it = gw; it < T * 8; it += NGW) { const int t = it >> 3, hd = it & 7;
        const bf16* o0 = OA + (size_t)t * 4096 + hd * 512 + 4 * lane;
        const f32x4 d = unpack4(*(const GAS u32x2*)o0) - lam * unpack4(*(const GAS u32x2*)(o0 + 256));
        const float rstd = 1.0f / sqrtf(wave_sum(dot4(d, d)) * (1.0f / 256.0f) + EPS);
        *(GAS u32x2*)(ON + (size_t)t * 4096 + hd * 256 + 4 * lane) = pack4(d * rstd * sg); }
    const bf16* R = (const bf16*)(ws + WS_R); bf16* CV = (bf16*)(ws + WS_ON) + 2048; const float* cw = (const float*)KIN(7);
    for (int it = gw; it < 2048; it += NGW) { const int tb = it >> 2, ch = (it & 3) * 512 + 8 * lane, t0 = tb * 16;
        f32x4 w0a = *(const GAS f32x4*)(cw + ch), w0b = *(const GAS f32x4*)(cw + ch + 4), w1a = *(const GAS f32x4*)(cw + 2048 + ch), w1b = *(const GAS f32x4*)(cw + 2048 + ch + 4),
              w2a = *(const GAS f32x4*)(cw + 4096 + ch), w2b = *(const GAS f32x4*)(cw + 4096 + ch + 4);
        f32x4 u1a = (f32x4){0.f, 0.f, 0.f, 0.f}, u1b = u1a, u2a = u1a, u2b = u1a;
        if (t0 > 0) {
            { const bf16* r = R + (size_t)(t0 - 1) * 10240 + ch; const v4u c = *(const GAS v4u*)(r + 2048), h = *(const GAS v4u*)(r + 4096);
              u1a = unpack4((u32x2){c.x, c.y}) * unpack4((u32x2){h.x, h.y}); u1b = unpack4((u32x2){c.z, c.w}) * unpack4((u32x2){h.z, h.w}); }
            { const bf16* r = R + (size_t)(t0 - 2) * 10240 + ch; const v4u c = *(const GAS v4u*)(r + 2048), h = *(const GAS v4u*)(r + 4096);
              u2a = unpack4((u32x2){c.x, c.y}) * unpack4((u32x2){h.x, h.y}); u2b = unpack4((u32x2){c.z, c.w}) * unpack4((u32x2){h.z, h.w}); }
        }
#pragma unroll 4
        for (int i = 0; i < 16; ++i) { const int t = t0 + i; const bf16* r = R + (size_t)t * 10240 + ch;
            const v4u b = *(const GAS v4u*)r, c = *(const GAS v4u*)(r + 2048), h = *(const GAS v4u*)(r + 4096);
            const f32x4 ua = unpack4((u32x2){c.x, c.y}) * unpack4((u32x2){h.x, h.y}), ub = unpack4((u32x2){c.z, c.w}) * unpack4((u32x2){h.z, h.w});
            const f32x4 ya = unpack4((u32x2){b.x, b.y}) * (w0a * u2a + w1a * u1a + w2a * ua), yb = unpack4((u32x2){b.z, b.w}) * (w0b * u2b + w1b * u1b + w2b * ub);
            const u32x2 pa = pack4(ya), pb = pack4(yb);
            *(GAS v4u*)(CV + (size_t)t * 4096 + ch) = (v4u){pa.x, pa.y, pb.x, pb.y};
            u2a = u1a; u2b = u1b; u1a = ua; u1b = ub; }
    }
}

typedef float f32x16 __attribute__((ext_vector_type(16)));
__device__ __forceinline__ float half_max(float v) { v = fmaxf(v, __shfl_xor(v, 1)); v = fmaxf(v, __shfl_xor(v, 2)); v = fmaxf(v, __shfl_xor(v, 4)); v = fmaxf(v, __shfl_xor(v, 8)); v = fmaxf(v, __shfl_xor(v, 16)); return v; }
__device__ __forceinline__ int half_min(int v) { v = min(v, __shfl_xor(v, 1)); v = min(v, __shfl_xor(v, 2)); v = min(v, __shfl_xor(v, 4)); v = min(v, __shfl_xor(v, 8)); v = min(v, __shfl_xor(v, 16)); return v; }
__device__ __forceinline__ void phase8(KP kp, LAS unsigned char* lds, int wave, int bid) {
    const int lane = fresh_lane(), tid = wave * 64 + lane;
    unsigned char* ws = KWS();
    LAS float* A2 = (LAS float*)lds; LAS float* B2 = A2 + 2048;
    LAS float* rs = (LAS float*)(lds + 16384);
    LAS int* eidx = (LAS int*)(lds + 16384 + 128);
    LAS float* part = (LAS float*)(lds + 20480);
    LAS float* lg = (LAS float*)(lds + 56320);
    const float* mod = (const float*)(ws + WS_MOD); const float* n2g = (const float*)KIN(16);
    for (int c = tid; c < 2048; c += 512) { A2[c] = n2g[c] * (1.0f + mod[4 * 2048 + c]); B2[c] = mod[3 * 2048 + c]; }
    __syncthreads();
    const float* X1 = (const float*)(ws + WS_X1); bf16* H = (bf16*)(ws + WS_H); const float* wrt = (const float*)(ws + WS_WRT); const float* br = (const float*)KIN(18);
    int* TOPI = (int*)(ws + WS_TOPI); float* TOPW = (float*)(ws + WS_TOPW);
#pragma unroll 2
    for (int q = 0; q < 4; ++q) {
        const int lt = 4 * wave + q, t = 32 * bid + lt;
        const GAS f32x4* xr = (const GAS f32x4*)(X1 + (size_t)t * DM) + lane;
        f32x4 v[8]; float s = 0.f;
#pragma unroll
        for (int j = 0; j < 8; ++j) { v[j] = xr[64 * j]; s += dot4(v[j], v[j]); }
        const float rstd = 1.0f / sqrtf(wave_sum(s) * (1.0f / DM) + EPS);
        if (lane == 0) rs[lt] = rstd;
        GAS u32x2* o8 = (GAS u32x2*)(H + (size_t)t * DM) + lane;
#pragma unroll
        for (int j = 0; j < 8; ++j) { const f32x4 av = *(const LAS f32x4*)(A2 + 256 * j + 4 * lane), bv = *(const LAS f32x4*)(B2 + 256 * j + 4 * lane);
            o8[64 * j] = pack4(v[j] * rstd * av + bv); }
    }
    __syncthreads();
    {
        const int i = lane & 31, hk = lane >> 5; const float rstd_i = rs[i];
        const float* xrow = X1 + (size_t)(32 * bid + i) * DM + 256 * wave + 16 * hk; const float* wrow = wrt + (size_t)i * DM + 256 * wave + 16 * hk;
        const LAS float* a2p = A2 + 256 * wave + 16 * hk; const LAS float* b2p = B2 + 256 * wave + 16 * hk;
        f32x16 acc = {0.f, 0.f, 0.f, 0.f, 0.f, 0.f, 0.f, 0.f, 0.f, 0.f, 0.f, 0.f, 0.f, 0.f, 0.f, 0.f};
#pragma unroll 2
        for (int kb = 0; kb < 8; ++kb) {
            f32x4 xv[4], wv[4];
#pragma unroll
            for (int q = 0; q < 4; ++q) { xv[q] = *(const GAS f32x4*)(xrow + 32 * kb + 4 * q); wv[q] = *(const GAS f32x4*)(wrow + 32 * kb + 4 * q); }
#pragma unroll
            for (int q = 0; q < 4; ++q) { const f32x4 av = *(const LAS f32x4*)(a2p + 32 * kb + 4 * q), bv = *(const LAS f32x4*)(b2p + 32 * kb + 4 * q); xv[q] = xv[q] * rstd_i * av + bv; }
#pragma unroll
            for (int q = 0; q < 4; ++q) {
                acc = __builtin_amdgcn_mfma_f32_32x32x2f32(xv[q].x, wv[q].x, acc, 0, 0, 0); acc = __builtin_amdgcn_mfma_f32_32x32x2f32(xv[q].y, wv[q].y, acc, 0, 0, 0);
                acc = __builtin_amdgcn_mfma_f32_32x32x2f32(xv[q].z, wv[q].z, acc, 0, 0, 0); acc = __builtin_amdgcn_mfma_f32_32x32x2f32(xv[q].w, wv[q].w, acc, 0, 0, 0); }
        }
#pragma unroll
        for (int r = 0; r < 16; ++r) part[(wave * 32 + (r & 3) + 8 * (r >> 2) + 4 * hk) * 33 + i] = acc[r];
    }
    __syncthreads();
#pragma unroll
    for (int o = tid; o < 1024; o += 512) { const int tok = o >> 5, e = o & 31; float s = br[e];
#pragma unroll
        for (int w = 0; w < 8; ++w) s += part[(w * 32 + tok) * 33 + e];
        lg[tok * 33 + e] = s; }
    __syncthreads();
#pragma unroll
    for (int p = 0; p < 2; ++p) {
        const int tok = 4 * wave + 2 * p + (lane >> 5), e = lane & 31;
        float v = lg[tok * 33 + e]; float tv[4]; int ti[4];
#pragma unroll
        for (int k = 0; k < 4; ++k) { const float m = half_max(v); const int idx = min(half_min(v == m ? e : 64), 31);     tv[k] = m; ti[k] = idx; v = (e == idx) ? -3.0e38f : v; }
        const float p1 = __expf(tv[1] - tv[0]), p2 = __expf(tv[2] - tv[0]), p3 = __expf(tv[3] - tv[0]); const float inv = 1.0f / (1.0f + p1 + p2 + p3);
        if (e == 0) { const int t = 32 * bid + tok;
            *(GAS i32x4*)(TOPI + t * 4) = (i32x4){ti[0], ti[1], ti[2], ti[3]}; *(GAS f32x4*)(TOPW + t * 4) = (f32x4){inv, p1 * inv, p2 * inv, p3 * inv};
            eidx[tok * 4 + 0] = ti[0]; eidx[tok * 4 + 1] = ti[1]; eidx[tok * 4 + 2] = ti[2]; eidx[tok * 4 + 3] = ti[3]; }
    }
    __syncthreads();
    LAS int* cbase = (LAS int*)(lds + 16384 + 1024);
    int rank = 0, em = 0;
    if (tid < 128) { em = eidx[tid]; for (int q = 0; q < tid; ++q) rank += (eidx[q] == em) ? 1 : 0; }
    if (tid < 32) { int cnt = 0; for (int q = 0; q < 128; ++q) cnt += (eidx[q] == tid) ? 1 : 0;
        cbase[tid] = cnt ? __hip_atomic_fetch_add((int*)(ws + WS_ECNT) + 16 * tid, cnt, __ATOMIC_RELAXED, __HIP_MEMORY_SCOPE_AGENT) : 0; }
    __syncthreads();
    if (tid < 128) { const int r = cbase[em] + rank; ((int*)(ws + WS_TRANK))[32 * bid * 4 + tid] = r; ((int*)(ws + WS_STOK))[em * 8192 + r] = 32 * bid + (tid >> 2); }
}

__device__ __forceinline__ void moe_tables(const int* ECNT, LAS unsigned char* lds, int tid) {
    LAS int* totp = (LAS int*)lds;
    LAS int* tile_e = (LAS int*)(lds + TILE_OFF); LAS int* ntl = tile_e + 160; LAS int* pstart = (LAS int*)(lds + TILE_OFF + 1024);
    if (tid < 32) { const int tot = ECNT[16 * tid]; totp[tid] = tot; ((LAS int*)(lds + TILE_OFF + 1280))[tid] = tot; }
    __syncthreads();
    if (tid == 0) { int ps = 0, nt = 0;
        for (int e = 0; e < NE; ++e) { const int c = totp[e]; const int npad = (c + 255) >> 8; pstart[e] = ps; for (int k = 0; k < npad; ++k) { if (nt < 160) tile_e[nt] = e; ++nt; } ps += npad * 256; }
        *ntl = nt < 160 ? nt : 160; }
    __syncthreads();
}

__device__ __forceinline__ void phase12(KP kp, LAS unsigned char* lds, int wave, int bid, int G) {
    const int lane = fresh_lane();
    unsigned char* ws = KWS();
    const float* X1 = (const float*)(ws + WS_X1); const bf16* YS = (const bf16*)(ws + WS_YS); const float* mod = (const float*)(ws + WS_MOD); const float* fg = (const float*)KIN(23);
    const int* TOPI = (const int*)(ws + WS_TOPI); const int* TRANK = (const int*)(ws + WS_TRANK); const float* TOPW = (const float*)(ws + WS_TOPW);
    const LAS int* pstart = (const LAS int*)(lds + TILE_OFF + 1024);
    for (int m = bid * NWAVES + wave; m < T; m += G * NWAVES) {
        const GAS f32x4* xr = (const GAS f32x4*)(X1 + (size_t)m * DM) + lane;
        const i32x4 te = *(const GAS i32x4*)(TOPI + m * 4), rk = *(const GAS i32x4*)(TRANK + m * 4); const f32x4 tw = *(const GAS f32x4*)(TOPW + m * 4);
        const i32x4 sl = (i32x4){pstart[te.x] + rk.x, pstart[te.y] + rk.y, pstart[te.z] + rk.z, pstart[te.w] + rk.w};
        const GAS u32x2* y0 = (const GAS u32x2*)(YS + (size_t)sl.x * DM) + lane; const GAS u32x2* y1 = (const GAS u32x2*)(YS + (size_t)sl.y * DM) + lane;
        const GAS u32x2* y2 = (const GAS u32x2*)(YS + (size_t)sl.z * DM) + lane; const GAS u32x2* y3 = (const GAS u32x2*)(YS + (size_t)sl.w * DM) + lane;
        f32x4 v[8]; float s = 0.f;
#pragma unroll
        for (int j = 0; j < 8; ++j) {
            const f32x4 mo = tw.x * unpack4(y0[64 * j]) + tw.y * unpack4(y1[64 * j]) + tw.z * unpack4(y2[64 * j]) + tw.w * unpack4(y3[64 * j]);
            const f32x4 g2 = *(const GAS f32x4*)(mod + 5 * 2048 + 256 * j + 4 * lane);
            v[j] = xr[64 * j] + g2 * mo; s += dot4(v[j], v[j]); }
        const float rstd = 1.0f / sqrtf(wave_sum(s) * (1.0f / DM) + EPS);
        GAS f32x4* o = (GAS f32x4*)(KOUT() + (size_t)m * DM) + lane;
#pragma unroll
        for (int j = 0; j < 8; ++j) o[64 * j] = v[j] * rstd * *(const GAS f32x4*)(fg + 256 * j + 4 * lane);
    }
}

__device__ __forceinline__ void phase3(KP kp, char* lds, LAS unsigned char* ldsl, int wave, int bid, int G) {
    typedef attn::bf16 abf;
    const int tid = wave * 64 + fresh_lane();
    unsigned char* ws = KWS();
    const abf* Qb = (const abf*)(ws + WS_Q); const abf* Kb = (const abf*)(ws + WS_K); const abf* Vb = (const abf*)(ws + WS_V); abf* OAp = (abf*)(ws + WS_OA);
    for (int L = bid; L < 256; L += G) {
        const int x = L & 7, s = L >> 3, j = 2 * x + (s >> 4), y = s & 15;
#pragma unroll 1
        for (int pass = 0; pass < 2; ++pass) {
            const int qb = (pass ^ (y & 1)) ? y : 31 - y;
            attn3::Blk B; B.Q = Qb + ((size_t)j * T + (size_t)qb * 256) * 128; B.K = Kb + (size_t)j * T * 128;
            B.V0 = Vb + (size_t)((j >> 1) * 2) * T * 128; B.V1 = B.V0 + (size_t)T * 128;
            B.O = OAp + (size_t)(qb * 256) * 4096 + j * 256; B.P0 = qb * 256;
            const int tid_p = wave * 64 + fresh_lane();
            attn3::block(B, lds, ldsl, tid_p);
            if (pass == 0) { conv_run(kargs(), KWS(), (LAS unsigned*)(ldsl + wave * 8320), fresh_lane(), 32 * 256 + bid * NWAVES + wave, CONV_UP_END, G * NWAVES); __syncthreads(); }
        }
    }
}

__global__ void __launch_bounds__(NWAVES * 64, 2) mk_fwd(Args args) {
    extern __shared__ __attribute__((aligned(16))) unsigned char lds_raw[];
    LAS unsigned char* lds = (LAS unsigned char*)lds_raw;
    volatile LAS unsigned* MISC = (volatile LAS unsigned*)(lds + MISC_OFF);
    const int wave = __builtin_amdgcn_readfirstlane(threadIdx.x >> 6);
    const int G = gridDim.x, bid = blockIdx.x;
    const int lo = ((const __attribute__((address_space(4))) int*)__builtin_amdgcn_kernarg_segment_ptr())[52], hi = ((const __attribute__((address_space(4))) int*)__builtin_amdgcn_kernarg_segment_ptr())[53];
    XcdBarrier bar;
    { KP kp = kargs(); gu32* ctl = (gu32*)(KWS() + WS_CTL);
      const int tid = wave * 64 + fresh_lane();
      for (int u = tid; u < (LDS_BYTES - LDSCTL_OFF) / 4; u += NWAVES * 64) ((LAS unsigned*)(lds + LDSCTL_OFF))[u] = 0u;
      __syncthreads();
      bar.bar = (unsigned*)(ctl + CW_BAR); bar.x = 0; bar.st = nullptr;
      if (hi - lo > 1) bar = xcd_barrier_post((unsigned*)(ctl + CW_BAR), MISC + 8); }
#ifndef PH_MASK
#define PH_MASK 0x1FFF
#endif
#define IN(k) (((PH_MASK >> (k)) & 1) && lo <= (k) && (k) < hi)
#ifndef PH_DUP
#define PH_DUP 0
#endif
#define REP(k) for (int rep_ = 0; rep_ <= ((PH_DUP >> (k)) & 1); ++rep_)
#define REPBAR() do { if (rep_) xcd_barrier(bar, wave * 64 + fresh_lane()); } while (0)
#define NEXTPH(k) ((k) == 5 ? 7 : (k) == 8 ? 10 : (k) + 1)
#define SEAM(k) do { if (IN(k) && IN(NEXTPH(k))) xcd_barrier(bar, wave * 64 + fresh_lane()); } while (0)

    if (IN(0)) { REP(0) { REPBAR(); phase0(kargs(), lds, wave, bid, G); } SEAM(0); }
    if (IN(1)) { REP(1) { REPBAR(); phase1(kargs(), lds, wave, bid, G); } SEAM(1); }
    if (IN(2)) {
        REP(2) { REPBAR();
        KP kp = kargs(); unsigned char* ws = KWS();
        pg8::Gemm g{(const pg8::bf16_t*)(ws + WS_H), (const pg8::bf16_t*)(ws + WS_WIN), T, 16384, 2048, 0, 1};
        pg8::StaticOrder S; S.init(T, 16384, G, bid);
        pg8::EpiInProj E{(pg8::bf16_t*)(ws + WS_Q), (pg8::bf16_t*)(ws + WS_K), (pg8::bf16_t*)(ws + WS_V), (pg8::bf16_t*)(ws + WS_R), (const float*)(ws + WS_ROPE)};
        pg8::gemm_phase<pg8::EpiInProj, pg8::StaticOrder, true, true>(lds + RING_OFF, g, S, E, wave * 64 + fresh_lane());
        }
        SEAM(2);
    }
    if (IN(3)) { REP(3) { REPBAR(); phase3(kargs(), (char*)lds_raw + RING_OFF, lds + RING_OFF, wave, bid, G); } SEAM(3); }
    if (IN(4)) { REP(4) { REPBAR(); phase4(kargs(), wave, bid, G); } SEAM(4); }
    if (IN(5)) {
        REP(5) { REPBAR();
        KP kp = kargs(); unsigned char* ws = KWS();
        pg8::Gemm g{(const pg8::bf16_t*)(ws + WS_ON), (const pg8::bf16_t*)(ws + WS_WAO), T, 2048, 4096, 0, 1};
        pg8::StaticOrder S; S.init(T, 2048, G, bid);
        pg8::EpiMerge2 E{(pg8::bf16_t*)(ws + WS_MG), (const pg8::bf16_t*)(ws + WS_R)};
        pg8::gemm_phase<pg8::EpiMerge2, pg8::StaticOrder, true, true>(lds + RING_OFF, g, S, E, wave * 64 + fresh_lane());
        }
        SEAM(5);
    }
    if (IN(7)) {
        REP(7) { REPBAR();
        KP kp = kargs(); unsigned char* ws = KWS();
        pg8::Gemm g{(const pg8::bf16_t*)(ws + WS_MG), (const pg8::bf16_t*)(ws + WS_WO), T, 2048, 2048, 0, 1};
        pg8::StaticOrder S; S.init(T, 2048, G, bid);
        pg8::EpiResid E{(const float*)KIN(0), (float*)(ws + WS_X1), (const float*)(ws + WS_MOD) + 2 * 2048};
        pg8::gemm_phase<pg8::EpiResid, pg8::StaticOrder, true, true>(lds + RING_OFF, g, S, E, wave * 64 + fresh_lane());
        }
        SEAM(7);
    }
    if (IN(8)) { REP(8) { REPBAR(); phase8(kargs(), lds, wave, bid); } SEAM(8); }
    if (IN(10)) {
        REP(10) { REPBAR();
        KP kp = kargs(); unsigned char* ws = KWS();
        moe_tables((const int*)(ws + WS_ECNT), lds, wave * 64 + fresh_lane());
        const LAS int* tile_e = (const LAS int*)(lds + TILE_OFF); const int nTiles = tile_e[160];
        pg8::Gemm g{(const pg8::bf16_t*)(ws + WS_H), (const pg8::bf16_t*)(ws + WS_WUP), nTiles * 256, 4096, 2048, (size_t)4096 * 2048 * 2, 1};
        pg8::MoeOrder<true> S; S.init(nTiles, 4096, G, bid, tile_e); S.tab = (const LAS int*)(lds + TOKTAB_OFF);
        { const int tid = wave * 64 + fresh_lane(); const int* STOK = (const int*)(ws + WS_STOK); LAS int* tab = (LAS int*)(lds + TOKTAB_OFF);
          const LAS int* pstart = (const LAS int*)(lds + TILE_OFF + 1024); const LAS int* etot = (const LAS int*)(lds + TILE_OFF + 1280);
          for (int i = 0; i < 10; ++i) { pg8::Unit u; if (!S.next(i, u)) break;
              if (tid < 256) { const int rr = u.pm * 256 + tid - pstart[u.e]; const bool valid = rr < etot[u.e]; tab[i * 256 + tid] = valid ? STOK[u.e * 8192 + rr] : 0; } }
          __syncthreads(); }
        pg8::EpiSwiglu E{(pg8::bf16_t*)(ws + WS_ACT), (const float*)KIN(20)};
        const int slot = (bid >> 3) & 7;
        if (slot > 0) { S.i0 = 0; S.imax = slot; pg8::gemm_phase<pg8::EpiSwiglu, pg8::MoeOrder<true>, true, true>(lds + RING_OFF, g, S, E, wave * 64 + fresh_lane()); }
        {
          constexpr int CONV_D = 68; const int nwg = nTiles * 16, rem = nwg - (nwg / G) * G; const long I = CONV_ALL_ITEMS - CONV_UP_END;
          const long Sl = I + (long)CONV_D * rem, Sh = Sl - (long)CONV_D * G;
          const long P0 = bid < rem ? bid * Sh : rem * Sh + (bid - rem) * Sl, P1 = P0 + (bid < rem ? Sh : Sl);
          conv_moe_range(kargs(), lds, wave, CONV_UP_END + (int)(P0 / G), CONV_UP_END + (int)(P1 / G)); }
        S.i0 = slot; S.imax = 1 << 30;
        pg8::gemm_phase<pg8::EpiSwiglu, pg8::MoeOrder<true>, true, true>(lds + RING_OFF, g, S, E, wave * 64 + fresh_lane());
        }
        SEAM(10);
    }
    if (IN(11)) {
        REP(11) { REPBAR();
        KP kp = kargs(); unsigned char* ws = KWS();
        if (!IN(10)) moe_tables((const int*)(ws + WS_ECNT), lds, wave * 64 + fresh_lane());
        const LAS int* tile_e = (const LAS int*)(lds + TILE_OFF); const int nTiles = tile_e[160];
        pg8::Gemm g{(const pg8::bf16_t*)(ws + WS_ACT), (const pg8::bf16_t*)(ws + WS_WDN), nTiles * 256, 2048, 2048, (size_t)2048 * 2048 * 2, 1};
        pg8::MoeOrder<false> S; S.init(nTiles, 2048, G, bid, tile_e);
        pg8::EpiDown E{(pg8::bf16_t*)(ws + WS_YS), (const float*)KIN(22)};
        pg8::gemm_phase<pg8::EpiDown, pg8::MoeOrder<false>, true, true>(lds + RING_OFF, g, S, E, wave * 64 + fresh_lane());
        }
        SEAM(11);
    }
    if (IN(12)) { REP(12) { REPBAR(); if (!IN(11)) { KP kp = kargs(); moe_tables((const int*)(KWS() + WS_ECNT), lds, wave * 64 + fresh_lane()); } phase12(kargs(), lds, wave, bid, G); } }
#undef IN
#undef SEAM
}

extern "C" void kernel_launch(void* const* d_in, const int* in_sizes, int n_in, void* d_out, int out_size, void* d_ws, size_t ws_size, hipStream_t stream) {
    static int grid = 0;
    if (grid == 0) {
        if (n_in != 24 || out_size != T * DM || ws_size < WS_END) { fprintf(stderr, "kernel_launch: unexpected shapes (n_in %d, out %d, ws %zu)\n", n_in, out_size, ws_size); grid = -1; return; }
        if (hipFuncSetAttribute((const void*)mk_fwd, hipFuncAttributeMaxDynamicSharedMemorySize, LDS_BYTES) != hipSuccess) { fprintf(stderr, "kernel_launch: hipFuncSetAttribute failed\n"); grid = -1; return; }
        int per_cu = 0;
        if (hipOccupancyMaxActiveBlocksPerMultiprocessor(&per_cu, (const void*)mk_fwd, NWAVES * 64, LDS_BYTES) != hipSuccess || per_cu < 1) fprintf(stderr, "kernel_launch: occupancy query reports %d\n", per_cu);
        (void)hipGetLastError();
        grid = 256;
    }
    if (grid < 0) return;
    if (hipMemsetAsync((char*)d_ws + WS_CTL, 0, CTL_ZERO_BYTES, stream) != hipSuccess) { fprintf(stderr, "kernel_launch: memset failed\n"); return; }
    Args a{};
    for (int i = 0; i < 24; ++i) a.in[i] = d_in[i];
    a.out = (float*)d_out; a.ws = (unsigned char*)d_ws;
#if MK_ONE_LAUNCH
    a.ph_lo = 0; a.ph_hi = NPHASE; a.li = 0; a.pad = 0;
    hipLaunchKernelGGL(mk_fwd, dim3(grid), dim3(NWAVES * 64), LDS_BYTES, stream, a);
#else
    for (int p = 0; p < NPHASE; ++p) { a.ph_lo = p; a.ph_hi = p + 1; a.li = p; a.pad = 0;
        hipLaunchKernelGGL(mk_fwd, dim3(grid), dim3(NWAVES * 64), LDS_BYTES, stream, a); }
#endif
}
```

```cpp
#include <hip/hip_runtime.h>
#include <hip/hip_bf16.h>
#include <cstdio>
#include <cstdint>
namespace pg8 {
#define PG8_LAS __attribute__((address_space(3)))
typedef unsigned short bf16_t;
typedef short bf16x8 __attribute__((ext_vector_type(8)));
typedef float f32x4 __attribute__((ext_vector_type(4)));
typedef unsigned u32x4 __attribute__((ext_vector_type(4)));
constexpr int BM = 256, BK = 64, HALF = 128, HTB = HALF * BK * 2  , STAGE_BYTES = 8 * HTB, NXCD = 8, WGM = 8;

__host__ __device__ __forceinline__ int lds_byte(int r, int c) { const int st = (r >> 4) * 2 + (c >> 5), rr = r & 15, cc = c & 31, ob = rr * 64 + cc * 2; return st * 1024 + (ob ^ (((ob >> 9) & 1) << 5)); }
__host__ __device__ __forceinline__ void stage_rc(int b, int& R, int& C) { const int st = b / 1024, sb = b % 1024, swz = sb ^ (((sb >> 9) & 1) << 5); R = (st >> 1) * 16 + swz / 64; C = (st & 1) * 32 + (swz % 64) / 2; }
__host__ __device__ __forceinline__ int perm32(int rho) { const int n = rho >> 4, i = rho & 15; return 8 * (i >> 2) + 4 * n + (i & 3); }

struct Unit { int pm, pn, e; };
struct Gemm { const bf16_t* A; const bf16_t* Bt; int M, N, K; size_t estride; int btiled; };

struct StaticOrder {
    int nM, nN, nwg, G, c, i0 = 0, imax = 1 << 30;
    __host__ __device__ void init(int M, int N, int G_, int c_) { nM = M / BM; nN = N / BM; nwg = nM * nN; G = G_; c = c_; }
    __host__ __device__ bool next(int i, Unit& u) const {
        if (i + i0 >= imax) return false; const long L = (long)(i + i0) * G + c; if (L >= nwg) return false;
        int wgid = (int)L; { const int q = nwg / NXCD, r = nwg % NXCD, xcd = wgid % NXCD, off = wgid / NXCD; wgid = (xcd < r ? xcd * (q + 1) : r * (q + 1) + (xcd - r) * q) + off; }
        const int nig = WGM * nN, gid = wgid / nig, fm = gid * WGM, gsz = (nM - fm) < WGM ? (nM - fm) : WGM;
        u.pm = fm + ((wgid % nig) % gsz); u.pn = (wgid % nig) / gsz; u.e = 0; return true;
    }
    static constexpr bool GATHER = false;
    __device__ __forceinline__ int row_tok(int, int) const { return 0; }
    __device__ __forceinline__ void a_ready(const Unit&) const {}
    __device__ __forceinline__ void done(const Unit&) const {}
};


typedef unsigned u32x2 __attribute__((ext_vector_type(2)));
constexpr int T_ROWS = 8192, R_LD = 10240;
__device__ __forceinline__ unsigned cvt_pk_bf16(float lo, float hi) { unsigned r; asm volatile("v_cvt_pk_bf16_f32 %0, %1, %2" : "=v"(r) : "v"(lo), "v"(hi)); return r; }
__device__ __forceinline__ u32x2 pk4(f32x4 v) { u32x2 w; w.x = cvt_pk_bf16(v[0], v[1]); w.y = cvt_pk_bf16(v[2], v[3]); return w; }
__device__ __forceinline__ float bf_lo(unsigned w) { return __uint_as_float(w << 16); }
__device__ __forceinline__ float bf_hi(unsigned w) { return __uint_as_float(w & 0xffff0000u); }
__device__ __forceinline__ float sigm(float x) { return __builtin_amdgcn_rcpf(1.0f + __expf(-x)); }
__device__ __forceinline__ f32x4 sig4(u32x2 g) { return (f32x4){sigm(bf_lo(g.x)), sigm(bf_hi(g.x)), sigm(bf_lo(g.y)), sigm(bf_hi(g.y))}; }

struct EpiInProj {
    static constexpr bool PERM = true, AFTER_DRAIN = false, HAS_MID = false;
    bf16_t* Q; bf16_t* K; bf16_t* V; bf16_t* R; const float* rope;
    __device__ __forceinline__ void operator()(const f32x4 (&acc)[2][2][4][2], const Unit& u, int wr, int wc, int fr, int fq) const {
        const int row0 = u.pm * BM + wr * 64 + fr; const int pn = u.pn;
        if (pn < 16) {
            bf16_t* base = (pn < 8) ? Q : K; const int hp = (pn & 7) * 2; const float sgn = (fq >= 2) ? 1.0f : -1.0f;
#pragma unroll
            for (int ai = 0; ai < 2; ++ai)
#pragma unroll
                for (int m = 0; m < 4; ++m) { const int row = row0 + ai * HALF + m * 16;
                    f32x4 cs0 = (f32x4){1.f, 1.f, 1.f, 1.f}, cs1 = cs0, sn0 = (f32x4){0.f, 0.f, 0.f, 0.f}, sn1 = sn0;
                    if (wc == 0) { const float* rp = rope + (size_t)row * 32 + 8 * (fq & 1); cs0 = *(const f32x4*)rp; cs1 = *(const f32x4*)(rp + 4); sn0 = *(const f32x4*)(rp + 16) * sgn; sn1 = *(const f32x4*)(rp + 20) * sgn; }
#pragma unroll
                    for (int bj = 0; bj < 2; ++bj) { f32x4 v0 = acc[ai][bj][m][0], v1 = acc[ai][bj][m][1];
                        if (wc == 0) { f32x4 p0, p1;
#pragma unroll
                            for (int i = 0; i < 4; ++i) { p0[i] = __shfl_xor(v0[i], 32); p1[i] = __shfl_xor(v1[i], 32); }
                            v0 = v0 * cs0 + p0 * sn0; v1 = v1 * cs1 + p1 * sn1; }
                        u32x4 w; w.x = cvt_pk_bf16(v0[0], v0[1]); w.y = cvt_pk_bf16(v0[2], v0[3]); w.z = cvt_pk_bf16(v1[0], v1[1]); w.w = cvt_pk_bf16(v1[2], v1[3]);
                        *(u32x4*)(base + ((size_t)(hp + bj) * T_ROWS + row) * 128 + wc * 32 + 8 * fq) = w; } }
        } else if (pn < 24) {
            const int hv = (pn - 16) * 2;
#pragma unroll
            for (int ai = 0; ai < 2; ++ai)
#pragma unroll
                for (int m = 0; m < 4; ++m) { const int row = row0 + ai * HALF + m * 16;
#pragma unroll
                    for (int bj = 0; bj < 2; ++bj) { const f32x4 v0 = acc[ai][bj][m][0], v1 = acc[ai][bj][m][1];
                        u32x4 w; w.x = cvt_pk_bf16(v0[0], v0[1]); w.y = cvt_pk_bf16(v0[2], v0[3]); w.z = cvt_pk_bf16(v1[0], v1[1]); w.w = cvt_pk_bf16(v1[2], v1[3]);
                        *(u32x4*)(V + ((size_t)(hv + bj) * T_ROWS + row) * 128 + wc * 32 + 8 * fq) = w; } }
        } else {
            const int col0 = (pn - 24) * BM + wc * 32 + 8 * fq;
#pragma unroll
            for (int ai = 0; ai < 2; ++ai)
#pragma unroll
                for (int m = 0; m < 4; ++m) { const int row = row0 + ai * HALF + m * 16;
#pragma unroll
                    for (int bj = 0; bj < 2; ++bj) { const f32x4 v0 = acc[ai][bj][m][0], v1 = acc[ai][bj][m][1];
                        u32x4 w; w.x = cvt_pk_bf16(v0[0], v0[1]); w.y = cvt_pk_bf16(v0[2], v0[3]); w.z = cvt_pk_bf16(v1[0], v1[1]); w.w = cvt_pk_bf16(v1[2], v1[3]);
                        *(u32x4*)(R + (size_t)row * R_LD + col0 + bj * HALF) = w; } }
        }
    }
};
struct EpiGate {
    static constexpr bool PERM = false, AFTER_DRAIN = false, HAS_MID = false;
    float* C; const bf16_t* G;
    __device__ __forceinline__ void operator()(const f32x4 (&acc)[2][2][4][2], const Unit& u, int wr, int wc, int fr, int fq) const {
        const int row0 = u.pm * BM + wr * 64 + fr, col0 = u.pn * BM + wc * 32 + 4 * fq;
#pragma unroll
        for (int ai = 0; ai < 2; ++ai)
#pragma unroll
            for (int m = 0; m < 4; ++m) { const int row = row0 + ai * HALF + m * 16;
#pragma unroll
                for (int bj = 0; bj < 2; ++bj)
#pragma unroll
                    for (int n = 0; n < 2; ++n) { const int col = col0 + bj * HALF + n * 16;
                        const u32x2 g = *(const u32x2*)(G + (size_t)row * R_LD + col);
                        *(f32x4*)(C + (size_t)row * 2048 + col) = acc[ai][bj][m][n] * sig4(g); } }
    }
};
struct EpiMerge {
    static constexpr bool PERM = false, AFTER_DRAIN = false, HAS_MID = false;
    const float* Tm; bf16_t* O; const bf16_t* G;
    __device__ __forceinline__ void operator()(const f32x4 (&acc)[2][2][4][2], const Unit& u, int wr, int wc, int fr, int fq) const {
        const int row0 = u.pm * BM + wr * 64 + fr, col0 = u.pn * BM + wc * 32 + 4 * fq;
#pragma unroll
        for (int ai = 0; ai < 2; ++ai)
#pragma unroll
            for (int m = 0; m < 4; ++m) { const int row = row0 + ai * HALF + m * 16;
#pragma unroll
                for (int bj = 0; bj < 2; ++bj)
#pragma unroll
                    for (int n = 0; n < 2; ++n) { const int col = col0 + bj * HALF + n * 16;
                        const u32x2 g = *(const u32x2*)(G + (size_t)row * R_LD + col);
                        const f32x4 tv = *(const f32x4*)(Tm + (size_t)row * 2048 + col);
                        *(u32x2*)(O + (size_t)row * 2048 + col) = pk4(tv + acc[ai][bj][m][n] * sig4(g)); } }
    }
};
struct EpiMerge2 {
    static constexpr bool PERM = true, AFTER_DRAIN = false, HAS_MID = true;
    bf16_t* O; const bf16_t* R;
    static __device__ __forceinline__ float ex(float x) { return __expf(fminf(-x, 60.f)); }
    __device__ __forceinline__ void mid(f32x4 (&acc)[2][2][4][2], const Unit& u, int wr, int wc, int fr, int fq) const {
        const int row0 = u.pm * BM + wr * 64 + fr, col0 = u.pn * BM + wc * 32 + 8 * fq;
        const bf16_t* rp0 = R + (size_t)row0 * R_LD + col0;
#pragma unroll
        for (int ai = 0; ai < 2; ++ai)
#pragma unroll
            for (int m = 0; m < 4; ++m) {
                int off = (ai * HALF + m * 16) * R_LD; asm volatile("" : "+s"(off) :: "memory");
                const bf16_t* rp = rp0 + off;
#pragma unroll
                for (int bj = 0; bj < 2; ++bj) {
                    const u32x4 ga = *(const u32x4*)(rp + 6144 + bj * HALF), gc = *(const u32x4*)(rp + 8192 + bj * HALF);
                    f32x4 r0, r1;
                    r0[0] = (1.0f + ex(bf_lo(gc.x))) * __builtin_amdgcn_rcpf(1.0f + ex(bf_lo(ga.x))); r0[1] = (1.0f + ex(bf_hi(gc.x))) * __builtin_amdgcn_rcpf(1.0f + ex(bf_hi(ga.x)));
                    r0[2] = (1.0f + ex(bf_lo(gc.y))) * __builtin_amdgcn_rcpf(1.0f + ex(bf_lo(ga.y))); r0[3] = (1.0f + ex(bf_hi(gc.y))) * __builtin_amdgcn_rcpf(1.0f + ex(bf_hi(ga.y)));
                    r1[0] = (1.0f + ex(bf_lo(gc.z))) * __builtin_amdgcn_rcpf(1.0f + ex(bf_lo(ga.z))); r1[1] = (1.0f + ex(bf_hi(gc.z))) * __builtin_amdgcn_rcpf(1.0f + ex(bf_hi(ga.z)));
                    r1[2] = (1.0f + ex(bf_lo(gc.w))) * __builtin_amdgcn_rcpf(1.0f + ex(bf_lo(ga.w))); r1[3] = (1.0f + ex(bf_hi(gc.w))) * __builtin_amdgcn_rcpf(1.0f + ex(bf_hi(ga.w)));
                    acc[ai][bj][m][0] *= r0; acc[ai][bj][m][1] *= r1; }
                asm volatile("" : "+v"(acc[ai][0][m][0]), "+v"(acc[ai][0][m][1]), "+v"(acc[ai][1][m][0]), "+v"(acc[ai][1][m][1]) :: "memory"); }
    }
    __device__ __forceinline__ void operator()(const f32x4 (&acc)[2][2][4][2], const Unit& u, int wr, int wc, int fr, int fq) const {
        const int row0 = u.pm * BM + wr * 64 + fr, col0 = u.pn * BM + wc * 32 + 8 * fq;
#pragma unroll
        for (int ai = 0; ai < 2; ++ai)
#pragma unroll
            for (int m = 0; m < 4; ++m) { const int row = row0 + ai * HALF + m * 16;
#pragma unroll
                for (int bj = 0; bj < 2; ++bj) { const int col = col0 + bj * HALF;
                    const u32x4 gc = *(const u32x4*)(R + (size_t)row * R_LD + 8192 + col);
                    f32x4 s0, s1;
                    s0[0] = __builtin_amdgcn_rcpf(1.0f + ex(bf_lo(gc.x))); s0[1] = __builtin_amdgcn_rcpf(1.0f + ex(bf_hi(gc.x))); s0[2] = __builtin_amdgcn_rcpf(1.0f + ex(bf_lo(gc.y))); s0[3] = __builtin_amdgcn_rcpf(1.0f + ex(bf_hi(gc.y)));
                    s1[0] = __builtin_amdgcn_rcpf(1.0f + ex(bf_lo(gc.z))); s1[1] = __builtin_amdgcn_rcpf(1.0f + ex(bf_hi(gc.z))); s1[2] = __builtin_amdgcn_rcpf(1.0f + ex(bf_lo(gc.w))); s1[3] = __builtin_amdgcn_rcpf(1.0f + ex(bf_hi(gc.w)));
                    const f32x4 v0 = acc[ai][bj][m][0] * s0, v1 = acc[ai][bj][m][1] * s1;
                    u32x4 w; w.x = cvt_pk_bf16(v0[0], v0[1]); w.y = cvt_pk_bf16(v0[2], v0[3]); w.z = cvt_pk_bf16(v1[0], v1[1]); w.w = cvt_pk_bf16(v1[2], v1[3]);
                    *(u32x4*)(O + (size_t)row * 2048 + col) = w; } }
    }
};
struct EpiResid {
    static constexpr bool PERM = false, AFTER_DRAIN = false, HAS_MID = false;
    const float* X; float* O; const float* gate;
    __device__ __forceinline__ void operator()(const f32x4 (&acc)[2][2][4][2], const Unit& u, int wr, int wc, int fr, int fq) const {
        const int row0 = u.pm * BM + wr * 64 + fr, col0 = u.pn * BM + wc * 32 + 4 * fq;
        f32x4 gv[2][2];
#pragma unroll
        for (int bj = 0; bj < 2; ++bj)
#pragma unroll
            for (int n = 0; n < 2; ++n) gv[bj][n] = *(const f32x4*)(gate + col0 + bj * HALF + n * 16);
#pragma unroll
        for (int ai = 0; ai < 2; ++ai)
#pragma unroll
            for (int m = 0; m < 4; ++m) { const int row = row0 + ai * HALF + m * 16;
#pragma unroll
                for (int bj = 0; bj < 2; ++bj)
#pragma unroll
                    for (int n = 0; n < 2; ++n) { const size_t off = (size_t)row * 2048 + col0 + bj * HALF + n * 16;
                        *(f32x4*)(O + off) = *(const f32x4*)(X + off) + gv[bj][n] * acc[ai][bj][m][n]; } }
    }
};
__device__ __forceinline__ float swiglu1(float g, float l) { g = fminf(g, 7.0f); l = fminf(fmaxf(l, -7.0f), 7.0f); return g * sigm(1.702f * g) * (l + 1.0f); }
struct EpiSwiglu {
    static constexpr bool PERM = true, AFTER_DRAIN = false, HAS_MID = false;
    bf16_t* O; const float* bias;
    __device__ __forceinline__ void operator()(const f32x4 (&acc)[2][2][4][2], const Unit& u, int wr, int wc, int fr, int fq) const {
        const int row0 = u.pm * BM + wr * 64 + fr, col0 = u.pn * BM + wc * 32 + 8 * fq; const float* bb = bias + (size_t)u.e * 4096;
        f32x4 bv[2][2];
#pragma unroll
        for (int bj = 0; bj < 2; ++bj)
#pragma unroll
            for (int n = 0; n < 2; ++n) bv[bj][n] = *(const f32x4*)(bb + col0 + bj * HALF + 4 * n);
#pragma unroll
        for (int ai = 0; ai < 2; ++ai)
#pragma unroll
            for (int m = 0; m < 4; ++m) { const int row = row0 + ai * HALF + m * 16;
#pragma unroll
                for (int bj = 0; bj < 2; ++bj) { const f32x4 v0 = acc[ai][bj][m][0] + bv[bj][0], v1 = acc[ai][bj][m][1] + bv[bj][1];
                    u32x2 w; w.x = cvt_pk_bf16(swiglu1(v0[0], v0[1]), swiglu1(v0[2], v0[3])); w.y = cvt_pk_bf16(swiglu1(v1[0], v1[1]), swiglu1(v1[2], v1[3]));
                    *(u32x2*)(O + (size_t)row * 2048 + ((col0 + bj * HALF) >> 1)) = w; } }
    }
};
struct EpiDown {
    static constexpr bool PERM = true, AFTER_DRAIN = false, HAS_MID = false;
    bf16_t* O; const float* bias;
    __device__ __forceinline__ void operator()(const f32x4 (&acc)[2][2][4][2], const Unit& u, int wr, int wc, int fr, int fq) const {
        const int row0 = u.pm * BM + wr * 64 + fr, col0 = u.pn * BM + wc * 32 + 8 * fq; const float* bb = bias + (size_t)u.e * 2048;
        f32x4 bv[2][2];
#pragma unroll
        for (int bj = 0; bj < 2; ++bj)
#pragma unroll
            for (int n = 0; n < 2; ++n) bv[bj][n] = *(const f32x4*)(bb + col0 + bj * HALF + 4 * n);
#pragma unroll
        for (int ai = 0; ai < 2; ++ai)
#pragma unroll
            for (int m = 0; m < 4; ++m) { const int row = row0 + ai * HALF + m * 16;
#pragma unroll
                for (int bj = 0; bj < 2; ++bj) { const f32x4 v0 = acc[ai][bj][m][0] + bv[bj][0], v1 = acc[ai][bj][m][1] + bv[bj][1];
                    u32x4 w; w.x = cvt_pk_bf16(v0[0], v0[1]); w.y = cvt_pk_bf16(v0[2], v0[3]); w.z = cvt_pk_bf16(v1[0], v1[1]); w.w = cvt_pk_bf16(v1[2], v1[3]);
                    *(u32x4*)(O + (size_t)row * 2048 + col0 + bj * HALF) = w; } }
    }
};
template <bool GATHER_> struct MoeOrder {
    static constexpr bool GATHER = GATHER_;
    int nM, nN, nwg, G, c, i0 = 0, imax = 1 << 30; const PG8_LAS int* tile_e; const PG8_LAS int* tab = nullptr;
    __device__ __forceinline__ int row_tok(int ui, int r) const { return tab[(ui + i0) * 256 + r]; }
    __device__ __forceinline__ void init(int nTiles, int N, int G_, int c_, const PG8_LAS int* te) { nM = nTiles; nN = N / BM; nwg = nM * nN; G = G_; c = c_; tile_e = te; }
    __device__ __forceinline__ bool next(int i, Unit& u) const {
        if (i + i0 >= imax) return false; const long L = (long)(i + i0) * G + c; if (L >= nwg) return false;
        int wgid = (int)L; { const int q = nwg / NXCD, r = nwg % NXCD, xcd = wgid % NXCD, off = wgid / NXCD; wgid = (xcd < r ? xcd * (q + 1) : r * (q + 1) + (xcd - r) * q) + off; }
        const int tq = wgid / nN, e = tile_e[tq], ft = tile_e[256 + e] >> 8, gsz = (tile_e[320 + e] + 255) >> 8, idx = wgid - ft * nN;
        u.pm = ft + idx % gsz; u.pn = idx / gsz; u.e = e; return true;
    }
    __device__ __forceinline__ void a_ready(const Unit&) const {}
    __device__ __forceinline__ void done(const Unit&) const {}
};
template <class Epi, class Sched, bool ALIGN_EPI = false, bool SP2 = false>
__device__ __forceinline__ void gemm_phase(PG8_LAS unsigned char* lds, const Gemm g, const Sched& S, const Epi& E, const int tid_in) {
    const int tid = tid_in, wid = __builtin_amdgcn_readfirstlane(tid >> 6), lane = tid & 63, wr = wid >> 2, wc = wid & 3, fr = lane & 15, fq = lane >> 4;
    const int K = g.K, nt = K / BK, LDB = g.btiled ? 64 : K;
    unsigned voffA[2], voffB[2]; unsigned vc[2][2] = {{0u, 0u}, {0u, 0u}}, vn[2][2] = {{0u, 0u}, {0u, 0u}}; int gR[2], gC[2];
#pragma unroll
    for (int i = 0; i < 2; ++i) { int R, C; stage_rc(tid * 16 + i * 8192, R, C); const int Rb = Epi::PERM ? ((R & ~31) + perm32(R & 31)) : R;
        voffA[i] = (unsigned)(R * K + C) * 2u; voffB[i] = (unsigned)(Rb * LDB + C) * 2u; gR[i] = R; gC[i] = C * 2; }
    const size_t kstep = (size_t)(BK * 2);
    const size_t hstep = (size_t)HALF * K * 2;
    const size_t tstep = 2 * hstep; const size_t kstepB = g.btiled ? (size_t)32768 : kstep, hstepB = g.btiled ? (size_t)16384 : hstep;
    const unsigned ldsw = (unsigned)wid * 1024u;
    const int aoff = lds_byte(wr * 64 + fr, fq * 8), boff = lds_byte(wc * 32 + fr, fq * 8);
#define PG8_SA(b, h) (((b) * 2 + (h)) * HTB)
#define PG8_SB(b, h) ((4 + (b) * 2 + (h)) * HTB)
#define PG8_STAGE(bufoff, gbase, voff) do { _Pragma("unroll") for (int _i = 0; _i < 2; ++_i) \
        __builtin_amdgcn_global_load_lds((const unsigned*)((const char*)(gbase) + (voff)[_i]), (PG8_LAS unsigned*)(lds + (bufoff) + ldsw + _i * 8192), 16, 0, 0); } while (0)
#define PG8_STAGE_A(bufoff, base, h, isnext) do { if constexpr (Sched::GATHER) { unsigned vv_[2] = {(isnext) ? vn[h][0] : vc[h][0], (isnext) ? vn[h][1] : vc[h][1]}; PG8_STAGE(bufoff, base, vv_); } else { PG8_STAGE(bufoff, (base) + (h) * hstep, voffA); } } while (0)
#define PG8_GFILL(dst, uidx) do { _Pragma("unroll") for (int h_ = 0; h_ < 2; ++h_) _Pragma("unroll") for (int i_ = 0; i_ < 2; ++i_) dst[h_][i_] = (unsigned)S.row_tok((uidx), h_ * HALF + gR[i_]) * (unsigned)(K * 2) + (unsigned)gC[i_]; } while (0)
#define PG8_LDA(dst, b, h) do { _Pragma("unroll") for (int m = 0; m < 4; ++m) _Pragma("unroll") for (int k = 0; k < 2; ++k) dst[m][k] = *(const PG8_LAS bf16x8*)(lds + PG8_SA(b, h) + aoff + m * 2048 + k * 1024); } while (0)
#define PG8_LDB(dst, b, h) do { _Pragma("unroll") for (int n = 0; n < 2; ++n) _Pragma("unroll") for (int k = 0; k < 2; ++k) dst[n][k] = *(const PG8_LAS bf16x8*)(lds + PG8_SB(b, h) + boff + n * 2048 + k * 1024); } while (0)
#define PG8_MMA(ai, bj, At, Bt) do { __builtin_amdgcn_s_setprio(1); _Pragma("unroll") for (int m = 0; m < 4; ++m) _Pragma("unroll") for (int n = 0; n < 2; ++n) _Pragma("unroll") for (int k = 0; k < 2; ++k) \
        acc[ai][bj][m][n] = __builtin_amdgcn_mfma_f32_16x16x32_bf16(Bt[n][k], At[m][k], acc[ai][bj][m][n], 0, 0, 0); __builtin_amdgcn_s_setprio(0); } while (0)
#define PG8_WAIT_V(n) asm volatile("s_waitcnt vmcnt(" #n ")" ::: "memory")
#define PG8_WAIT_L(n) asm volatile("s_waitcnt lgkmcnt(" #n ")" ::: "memory")
#define PG8_BAR __builtin_amdgcn_s_barrier()
#define PG8_SCHED __builtin_amdgcn_sched_barrier(0)
    Unit cur, nxt; int ui = 0;
    if (!S.next(0, cur)) return;
    f32x4 acc[2][2][4][2];
#pragma unroll
    for (int a = 0; a < 2; ++a)
#pragma unroll
        for (int b = 0; b < 2; ++b)
#pragma unroll
            for (int m = 0; m < 4; ++m)
#pragma unroll
                for (int n = 0; n < 2; ++n) acc[a][b][m][n] = (f32x4){0.f, 0.f, 0.f, 0.f};
    bf16x8 At[4][2], B0[2][2], B1[2][2];
    const char* cA = (const char*)g.A + (Sched::GATHER ? (size_t)0 : (size_t)cur.pm * tstep); if constexpr (Sched::GATHER) PG8_GFILL(vc, 0); const char* cB = (const char*)g.Bt + (size_t)cur.pn * tstep + (size_t)cur.e * g.estride;
    S.a_ready(cur);
    if constexpr (SP2) {
        PG8_STAGE(PG8_SB(0, 0), cB, voffB); PG8_STAGE(PG8_SB(0, 1), cB + hstepB, voffB); PG8_STAGE_A(PG8_SA(0, 0), cA, 0, false); PG8_STAGE_A(PG8_SA(0, 1), cA, 1, false);
        if (wr == 1) PG8_BAR;
        PG8_WAIT_V(2); PG8_BAR;
        PG8_STAGE(PG8_SB(1, 0), cB + kstepB, voffB); PG8_STAGE_A(PG8_SA(1, 0), cA + kstep, 0, false); PG8_STAGE(PG8_SB(1, 1), cB + hstepB + kstepB, voffB);
        PG8_WAIT_V(6); PG8_BAR;
    } else {
        PG8_STAGE(PG8_SB(0, 0), cB, voffB); PG8_STAGE_A(PG8_SA(0, 0), cA, 0, false); PG8_STAGE(PG8_SB(0, 1), cB + hstepB, voffB); PG8_STAGE_A(PG8_SA(0, 1), cA, 1, false);
        if (wr == 1) PG8_BAR;
        PG8_WAIT_V(4); PG8_BAR;
        PG8_STAGE(PG8_SB(1, 0), cB + kstepB, voffB); PG8_STAGE_A(PG8_SA(1, 0), cA + kstep, 0, false); PG8_STAGE(PG8_SB(1, 1), cB + hstepB + kstepB, voffB);
        PG8_WAIT_V(6); PG8_BAR;
    }
    for (;;) {
        const bool has_next = S.next(ui + 1, nxt);
        const char* nA = (has_next && !Sched::GATHER) ? (const char*)g.A + (size_t)nxt.pm * tstep : cA; if constexpr (Sched::GATHER) { if (has_next) PG8_GFILL(vn, ui + 1); else { vn[0][0] = vc[0][0]; vn[0][1] = vc[0][1]; vn[1][0] = vc[1][0]; vn[1][1] = vc[1][1]; } } const char* nB = has_next ? (const char*)g.Bt + (size_t)nxt.pn * tstep + (size_t)nxt.e * g.estride : cB;
        for (int seg = 0; seg < (Epi::HAS_MID ? 2 : 1); ++seg) {
        if constexpr (Epi::HAS_MID) { if (seg == 1) E.mid(acc, cur, wr, wc, fr, fq); }
        for (int t = (Epi::HAS_MID && seg == 1) ? nt / 2 : 0; t < ((Epi::HAS_MID && seg == 0) ? nt / 2 : nt); t += 2) {
            const bool last = (t == nt - 2);
            const char* a1 = cA + (size_t)(t + 1) * kstep;
            const char* a2 = last ? nA : cA + (size_t)(t + 2) * kstep; const char* b2 = last ? nB : cB + (size_t)(t + 2) * kstepB;
            const char* a3 = a2 + kstep; const char* b3 = b2 + kstepB;
            if (last && has_next) S.a_ready(nxt);
            if constexpr (SP2) {
            PG8_LDB(B0, 0, 0); PG8_LDB(B1, 0, 1); PG8_SCHED; PG8_LDA(At, 0, 0); PG8_STAGE_A(PG8_SA(1, 1), a1, 1, false);
            PG8_WAIT_V(8); PG8_WAIT_L(0); PG8_BAR; PG8_MMA(0, 0, At, B0); PG8_MMA(0, 1, At, B1); PG8_BAR; PG8_SCHED;
            PG8_LDA(At, 0, 1); PG8_STAGE(PG8_SB(0, 0), b2, voffB); PG8_STAGE(PG8_SB(0, 1), b2 + hstepB, voffB); PG8_STAGE_A(PG8_SA(0, 0), a2, 0, last);
            PG8_WAIT_V(8); PG8_WAIT_L(0); PG8_BAR; PG8_MMA(1, 0, At, B0); PG8_MMA(1, 1, At, B1); PG8_BAR; PG8_SCHED;
            PG8_LDB(B0, 1, 0); PG8_LDB(B1, 1, 1); PG8_SCHED; PG8_LDA(At, 1, 0); PG8_STAGE_A(PG8_SA(0, 1), a2, 1, last);
            PG8_WAIT_V(8); PG8_WAIT_L(0); PG8_BAR; PG8_MMA(0, 0, At, B0); PG8_MMA(0, 1, At, B1); PG8_BAR; PG8_SCHED;
            PG8_LDA(At, 1, 1); PG8_STAGE(PG8_SB(1, 0), b3, voffB); PG8_STAGE(PG8_SB(1, 1), b3 + hstepB, voffB); PG8_STAGE_A(PG8_SA(1, 0), a3, 0, last);
            PG8_WAIT_V(8); PG8_WAIT_L(0); PG8_BAR; PG8_MMA(1, 0, At, B0); PG8_MMA(1, 1, At, B1); PG8_BAR; PG8_SCHED;
            } else {
            PG8_LDB(B0, 0, 0); PG8_SCHED; PG8_LDA(At, 0, 0); PG8_STAGE_A(PG8_SA(1, 1), a1, 1, false);
            PG8_WAIT_L(8); PG8_BAR; PG8_WAIT_L(0); PG8_MMA(0, 0, At, B0); PG8_BAR; PG8_SCHED;
            PG8_LDB(B1, 0, 1); PG8_STAGE(PG8_SB(0, 0), b2, voffB);
            PG8_BAR; PG8_WAIT_L(0); PG8_MMA(0, 1, At, B1); PG8_BAR;
            PG8_LDA(At, 0, 1); PG8_STAGE_A(PG8_SA(0, 0), a2, 0, last);
            PG8_BAR; PG8_WAIT_L(0); PG8_MMA(1, 0, At, B0); PG8_BAR; PG8_SCHED;
            PG8_STAGE(PG8_SB(0, 1), b2 + hstepB, voffB);
            PG8_WAIT_V(6); PG8_BAR; PG8_MMA(1, 1, At, B1); PG8_BAR;
            PG8_LDB(B0, 1, 0); PG8_SCHED; PG8_LDA(At, 1, 0); PG8_STAGE_A(PG8_SA(0, 1), a2, 1, last);
            PG8_WAIT_L(8); PG8_BAR; PG8_WAIT_L(0); PG8_MMA(0, 0, At, B0); PG8_BAR; PG8_SCHED;
            PG8_LDB(B1, 1, 1); PG8_STAGE(PG8_SB(1, 0), b3, voffB);
            PG8_BAR; PG8_WAIT_L(0); PG8_MMA(0, 1, At, B1); PG8_BAR;
            PG8_LDA(At, 1, 1); PG8_STAGE_A(PG8_SA(1, 0), a3, 0, last);
            PG8_BAR; PG8_WAIT_L(0); PG8_MMA(1, 0, At, B0); PG8_BAR; PG8_SCHED;
            PG8_STAGE(PG8_SB(1, 1), b3 + hstepB, voffB);
            PG8_WAIT_V(6); PG8_BAR; PG8_MMA(1, 1, At, B1); PG8_BAR;
            }
        }
        }
        if constexpr (ALIGN_EPI) { if (wr == 0) PG8_BAR; }
        if constexpr (!Epi::AFTER_DRAIN) { E(acc, cur, wr, wc, fr, fq); S.done(cur); }
        if (!has_next) break;
#pragma unroll
        for (int a = 0; a < 2; ++a)
#pragma unroll
            for (int b = 0; b < 2; ++b)
#pragma unroll
                for (int m = 0; m < 4; ++m)
#pragma unroll
                    for (int n = 0; n < 2; ++n) acc[a][b][m][n] = (f32x4){0.f, 0.f, 0.f, 0.f};
        cur = nxt; cA = nA; cB = nB; ++ui; if constexpr (Sched::GATHER) { vc[0][0] = vn[0][0]; vc[0][1] = vn[0][1]; vc[1][0] = vn[1][0]; vc[1][1] = vn[1][1]; }
        if constexpr (ALIGN_EPI) { if (wr == 1) PG8_BAR; }
    }
    PG8_WAIT_V(0);
    if constexpr (!ALIGN_EPI) { if (wr == 0) PG8_BAR; }
    PG8_BAR;
    if constexpr (Epi::AFTER_DRAIN) { E.fused(acc, cur, wr, wc, fr, fq, lds, wid, lane); S.done(cur); }
#undef PG8_SA
#undef PG8_SB
#undef PG8_STAGE
#undef PG8_STAGE_A
#undef PG8_GFILL
#undef PG8_LDA
#undef PG8_LDB
#undef PG8_MMA
#undef PG8_WAIT_V
#undef PG8_WAIT_L
#undef PG8_BAR
#undef PG8_SCHED
}
}

namespace attn {
constexpr int D = 128; constexpr float THR = 8.f; constexpr bool WSKIP = false; constexpr int LDO = 4096;
constexpr float SCALE = 0.08838834764831845f;
constexpr int NW = 8, QBLK = 32, KVBLK = 64, QB = NW * QBLK;
constexpr int SHM_V = KVBLK * D * 2, SHM_K = KVBLK * D * 2;
constexpr int LDS_BYTES = 2 * SHM_V + 2 * SHM_K + NW * 64 * 4;
static_assert(D == 128, "geometry");

using bf16 = __hip_bfloat16;
typedef short bf16x8 __attribute__((ext_vector_type(8)));
typedef short s16x4 __attribute__((ext_vector_type(4)));
typedef float f32x16 __attribute__((ext_vector_type(16)));
typedef float f32x4 __attribute__((ext_vector_type(4)));
typedef unsigned u32x4 __attribute__((ext_vector_type(4)));
template <class A, class Bt> struct same_t { static constexpr bool v = false; };
template <class A> struct same_t<A, A> { static constexpr bool v = true; };

#define KSWZ(row, colB) ((row) * 256 + ((colB) ^ (((row) & 7) << 4)))
#define SBAR() __builtin_amdgcn_sched_barrier(0)
__device__ __forceinline__ int v_st(int k, int c) { const int kk = (k & ~0xC) | ((k & 4) << 1) | ((k & 8) >> 1); return ((kk >> 3) * 4 + (c >> 5)) * 512 + ((kk & 7) * 32 + (c & 31)) * 2; }
__device__ __forceinline__ int v_rd_base(int lane) { return ((lane & 3) << 3) | (((lane >> 2) & 3) << 6) | (((lane >> 4) & 1) << 5) | (((lane >> 5) & 1) << 8); }
constexpr int v_rd_off(int d0, int ks, int half) { return d0 * 512 + ks * 4096 + half * 2048; }
__device__ __forceinline__ int crow(int r, int hi) { return (r & 3) + 8 * (r >> 2) + 4 * hi; }
__device__ __forceinline__ unsigned cvtpk(float lo, float hi) {
    unsigned r; asm volatile("v_cvt_pk_bf16_f32 %0, %1, %2" : "=v"(r) : "v"(lo), "v"(hi)); return r;
}
__device__ __forceinline__ bf16x8 pack8(f32x4 a, f32x4 b) {
    u32x4 w = {cvtpk(a[0], a[1]), cvtpk(a[2], a[3]), cvtpk(b[0], b[1]), cvtpk(b[2], b[3])};
    return *reinterpret_cast<bf16x8*>(&w);
}
template <class T> __device__ __forceinline__ bf16x8 load8(const T* p) {
    if constexpr (same_t<T, float>::v) { return pack8(*(const f32x4*)p, *(const f32x4*)(p + 4)); }
    else { return *reinterpret_cast<const bf16x8*>(p); }
}
__device__ __forceinline__ void mask_tile(f32x16& p0, f32x16& p1, int dq, unsigned W) {
    const float NEG = -__builtin_inff();
#pragma unroll
    for (int r = 0; r < 16; ++r) {
        const int c = (r & 3) + 8 * (r >> 2);
        if ((unsigned)(dq - c) >= W) p0[r] = NEG;
        if ((unsigned)(dq - c - 32) >= W) p1[r] = NEG;
    }
}
__device__ __forceinline__ void partialSM(f32x16& p0, f32x16& p1, float& m_reg, float& mn, float& alpha) {
    float pmax = p0[0]; for (int r = 1; r < 16; ++r) pmax = fmaxf(pmax, p0[r]); for (int r = 0; r < 16; ++r) pmax = fmaxf(pmax, p1[r]);
    { auto rr = __builtin_amdgcn_permlane32_swap(__float_as_uint(pmax), __float_as_uint(pmax), false, false);
      pmax = fmaxf(__uint_as_float(rr[0]), __uint_as_float(rr[1])); }
    constexpr float C2 = 1.4426950408889634f * SCALE;
    if (__builtin_expect(__all((pmax - m_reg) * SCALE <= THR), 1)) { mn = m_reg; alpha = 1.f; }
    else { mn = fmaxf(m_reg, pmax); alpha = __builtin_amdgcn_exp2f((m_reg - mn) * C2); m_reg = mn; }
    const float mnL = -mn * C2;
    for (int r = 0; r < 16; ++r) p0[r] = fmaf(p0[r], C2, mnL); for (int r = 0; r < 16; ++r) p1[r] = fmaf(p1[r], C2, mnL);
    for (int r = 0; r < 16; ++r) p0[r] = __builtin_amdgcn_exp2f(p0[r]);
}
__device__ __forceinline__ void finishSM(f32x16& p0, f32x16& p1, float alpha, float& l_reg, bf16x8& pa0, bf16x8& pa1, bf16x8& pa2, bf16x8& pa3) {
    for (int r = 0; r < 16; ++r) p1[r] = __builtin_amdgcn_exp2f(p1[r]);
    float ps = 0; for (int r = 0; r < 16; ++r) ps += p0[r]; for (int r = 0; r < 16; ++r) ps += p1[r];
    { auto rr = __builtin_amdgcn_permlane32_swap(__float_as_uint(ps), __float_as_uint(ps), false, false);
      ps = __uint_as_float(rr[0]) + __uint_as_float(rr[1]); }
    l_reg = l_reg * alpha + ps;
#define PK4(P, B_, OUT) do { unsigned a0 = cvtpk(P[B_+0], P[B_+1]), a1 = cvtpk(P[B_+2], P[B_+3]);                          \
        unsigned b0 = cvtpk(P[B_+4], P[B_+5]), b1 = cvtpk(P[B_+6], P[B_+7]);                                             \
        auto r0 = __builtin_amdgcn_permlane32_swap(a0, b0, false, false); auto r1 = __builtin_amdgcn_permlane32_swap(a1, b1, false, false); \
        u32x4 w = {r0[0], r1[0], r0[1], r1[1]}; OUT = *reinterpret_cast<bf16x8*>(&w); } while (0)
    PK4(p0, 0, pa0); PK4(p0, 8, pa1); PK4(p1, 0, pa2); PK4(p1, 8, pa3);
#undef PK4
}
template <int KB, bool SK>
__device__ __forceinline__ void qkt(f32x16& p0, f32x16& p1, const char* K_lds, int r32, int hi, const bf16x8* qr, bool act) {
    if (SK && !act) { const float NEG = -__builtin_inff();
#pragma unroll
        for (int r = 0; r < 16; ++r) { p0[r] = NEG; p1[r] = NEG; } return; }
    p0 = f32x16{}; p1 = f32x16{};
    const char* kb[4];
#pragma unroll
    for (int dd = 0; dd < 4; ++dd) kb[dd] = K_lds + KB * SHM_K + KSWZ(r32, (dd * 16 + hi * 8) * 2);
#pragma unroll
    for (int d0 = 0; d0 < 8; ++d0) { const char* a = kb[d0 & 3] + (d0 >> 2) * 128;
        bf16x8 b0 = *reinterpret_cast<const bf16x8*>(a);
        bf16x8 b1 = *reinterpret_cast<const bf16x8*>(a + 32 * 256);
        p0 = __builtin_amdgcn_mfma_f32_32x32x16_bf16(b0, qr[d0], p0, 0, 0, 0);
        p1 = __builtin_amdgcn_mfma_f32_32x32x16_bf16(b1, qr[d0], p1, 0, 0, 0); }
}
template <int VB, bool SK>
__device__ __forceinline__ void pv_tile(f32x16* o, int vb0, bf16x8 pa0, bf16x8 pa1, bf16x8 pa2, bf16x8 pa3, bool act) {
    if (SK && !act) return;
#define TRRD(dst, off) asm volatile("ds_read_b64_tr_b16 %0, %1 offset:%2" : "=&v"(dst) : "v"(vb0), "i"(off) : "memory")
#define PV_D0(d0) do { s16x4 l0, l1, l2, l3, h0, h1, h2, h3; constexpr int b_ = VB * SHM_V + v_rd_off(d0, 0, 0);     \
        TRRD(l0, b_); TRRD(h0, b_ + 2048); TRRD(l1, b_ + 4096); TRRD(h1, b_ + 6144); TRRD(l2, b_ + 8192); TRRD(h2, b_ + 10240); TRRD(l3, b_ + 12288); TRRD(h3, b_ + 14336); \
        asm volatile("s_waitcnt lgkmcnt(0)" ::: "memory"); SBAR();                 \
        o[d0] = __builtin_amdgcn_mfma_f32_32x32x16_bf16(pa0, (bf16x8){l0[0], l0[1], l0[2], l0[3], h0[0], h0[1], h0[2], h0[3]}, o[d0], 0, 0, 0);   \
        o[d0] = __builtin_amdgcn_mfma_f32_32x32x16_bf16(pa1, (bf16x8){l1[0], l1[1], l1[2], l1[3], h1[0], h1[1], h1[2], h1[3]}, o[d0], 0, 0, 0);   \
        o[d0] = __builtin_amdgcn_mfma_f32_32x32x16_bf16(pa2, (bf16x8){l2[0], l2[1], l2[2], l2[3], h2[0], h2[1], h2[2], h2[3]}, o[d0], 0, 0, 0);   \
        o[d0] = __builtin_amdgcn_mfma_f32_32x32x16_bf16(pa3, (bf16x8){l3[0], l3[1], l3[2], l3[3], h3[0], h3[1], h3[2], h3[3]}, o[d0], 0, 0, 0); } while (0)
    PV_D0(0); PV_D0(1); PV_D0(2); PV_D0(3);
#undef PV_D0
#undef TRRD
}

template <class TIn, class TOut> struct BlockRef { const TIn* Q; const TIn* K; const TIn* V; TOut* O; int P0; };
template <class TIn> struct Seam {
    bf16x8 qr[8];
    bf16x8 st_v0, st_v1, st_k0, st_k1; f32x4 sf0, sf1, sf2, sf3;
    f32x4 tq[16];
};
__device__ __forceinline__ int swa_jlo(int P0, int W) { const int lowk = P0 - W + 1; return lowk > 0 ? lowk / KVBLK : 0; }
#define ROW(p, k0, rr) ((p) + (size_t)((k0) + (rr)) * D + sc)
#define VMW() asm volatile("s_waitcnt vmcnt(0)" ::: "memory")
#define VMWN(n) asm volatile("s_waitcnt vmcnt(%0)" :: "i"(n) : "memory")
#define SLOAD_H(Kp, Vp, k0) do { S.st_v0 = load8<TIn>(ROW(Vp, k0, sr)); S.st_v1 = load8<TIn>(ROW(Vp, k0, 32 + sr));              \
                         S.st_k0 = load8<TIn>(ROW(Kp, k0, sr)); S.st_k1 = load8<TIn>(ROW(Kp, k0, 32 + sr)); } while (0)
#define SWRITE_HK(bf) do { *(bf16x8*)(K_lds + (bf) * SHM_K + kws) = S.st_k0; *(bf16x8*)(K_lds + (bf) * SHM_K + kws + 32 * 256) = S.st_k1; } while (0)
#define SWRITE_HV(bf) do { *(bf16x8*)(V_lds + (bf) * SHM_V + vst0) = S.st_v0; *(bf16x8*)(V_lds + (bf) * SHM_V + vst1) = S.st_v1; } while (0)
#define SWRITE_H(bf) do { SWRITE_HV(bf); SWRITE_HK(bf); } while (0)
#define SLOAD_F(p, k0) do { S.sf0 = *(const f32x4*)ROW(p, k0, sr); S.sf1 = *(const f32x4*)(ROW(p, k0, sr) + 4);                \
                            S.sf2 = *(const f32x4*)ROW(p, k0, 32 + sr); S.sf3 = *(const f32x4*)(ROW(p, k0, 32 + sr) + 4); } while (0)
#define SWRITE_KF(bf) do { *(bf16x8*)(K_lds + (bf) * SHM_K + kws) = pack8(S.sf0, S.sf1); *(bf16x8*)(K_lds + (bf) * SHM_K + kws + 32 * 256) = pack8(S.sf2, S.sf3); } while (0)
#define SWRITE_VF(bf) do { *(bf16x8*)(V_lds + (bf) * SHM_V + vst0) = pack8(S.sf0, S.sf1); *(bf16x8*)(V_lds + (bf) * SHM_V + vst1) = pack8(S.sf2, S.sf3); } while (0)
template <class TIn, class TOut>
__device__ __forceinline__ void causal_swa_prime(const BlockRef<TIn, TOut>& cur, int W, char* lds, Seam<TIn>& S, const int tid_in) {
    constexpr bool F32 = same_t<TIn, float>::v;
    const int tid = tid_in, wid = __builtin_amdgcn_readfirstlane(tid >> 6), lane = tid & 63, r32 = lane & 31, hi = lane >> 5;
    const int sr = tid >> 4, sc = (tid & 15) * 8, kws = KSWZ(sr, sc * 2); char* K_lds = lds + 2 * SHM_V;
    const int kb0 = swa_jlo(cur.P0, W) * KVBLK;
    for (int d0 = 0; d0 < 8; ++d0) S.qr[d0] = load8<TIn>(cur.Q + (size_t)(wid * QBLK + r32) * D + d0 * 16 + hi * 8);
    if constexpr (F32) { SLOAD_F((const float*)cur.K, kb0); VMW(); SWRITE_KF(0); SBAR(); SLOAD_F((const float*)cur.V, kb0); }
    else { SLOAD_H(cur.K, cur.V, kb0); VMW(); SWRITE_HK(0); }
    __syncthreads();
}
template <class TIn, class TOut>
__device__ __forceinline__ void causal_swa_block(const BlockRef<TIn, TOut>& cur, const BlockRef<TIn, TOut>& nxt, int skv, int W, char* lds, Seam<TIn>& S, const int tid_in) {
    constexpr bool F32 = same_t<TIn, float>::v;
    const int tid = tid_in, wid = __builtin_amdgcn_readfirstlane(tid >> 6), lane = tid & 63, r32 = lane & 31, hi = lane >> 5;
    const int j_lo = swa_jlo(cur.P0, W);
    int j_hi = (cur.P0 + QB - 1) / KVBLK + 1; if (j_hi > skv / KVBLK) j_hi = skv / KVBLK;
    const int NT = j_hi - j_lo;
    const int kbn = swa_jlo(nxt.P0, W) * KVBLK;
    const int qlo = cur.P0 + wid * QBLK, qm = qlo + r32 - 4 * hi;
    char* V_lds = lds; char* K_lds = lds + 2 * SHM_V;
    float* ws = (float*)(lds + 2 * SHM_V + 2 * SHM_K) + wid * 64; float* li_l = ws, * al_l = ws + 32;
    float m_reg = -1e30f, l_reg = 0; f32x16 o[4] = {};
    const int sr = tid >> 4, sc = (tid & 15) * 8, vst0 = v_st(sr, sc), vst1 = v_st(32 + sr, sc), kws = KSWZ(sr, sc * 2);
    const int vb0 = (int)(uintptr_t)V_lds + v_rd_base(lane);
    const TIn* Kh = cur.K; const TIn* Vh = cur.V;
#define RESC(a) do { if (__any((a) < 1.f)) { if (hi == 0) al_l[r32] = (a); asm volatile("s_waitcnt lgkmcnt(0)" ::: "memory");              \
                     for (int d_ = 0; d_ < 4; ++d_) for (int r = 0; r < 16; ++r) o[d_][r] *= al_l[crow(r, hi)]; } } while (0)
#define KBASE(t) ((j_lo + (t)) * KVBLK)
#define ACT(t) (KBASE(t) <= qlo + QBLK - 1 && KBASE(t) + KVBLK - 1 >= qlo - W + 1)
#define MASKT(P0_, P1_, t) do { const int kb_ = KBASE(t); if ((!SK || ACT(t)) && (kb_ + KVBLK - 1 > qlo || kb_ <= qlo + QBLK - 1 - W)) mask_tile(P0_, P1_, qm - kb_, (unsigned)W); } while (0)
    constexpr int NQL = F32 ? 16 : 8;
    constexpr bool SK = WSKIP && !F32;
#define SEAM_K0() do { VMWN(NQL); if constexpr (F32) { SWRITE_KF(0); SBAR(); SLOAD_F((const float*)nxt.V, kbn); } else { SWRITE_HK(0); } SBAR(); } while (0)
    f32x16 pA0, pA1, pB0, pB1; float mnA, mnB, alA, alB; bf16x8 pa0, pa1, pa2, pa3;
    if constexpr (F32) { VMW(); SWRITE_VF(0); SBAR(); } else { SWRITE_HV(0); SBAR(); }
    if (NT > 1) { if constexpr (F32) SLOAD_F((const float*)Kh, KBASE(1)); else SLOAD_H(Kh, Vh, KBASE(1)); }
    SBAR(); qkt<0, SK>(pA0, pA1, K_lds, r32, hi, S.qr, ACT(0));
    if constexpr (F32) { if (NT > 1) { VMW(); SWRITE_KF(1); SBAR(); SLOAD_F((const float*)Vh, KBASE(1)); } }
    MASKT(pA0, pA1, 0); partialSM(pA0, pA1, m_reg, mnA, alA);
    if (NT > 1) { VMW(); if constexpr (F32) { SWRITE_VF(1); SBAR(); if (NT > 2) SLOAD_F((const float*)Kh, KBASE(2)); } else SWRITE_H(1); }
    __syncthreads();
#define HALF_STEP(PX0, PX1, mnX, alX, PY0, PY1, alY, t, KB, VB, SB) do {                                                      \
        SBAR(); qkt<KB, SK>(PX0, PX1, K_lds, r32, hi, S.qr, ACT(t));                                             \
        finishSM(PY0, PY1, alY, l_reg, pa0, pa1, pa2, pa3); SBAR();                                                           \
        if ((t) + 1 < NT) { if constexpr (F32) { VMW(); SWRITE_KF(SB); SBAR(); SLOAD_F((const float*)Vh, KBASE((t) + 1)); }  \
                            else { SLOAD_H(Kh, Vh, KBASE((t) + 1)); } SBAR(); }                                               \
        pv_tile<VB, SK>(o, vb0, pa0, pa1, pa2, pa3, ACT((t) - 1)); MASKT(PX0, PX1, (t)); partialSM(PX0, PX1, m_reg, mnX, alX);                                        \
        __syncthreads();                                                                                                      \
        if ((t) + 1 < NT) { VMW(); if constexpr (F32) { SWRITE_VF(SB); SBAR(); if ((t) + 2 < NT) SLOAD_F((const float*)Kh, KBASE((t) + 2)); } \
                            else { SWRITE_H(SB); } }                                                                          \
        RESC(alX); __syncthreads(); } while (0)
    for (int t = 1; t + 1 < NT; t += 2) {
        HALF_STEP(pB0, pB1, mnB, alB, pA0, pA1, alA, t, 1, 0, 0);
        HALF_STEP(pA0, pA1, mnA, alA, pB0, pB1, alB, t + 1, 0, 1, 1);
    }
    const bool even = (NT & 1) == 0;
    if (even) { SBAR(); qkt<1, SK>(pB0, pB1, K_lds, r32, hi, S.qr, ACT(NT - 1)); SBAR(); }
#define QROW(e) (nxt.Q + (size_t)(wid * QBLK + r32) * D + ((e) >> 1) * 16 + hi * 8 + ((e) & 1) * 4)
    if constexpr (F32) { SLOAD_F((const float*)nxt.K, kbn); SBAR();
#pragma unroll
        for (int e = 0; e < 8; ++e) S.tq[e] = *(const f32x4*)QROW(e); }
    else { SLOAD_H(nxt.K, nxt.V, kbn); SBAR();
#pragma unroll
        for (int d0 = 0; d0 < 8; ++d0) S.qr[d0] = load8<TIn>(nxt.Q + (size_t)(wid * QBLK + r32) * D + d0 * 16 + hi * 8); }
    SBAR();
    finishSM(pA0, pA1, alA, l_reg, pa0, pa1, pa2, pa3); SBAR();
    if constexpr (F32) {
#pragma unroll
        for (int e = 8; e < 16; ++e) S.tq[e] = *(const f32x4*)QROW(e); SBAR(); }
#undef QROW
    pv_tile<0, SK>(o, vb0, pa0, pa1, pa2, pa3, ACT(even ? NT - 2 : NT - 1));
    if (even) { MASKT(pB0, pB1, NT - 1); partialSM(pB0, pB1, m_reg, mnB, alB); __syncthreads(); RESC(alB);
        finishSM(pB0, pB1, alB, l_reg, pa0, pa1, pa2, pa3); SBAR(); pv_tile<1, SK>(o, vb0, pa0, pa1, pa2, pa3, ACT(NT - 1)); }
    SBAR(); SEAM_K0();
    if (hi == 0) li_l[r32] = l_reg; asm volatile("s_waitcnt lgkmcnt(0)" ::: "memory");
    float rli[16];
#pragma unroll
    for (int r = 0; r < 16; ++r) rli[r] = __builtin_amdgcn_rcpf(li_l[crow(r, hi)]);
    TOut* Ow = cur.O + (size_t)(wid * QBLK) * LDO;
#pragma unroll
    for (int r = 0; r < 16; ++r) { const int orow = crow(r, hi);
#pragma unroll
        for (int d0 = 0; d0 < 4; ++d0) { const float v = o[d0][r] * rli[r];
            if constexpr (same_t<TOut, float>::v) { Ow[(size_t)orow * LDO + d0 * 32 + r32] = v; }
            else { const float vn = __shfl_xor(v, 1);
                   if ((r32 & 1) == 0) *(unsigned*)(Ow + (size_t)orow * LDO + d0 * 32 + r32) = cvtpk(v, vn); } } }
    if constexpr (F32) {
#pragma unroll
        for (int d0 = 0; d0 < 8; ++d0) S.qr[d0] = pack8(S.tq[2 * d0], S.tq[2 * d0 + 1]); }
    __syncthreads();
#undef RESC
#undef KBASE
#undef ACT
#undef MASKT
#undef SEAM_K0
#undef HALF_STEP
}
#undef ROW
#undef VMW
#undef VMWN
#undef SLOAD_H
#undef SWRITE_HK
#undef SWRITE_HV
#undef SWRITE_H
#undef SLOAD_F
#undef SWRITE_KF
#undef SWRITE_VF


}

namespace attn2 {
typedef float f32x2v __attribute__((ext_vector_type(2))); typedef attn::f32x4 f32x4; typedef attn::bf16 abf; typedef attn::bf16x8 bf16x8; typedef attn::f32x16 f32x16; typedef attn::u32x4 u32x4; typedef attn::s16x4 s16x4;
constexpr int KOFF = 0, VOFF = 32768, XOFF = 98304, XWAVE = 6656, XBUF = 4 * XWAVE, SCOFF = XOFF + 2 * XBUF, LDS_BYTES = SCOFF + 8 * 256;
static_assert(LDS_BYTES <= 157696, "attention LDS");
constexpr int QB2 = 128, LDO = 4096;
struct Blk { const abf* Q; const abf* K; const abf* V0; const abf* V1; abf* O; int P0; };
#define A2_TRRD(dst, vb, off) asm volatile("ds_read_b64_tr_b16 %0, %1 offset:%2" : "=&v"(dst) : "v"(vb), "i"(off) : "memory")
#define A2_FR(L, H) ((bf16x8){L[0], L[1], L[2], L[3], H[0], H[1], H[2], H[3]})
#define A2_RDK(vb, d0, s) do { A2_TRRD(xl##s, vb, (d0) * 512 + (s) * 4096); A2_TRRD(xh##s, vb, (d0) * 512 + (s) * 4096 + 2048); A2_TRRD(yl##s, vb, ((d0) + 1) * 512 + (s) * 4096); A2_TRRD(yh##s, vb, ((d0) + 1) * 512 + (s) * 4096 + 2048); } while (0)
#define A2_STEPK(accx, accy, pa, s, NEXT) do { asm volatile("s_waitcnt lgkmcnt(12)" ::: "memory"); __builtin_amdgcn_sched_barrier(0); \
        accx = __builtin_amdgcn_mfma_f32_32x32x16_bf16(pa, A2_FR(xl##s, xh##s), accx, 0, 0, 0); accy = __builtin_amdgcn_mfma_f32_32x32x16_bf16(pa, A2_FR(yl##s, yh##s), accy, 0, 0, 0); \
        __builtin_amdgcn_sched_barrier(0); NEXT; __builtin_amdgcn_sched_barrier(0); } while (0)
#define A2_PAIR(accx, accy, NEXT0, NEXT1, NEXT2, NEXT3) do { A2_STEPK(accx, accy, pa0, 0, NEXT0); A2_STEPK(accx, accy, pa1, 1, NEXT1); A2_STEPK(accx, accy, pa2, 2, NEXT2); A2_STEPK(accx, accy, pa3, 3, NEXT3); } while (0)
#define A2_NONE do { asm volatile("s_waitcnt lgkmcnt(0)" ::: "memory"); } while (0)
__device__ __forceinline__ void pv256(f32x16* o, int vb0, bf16x8 pa0, bf16x8 pa1, bf16x8 pa2, bf16x8 pa3) {
    s16x4 xl0, xh0, xl1, xh1, xl2, xh2, xl3, xh3, yl0, yh0, yl1, yh1, yl2, yh2, yl3, yh3;
    const int va = vb0, vb = vb0 + 16384;
    asm volatile("s_waitcnt lgkmcnt(0)" ::: "memory");
    A2_RDK(va, 0, 0); A2_RDK(va, 0, 1); A2_RDK(va, 0, 2); A2_RDK(va, 0, 3);
    A2_PAIR(o[0], o[1], A2_RDK(va, 2, 0), A2_RDK(va, 2, 1), A2_RDK(va, 2, 2), A2_RDK(va, 2, 3));
    A2_PAIR(o[2], o[3], A2_RDK(vb, 0, 0), A2_RDK(vb, 0, 1), A2_RDK(vb, 0, 2), A2_RDK(vb, 0, 3));
    A2_PAIR(o[4], o[5], A2_RDK(vb, 2, 0), A2_RDK(vb, 2, 1), A2_RDK(vb, 2, 2), A2_RDK(vb, 2, 3));
    A2_PAIR(o[6], o[7], A2_NONE, A2_NONE, A2_NONE, A2_NONE);
}
#undef A2_TRRD
#undef A2_FR
#undef A2_RDK
#undef A2_STEPK
#undef A2_PAIR
#undef A2_NONE
__device__ __forceinline__ void pack_half(const f32x16& P, bf16x8& outA, bf16x8& outB) {
#define A2_PK4(B_, OUT) do { unsigned a0 = attn::cvtpk(P[B_ + 0], P[B_ + 1]), a1 = attn::cvtpk(P[B_ + 2], P[B_ + 3]); unsigned b0 = attn::cvtpk(P[B_ + 4], P[B_ + 5]), b1 = attn::cvtpk(P[B_ + 6], P[B_ + 7]); \
        auto r0 = __builtin_amdgcn_permlane32_swap(a0, b0, false, false); auto r1 = __builtin_amdgcn_permlane32_swap(a1, b1, false, false); \
        u32x4 w = {r0[0], r1[0], r0[1], r1[1]}; OUT = *reinterpret_cast<bf16x8*>(&w); } while (0)
    A2_PK4(0, outA); A2_PK4(8, outB);
#undef A2_PK4
}
__device__ __forceinline__ float half_rowsum(const f32x16& P) {
    float ps = ((P[0] + P[1]) + (P[2] + P[3])) + ((P[4] + P[5]) + (P[6] + P[7])) + (((P[8] + P[9]) + (P[10] + P[11])) + ((P[12] + P[13]) + (P[14] + P[15])));
    auto rr = __builtin_amdgcn_permlane32_swap(__float_as_uint(ps), __float_as_uint(ps), false, false);
    return __uint_as_float(rr[0]) + __uint_as_float(rr[1]);
}
__device__ __forceinline__ void block(const Blk& B, char* lds, const int tid) {
    const int wid = __builtin_amdgcn_readfirstlane(tid >> 6), lane = tid & 63, r32 = lane & 31, hi = lane >> 5;
    const bool isA = wid < 4; const int wa = wid & 3;
    const int NT = (B.P0 + QB2) / 64;
    char* K_lds = lds + KOFF; char* V_lds = lds + VOFF;
    char* X_l = lds + XOFF + wa * XWAVE;
    float* sc_l = (float*)(lds + SCOFF) + wid * 64;
    const int t2 = tid & 255, sr = t2 >> 4, sc = (t2 & 15) * 8;
    const int kws = KSWZ(sr, sc * 2), vst = attn::v_st(sr, sc);
    const unsigned goff = (unsigned)(sr * 128 + sc) * 2u;
#define A2_LD(base, rowbytes, i) (*(const bf16x8*)((const char*)(base) + (size_t)(rowbytes) + (size_t)(gof_ + (unsigned)(i) * 4096u)))
#define A2_FRESH() unsigned gof_ = goff; asm volatile("" : "+v"(gof_))
    const int vb0 = (int)(uintptr_t)V_lds + attn::v_rd_base(lane);
    const int qlo = B.P0 + wa * 32, qm = qlo + r32 - 4 * hi;
    constexpr float C2 = 1.4426950408889634f * attn::SCALE;
    if (isA) {
        float m_reg = -1e30f, l_reg = 0.f; bf16x8 qr[8]; bf16x8 st[4];
#pragma unroll
        for (int d0 = 0; d0 < 8; ++d0) qr[d0] = attn::load8<abf>(B.Q + (size_t)(wa * 32 + r32) * 128 + d0 * 16 + hi * 8);
        { A2_FRESH();
#pragma unroll
        for (int i = 0; i < 4; ++i) st[i] = A2_LD(B.K, 0, i); }
        asm volatile("s_waitcnt vmcnt(0)" ::: "memory");
#pragma unroll
        for (int i = 0; i < 4; ++i) *(bf16x8*)(K_lds + kws + i * 4096) = st[i];
        { A2_FRESH();
#pragma unroll
        for (int i = 0; i < 4; ++i) st[i] = A2_LD(B.K, 64 * 256, i); }
        asm volatile("s_waitcnt vmcnt(0)" ::: "memory");
#pragma unroll
        for (int i = 0; i < 4; ++i) *(bf16x8*)(K_lds + 16384 + kws + i * 4096) = st[i];
        __syncthreads();
        f32x16 p0, p1;
        attn::qkt<0, false>(p0, p1, K_lds, r32, hi, qr, true);
        for (int t = 0; t <= NT; ++t) {
            if (t < NT) {
                const int buf = t & 1, kb = t * 64; const bool more2 = t + 2 < NT;
                if (more2) { A2_FRESH();
#pragma unroll
                    for (int i = 0; i < 4; ++i) st[i] = A2_LD(B.K, (kb + 128) * 256, i);
                }
                if (kb + 63 > qlo) attn::mask_tile(p0, p1, qm - kb, 0x7fffffffu);
                f32x16 n0, n1;
                attn::qkt<0, false>(n0, n1, K_lds + (buf ^ 1) * 16384, r32, hi, qr, true);
                float pmax = fmaxf(p0[0], p1[0]);
#pragma unroll
                for (int r = 1; r < 16; ++r) pmax = fmaxf(pmax, fmaxf(p0[r], p1[r]));
                { auto rr = __builtin_amdgcn_permlane32_swap(__float_as_uint(pmax), __float_as_uint(pmax), false, false); pmax = fmaxf(__uint_as_float(rr[0]), __uint_as_float(rr[1])); }
                const bool keep = __all((pmax - m_reg) * attn::SCALE <= attn::THR);
                const float mn = keep ? m_reg : fmaxf(m_reg, pmax); const float alpha = __builtin_amdgcn_exp2f((m_reg - mn) * C2); m_reg = mn;
                const float mnL = -mn * C2;
                char* xl = X_l + buf * XBUF;
                *(f32x4*)(xl + lane * 16) = (f32x4){p1[0], p1[1], p1[2], p1[3]}; *(f32x4*)(xl + 1024 + lane * 16) = (f32x4){p1[4], p1[5], p1[6], p1[7]};
                *(f32x4*)(xl + 2048 + lane * 16) = (f32x4){p1[8], p1[9], p1[10], p1[11]}; *(f32x4*)(xl + 3072 + lane * 16) = (f32x4){p1[12], p1[13], p1[14], p1[15]};
                *(f32x2v*)(xl + 6144 + lane * 8) = (f32x2v){mnL, alpha};
#pragma unroll
                for (int r = 0; r < 16; ++r) p0[r] = __builtin_amdgcn_exp2f(fmaf(p0[r], C2, mnL));
                l_reg = l_reg * alpha + half_rowsum(p0);
                bf16x8 pa0, pa1; pack_half(p0, pa0, pa1);
                *(bf16x8*)(xl + 4096 + lane * 16) = pa0; *(bf16x8*)(xl + 5120 + lane * 16) = pa1;
                if (more2) {
                    asm volatile("s_waitcnt vmcnt(0)" ::: "memory");
#pragma unroll
                    for (int i = 0; i < 4; ++i) *(bf16x8*)(K_lds + buf * 16384 + kws + i * 4096) = st[i];
                }
                p0 = n0; p1 = n1;
            }
            __syncthreads();
        }
        *(float*)(X_l + 6144 + lane * 8) = l_reg;
        __syncthreads();
        __syncthreads();
    } else {
        f32x16 o[8] = {}; bf16x8 st[8]; float l_reg = 0.f;
        __syncthreads();
        for (int t = 0; t <= NT; ++t) {
            if (t < NT) { A2_FRESH();
#pragma unroll
                for (int i = 0; i < 4; ++i) { st[i] = A2_LD(B.V0, t * 64 * 256, i); st[4 + i] = A2_LD(B.V1, t * 64 * 256, i); }
            }
            if (t >= 1) {
                const int pb = (t - 1) & 1;
                const char* xl = X_l + pb * XBUF;
                f32x16 p1;
                { const f32x4 a = *(const f32x4*)(xl + lane * 16), b = *(const f32x4*)(xl + 1024 + lane * 16), c = *(const f32x4*)(xl + 2048 + lane * 16), d = *(const f32x4*)(xl + 3072 + lane * 16);
                  p1 = (f32x16){a[0], a[1], a[2], a[3], b[0], b[1], b[2], b[3], c[0], c[1], c[2], c[3], d[0], d[1], d[2], d[3]}; }
                const f32x2v ma = *(const f32x2v*)(xl + 6144 + lane * 8);
                const float mnL = ma.x, alpha = ma.y;
#pragma unroll
                for (int r = 0; r < 16; ++r) p1[r] = __builtin_amdgcn_exp2f(fmaf(p1[r], C2, mnL));
                l_reg = l_reg * alpha + half_rowsum(p1);
                bf16x8 pa2, pa3; pack_half(p1, pa2, pa3);
                const bf16x8 pa0 = *(const bf16x8*)(xl + 4096 + lane * 16), pa1 = *(const bf16x8*)(xl + 5120 + lane * 16);
                if (__any(alpha < 1.f)) {
                    if (hi == 0) sc_l[r32] = alpha;
                    asm volatile("s_waitcnt lgkmcnt(0)" ::: "memory");
                    float a16[16];
#pragma unroll
                    for (int r = 0; r < 16; ++r) a16[r] = sc_l[attn::crow(r, hi)];
#pragma unroll
                    for (int d0 = 0; d0 < 8; ++d0)
#pragma unroll
                        for (int r = 0; r < 16; ++r) o[d0][r] *= a16[r];
                }
                pv256(o, vb0 + pb * 32768, pa0, pa1, pa2, pa3);
            }
            if (t < NT) {
                asm volatile("s_waitcnt vmcnt(0)" ::: "memory");
                char* vd = V_lds + (t & 1) * 32768 + vst;
#pragma unroll
                for (int i = 0; i < 4; ++i) { *(bf16x8*)(vd + i * 4096) = st[i]; *(bf16x8*)(vd + 16384 + i * 4096) = st[4 + i]; }
            }
            __syncthreads();
        }
        __syncthreads();
        l_reg += *(const float*)(X_l + 6144 + lane * 8);
        if (hi == 0) sc_l[32 + r32] = l_reg;
        asm volatile("s_waitcnt lgkmcnt(0)" ::: "memory");
        float rli[16];
#pragma unroll
        for (int r = 0; r < 16; ++r) rli[r] = __builtin_amdgcn_rcpf(sc_l[32 + attn::crow(r, hi)]);
        abf* Ow = B.O + (size_t)(wa * 32) * LDO;
#pragma unroll
        for (int r = 0; r < 16; ++r) { const int orow = attn::crow(r, hi);
#pragma unroll
            for (int d0 = 0; d0 < 8; ++d0) { const float v = o[d0][r] * rli[r]; const float vn = __shfl_xor(v, 1);
                if ((r32 & 1) == 0) *(unsigned*)(Ow + (size_t)orow * LDO + d0 * 32 + r32) = attn::cvtpk(v, vn); } }
        __syncthreads();
    }
}
#undef A2_LD
#undef A2_FRESH
}

namespace attn3 {
#define A3_LAS __attribute__((address_space(3)))
typedef float f32x2v __attribute__((ext_vector_type(2))); typedef attn::f32x4 f32x4; typedef attn::bf16 abf; typedef attn::bf16x8 bf16x8; typedef attn::f32x16 f32x16; typedef attn::u32x4 u32x4; typedef attn::s16x4 s16x4;
constexpr int KOFF = 0, VOFF = 32768, SCOFF = 98304, LDS_BYTES = SCOFF + 8 * 256;
constexpr int QB3 = 256, LDO = 4096;
struct Blk { const abf* Q; const abf* K; const abf* V0; const abf* V1; abf* O; int P0; };
#define A3_TRRD(dst, vb, off) asm volatile("ds_read_b64_tr_b16 %0, %1 offset:%2" : "=&v"(dst) : "v"(vb), "i"(off) : "memory")
#define A3_FR(L, H) ((bf16x8){L[0], L[1], L[2], L[3], H[0], H[1], H[2], H[3]})
#define A3_RDK(vb, d0, s) do { A3_TRRD(xl##s, vb, (d0) * 512 + (s) * 4096); A3_TRRD(xh##s, vb, (d0) * 512 + (s) * 4096 + 2048); A3_TRRD(yl##s, vb, ((d0) + 1) * 512 + (s) * 4096); A3_TRRD(yh##s, vb, ((d0) + 1) * 512 + (s) * 4096 + 2048); } while (0)
#define A3_STEPK(accx, accy, pa, s, NEXT) do { asm volatile("s_waitcnt lgkmcnt(12)" ::: "memory"); __builtin_amdgcn_sched_barrier(0); \
        accx = __builtin_amdgcn_mfma_f32_32x32x16_bf16(pa, A3_FR(xl##s, xh##s), accx, 0, 0, 0); accy = __builtin_amdgcn_mfma_f32_32x32x16_bf16(pa, A3_FR(yl##s, yh##s), accy, 0, 0, 0); \
        __builtin_amdgcn_sched_barrier(0); NEXT; __builtin_amdgcn_sched_barrier(0); } while (0)
#define A3_PAIR(accx, accy, NEXT0, NEXT1, NEXT2, NEXT3) do { A3_STEPK(accx, accy, pa0, 0, NEXT0); A3_STEPK(accx, accy, pa1, 1, NEXT1); A3_STEPK(accx, accy, pa2, 2, NEXT2); A3_STEPK(accx, accy, pa3, 3, NEXT3); } while (0)
#define A3_NONE do { asm volatile("s_waitcnt lgkmcnt(0)" ::: "memory"); } while (0)
__device__ __forceinline__ void pv256(f32x16* o, int vb0, bf16x8 pa0, bf16x8 pa1, bf16x8 pa2, bf16x8 pa3) {
    s16x4 xl0, xh0, xl1, xh1, xl2, xh2, xl3, xh3, yl0, yh0, yl1, yh1, yl2, yh2, yl3, yh3;
    const int va = vb0, vb = vb0 + 16384;
    asm volatile("s_waitcnt lgkmcnt(0)" ::: "memory");
    A3_RDK(va, 0, 0); A3_RDK(va, 0, 1); A3_RDK(va, 0, 2); A3_RDK(va, 0, 3);
    A3_PAIR(o[0], o[1], A3_RDK(va, 2, 0), A3_RDK(va, 2, 1), A3_RDK(va, 2, 2), A3_RDK(va, 2, 3));
    A3_PAIR(o[2], o[3], A3_RDK(vb, 0, 0), A3_RDK(vb, 0, 1), A3_RDK(vb, 0, 2), A3_RDK(vb, 0, 3));
    A3_PAIR(o[4], o[5], A3_RDK(vb, 2, 0), A3_RDK(vb, 2, 1), A3_RDK(vb, 2, 2), A3_RDK(vb, 2, 3));
    A3_PAIR(o[6], o[7], A3_NONE, A3_NONE, A3_NONE, A3_NONE);
}
#undef A3_TRRD
#undef A3_FR
#undef A3_RDK
#undef A3_STEPK
#undef A3_PAIR
#undef A3_NONE
__device__ __forceinline__ float own_sum(const f32x16& P) { return ((P[0] + P[1]) + (P[2] + P[3])) + ((P[4] + P[5]) + (P[6] + P[7])) + (((P[8] + P[9]) + (P[10] + P[11])) + ((P[12] + P[13]) + (P[14] + P[15]))); }
__device__ __forceinline__ void pack_own(const f32x16& P, bf16x8& outA, bf16x8& outB) {
    u32x4 wa = {attn::cvtpk(P[0], P[1]), attn::cvtpk(P[2], P[3]), attn::cvtpk(P[4], P[5]), attn::cvtpk(P[6], P[7])}; outA = *reinterpret_cast<bf16x8*>(&wa);
    u32x4 wb = {attn::cvtpk(P[8], P[9]), attn::cvtpk(P[10], P[11]), attn::cvtpk(P[12], P[13]), attn::cvtpk(P[14], P[15])}; outB = *reinterpret_cast<bf16x8*>(&wb);
}
__device__ __forceinline__ float vmax3(float a, float b, float c) { float d; asm("v_max3_f32 %0, %1, %2, %3" : "=v"(d) : "v"(a), "v"(b), "v"(c)); return d; }
__device__ __forceinline__ void block(const Blk& B, char* lds, A3_LAS unsigned char* ldsl, const int tid) {
    const int wid = __builtin_amdgcn_readfirstlane(tid >> 6), lane = tid & 63, r32 = lane & 31, hi = lane >> 5;
    const int NT = (B.P0 + QB3) / 64;
    char* K_lds = lds + KOFF; char* V_lds = lds + VOFF;
    float* sc_l = (float*)(lds + SCOFF) + wid * 64;
    const int vb0 = (int)(uintptr_t)V_lds + attn::v_rd_base(lane);
    const int qlo = B.P0 + wid * 32, qm = qlo + r32 - 4 * hi;
    constexpr float C2 = 1.4426950408889634f * attn::SCALE;
    unsigned kso[2], vso[2];
#pragma unroll
    for (int i = 0; i < 2; ++i) { const int row = (2 * wid + i) * 4 + (lane >> 4); const int c = (lane & 15) ^ (row & 7); kso[i] = (unsigned)(row * 128 + c * 8) * 2u; }
#pragma unroll
    for (int q = 0; q < 2; ++q) { const int st = 2 * (2 * wid + q) + (lane >> 5), w16 = lane & 31; const int k = (st >> 2) * 8 + (w16 >> 2);
        const int c = (st & 3) * 32 + (w16 & 3) * 8; vso[q] = (unsigned)(k * 128 + c) * 2u; }
#define A3_STAGE(tile, buf) do { const size_t tb_ = (size_t)(tile) * (64 * 256); unsigned ko_[2] = {kso[0], kso[1]}, vo_[2] = {vso[0], vso[1]}; asm volatile("" : "+v"(ko_[0]), "+v"(ko_[1]), "+v"(vo_[0]), "+v"(vo_[1])); \
        _Pragma("unroll") for (int i_ = 0; i_ < 2; ++i_) __builtin_amdgcn_global_load_lds((const unsigned*)((const char*)B.K + tb_ + ko_[i_]), (A3_LAS unsigned*)(ldsl + KOFF + (buf) * 16384 + (2 * wid + i_) * 1024), 16, 0, 0); \
        _Pragma("unroll") for (int q_ = 0; q_ < 2; ++q_) { __builtin_amdgcn_global_load_lds((const unsigned*)((const char*)B.V0 + tb_ + vo_[q_]), (A3_LAS unsigned*)(ldsl + VOFF + (buf) * 32768 + (2 * wid + q_) * 1024), 16, 0, 0); \
            __builtin_amdgcn_global_load_lds((const unsigned*)((const char*)B.V1 + tb_ + vo_[q_]), (A3_LAS unsigned*)(ldsl + VOFF + (buf) * 32768 + 16384 + (2 * wid + q_) * 1024), 16, 0, 0); } } while (0)
    float m_reg = -1e30f, l_reg = 0.f; bf16x8 qr[8]; f32x16 o[8] = {};
#pragma unroll
    for (int d0 = 0; d0 < 8; ++d0) qr[d0] = attn::load8<abf>(B.Q + (size_t)(wid * 32 + r32) * 128 + d0 * 16 + hi * 8);
    A3_STAGE(0, 0);
    asm volatile("s_waitcnt vmcnt(0)" ::: "memory");
    __syncthreads();
    for (int t = 0; t < NT; ++t) {
        const int buf = t & 1, kb = t * 64;
        if (t + 1 < NT) A3_STAGE(t + 1, buf ^ 1);
        f32x16 p0, p1;
        attn::qkt<0, false>(p0, p1, K_lds + buf * 16384, r32, hi, qr, true);
        if (kb + 63 > qlo) attn::mask_tile(p0, p1, qm - kb, 0x7fffffffu);
        float pmax = fmaxf(p0[15], p1[15]);
        { float mb;
          asm("v_max3_f32 %0, %0, %2, %3\n\tv_max3_f32 %1, %10, %11, %12\n\tv_max3_f32 %0, %0, %4, %5\n\tv_max3_f32 %1, %1, %13, %14\n\tv_max3_f32 %0, %0, %6, %7\n\tv_max3_f32 %1, %1, %15, %16\n\tv_max3_f32 %0, %0, %8, %9\n\tv_max3_f32 %1, %1, %17, %18"
              : "+&v"(pmax), "=&v"(mb) : "v"(p0[0]), "v"(p0[1]), "v"(p0[2]), "v"(p0[3]), "v"(p0[4]), "v"(p0[5]), "v"(p0[6]), "v"(p0[7]),
                "v"(p1[0]), "v"(p1[1]), "v"(p1[2]), "v"(p1[3]), "v"(p1[4]), "v"(p1[5]), "v"(p1[6]), "v"(p1[7]), "v"(p1[8]));
          asm("v_max3_f32 %0, %0, %2, %3\n\tv_max3_f32 %1, %1, %9, %10\n\tv_max3_f32 %0, %0, %4, %5\n\tv_max3_f32 %1, %1, %11, %12\n\tv_max3_f32 %0, %0, %6, %7\n\tv_max3_f32 %1, %1, %13, %14\n\tv_max3_f32 %0, %0, %1, %8"
              : "+&v"(pmax), "+&v"(mb) : "v"(p0[8]), "v"(p0[9]), "v"(p0[10]), "v"(p0[11]), "v"(p0[12]), "v"(p0[13]), "v"(p0[14]),
                "v"(p1[9]), "v"(p1[10]), "v"(p1[11]), "v"(p1[12]), "v"(p1[13]), "v"(p1[14])); }
        { auto rr = __builtin_amdgcn_permlane32_swap(__float_as_uint(pmax), __float_as_uint(pmax), false, false); pmax = vmax3(__uint_as_float(rr[0]), __uint_as_float(rr[1]), __uint_as_float(rr[1])); }
        const bool keep = __all((pmax - m_reg) * attn::SCALE <= attn::THR);
        const float mn = keep ? m_reg : vmax3(m_reg, pmax, pmax); const float alpha = __builtin_amdgcn_exp2f((m_reg - mn) * C2); m_reg = mn;
        const float mnL = -mn * C2;
#pragma unroll
        for (int r = 0; r < 16; ++r) { p0[r] = __builtin_amdgcn_exp2f(fmaf(p0[r], C2, mnL)); p1[r] = __builtin_amdgcn_exp2f(fmaf(p1[r], C2, mnL)); }
        l_reg = l_reg * alpha + (own_sum(p0) + own_sum(p1));
        bf16x8 pa0, pa1, pa2, pa3; pack_own(p0, pa0, pa1); pack_own(p1, pa2, pa3);
        if (__any(alpha < 1.f)) {
            if (hi == 0) sc_l[r32] = alpha;
            asm volatile("s_waitcnt lgkmcnt(0)" ::: "memory");
            float a16[16];
#pragma unroll
            for (int r = 0; r < 16; ++r) a16[r] = sc_l[attn::crow(r, hi)];
#pragma unroll
            for (int d0 = 0; d0 < 8; ++d0)
#pragma unroll
                for (int r = 0; r < 16; ++r) o[d0][r] *= a16[r];
        }
        pv256(o, vb0 + buf * 32768, pa0, pa1, pa2, pa3);
        asm volatile("s_waitcnt vmcnt(0)" ::: "memory");
        __syncthreads();
    }
#undef A3_STAGE
    { auto rr = __builtin_amdgcn_permlane32_swap(__float_as_uint(l_reg), __float_as_uint(l_reg), false, false); l_reg = __uint_as_float(rr[0]) + __uint_as_float(rr[1]); }
    if (hi == 0) sc_l[32 + r32] = l_reg;
    asm volatile("s_waitcnt lgkmcnt(0)" ::: "memory");
    float rli[16];
#pragma unroll
    for (int r = 0; r < 16; ++r) rli[r] = __builtin_amdgcn_rcpf(sc_l[32 + attn::crow(r, hi)]);
    abf* Ow = B.O + (size_t)(wid * 32) * LDO;
#pragma unroll
    for (int r = 0; r < 16; ++r) { const int orow = attn::crow(r, hi);
#pragma unroll
        for (int d0 = 0; d0 < 8; ++d0) { const float v = o[d0][r] * rli[r]; const float vn = __shfl_xor(v, 1);
            if ((r32 & 1) == 0) *(unsigned*)(Ow + (size_t)orow * LDO + d0 * 32 + r32) = attn::cvtpk(v, vn); } }
    __syncthreads();
}
}
#define GAS __attribute__((address_space(1)))
#define LAS __attribute__((address_space(3)))
typedef unsigned short bf16;
typedef unsigned v4u __attribute__((ext_vector_type(4)));
typedef float f32x4 __attribute__((ext_vector_type(4)));
typedef short bf16x8 __attribute__((ext_vector_type(8)));
typedef GAS unsigned gu32;
typedef GAS unsigned long long gu64;
#define RLX_AGENT __ATOMIC_RELAXED, __HIP_MEMORY_SCOPE_AGENT
#define LDS_WAIT() asm volatile("s_waitcnt lgkmcnt(0)" ::: "memory")
#define VM_WAIT() asm volatile("s_waitcnt vmcnt(0)" ::: "memory")
__device__ __forceinline__ unsigned long long rt() { return __builtin_amdgcn_s_memrealtime(); }
__device__ __forceinline__ unsigned f2bf(float f) { unsigned u = __builtin_bit_cast(unsigned, f); return (u + 0x7fffu + ((u >> 16) & 1u)) >> 16; }
__device__ __forceinline__ unsigned pk2(float lo, float hi) { return f2bf(lo) | (f2bf(hi) << 16); }

#define XB_TMO      128
#define XB_XCNT(j)  (256  + 64 * (j))
#define XB_XSUB(j)  (1280 + 64 * (j))
#define XB_XGEN(j)  (2304 + 64 * (j))
#define XB_TOP      3328
#define XB_TOPGEN   3392
#define XCD_BAR_WORDS 3456
#define XB_SPIN_CAP (1u << 18)

__device__ __forceinline__ unsigned xb_ld(unsigned* p)              { return __hip_atomic_load(p, __ATOMIC_RELAXED, __HIP_MEMORY_SCOPE_AGENT); }
__device__ __forceinline__ unsigned xb_add(unsigned* p, unsigned v) { return __hip_atomic_fetch_add(p, v, __ATOMIC_RELAXED, __HIP_MEMORY_SCOPE_AGENT); }
__device__ __forceinline__ unsigned xb_xcc_id() { return (unsigned)__builtin_amdgcn_s_getreg((3 << 11) | 20) & 0xFu; }
#define XB_SPIN(cond, bar) do { unsigned _sp = 0; while (cond) { __builtin_amdgcn_s_sleep(1); \
    if ((++_sp & 255u) == 0u) { if (xb_ld(&(bar)[XB_TMO])) break; if (_sp > XB_SPIN_CAP) { atomicAdd(&(bar)[XB_TMO], 1u); break; } } } } while (0)

struct XcdBarrier {
    unsigned* bar; unsigned x;
    volatile LAS unsigned* st;
};

__device__ __forceinline__ XcdBarrier xcd_barrier_post(unsigned* bar, volatile LAS unsigned* st) {
    XcdBarrier b; b.bar = bar; b.x = xb_xcc_id(); b.st = st;
    if (threadIdx.x == 0) (void)xb_add(&bar[XB_XCNT(b.x)], 1u);
    return b;
}
__device__ __forceinline__ void xcd_barrier_complete(unsigned* bar, unsigned x, unsigned& nloc, unsigned& nx) {
    const unsigned G = gridDim.x * gridDim.y * gridDim.z;
    unsigned sum, cnt, mine, sp = 0u;
    for (;;) {
        sum = 0u; cnt = 0u; mine = 0u;
#pragma unroll
        for (unsigned j = 0; j < 16; ++j) { const unsigned c = xb_ld(&bar[XB_XCNT(j)]); sum += c; cnt += (c > 0u) ? 1u : 0u; mine = (j == x) ? c : mine; }
        if (sum == G) break;
        __builtin_amdgcn_s_sleep(1);
        if ((++sp & 255u) == 0u) { if (xb_ld(&bar[XB_TMO])) break; if (sp > XB_SPIN_CAP) { atomicAdd(&bar[XB_TMO], 1u); break; } }
    }
    nloc = mine > 0u ? mine : 1u; nx = cnt > 0u ? cnt : 1u;
}

__device__ __forceinline__ void xcd_barrier(const XcdBarrier& b, const int tid) {
    asm volatile("s_waitcnt vmcnt(0)" ::: "memory");
    __syncthreads();
    if (tid == 0) {
        unsigned* bar = b.bar;
        __builtin_amdgcn_s_waitcnt(0);
        unsigned nloc = b.st[0], nx = b.st[1];
        if (nloc == 0u) { xcd_barrier_complete(bar, b.x, nloc, nx); b.st[0] = nloc; b.st[1] = nx; }
        const unsigned old = xb_add(&bar[XB_XSUB(b.x)], 1u);
        const unsigned gen = old / nloc;
        if (old + 1u == (gen + 1u) * nloc) {
            __builtin_amdgcn_fence(__ATOMIC_RELEASE, "agent");
            asm volatile("s_waitcnt vmcnt(0)" ::: "memory");
            const unsigned og = xb_add(&bar[XB_TOP], 1u);
            const unsigned tg = og / nx;
            if (og + 1u == (tg + 1u) * nx) xb_add(&bar[XB_TOPGEN], 1u);
            else XB_SPIN(xb_ld(&bar[XB_TOPGEN]) == tg, bar);
            __builtin_amdgcn_fence(__ATOMIC_ACQUIRE, "agent");
            xb_add(&bar[XB_XGEN(b.x)], 1u);
            asm volatile("s_waitcnt vmcnt(0)" ::: "memory");
        } else {
            XB_SPIN(xb_ld(&bar[XB_XGEN(b.x)]) == gen, bar);
            __builtin_amdgcn_fence(__ATOMIC_ACQUIRE, "agent");
            asm volatile("s_waitcnt vmcnt(0)" ::: "memory");
        }
    }
    __syncthreads();
}

constexpr int NWAVES = 8;
#ifndef MK_ONE_LAUNCH
#define MK_ONE_LAUNCH 1
#endif
constexpr int NPHASE = 13;
constexpr int T = 8192, DM = 2048, NE = 32;
constexpr float EPS = 1e-5f;
constexpr size_t MiB = 1u << 20;
constexpr size_t WS_CTL = 0, CTL_ZERO_BYTES = 1 * MiB;
constexpr size_t WS_MODP = 1 * MiB;
constexpr size_t WS_MOD = 2 * MiB;
constexpr size_t WS_ROPE = 3 * MiB;
constexpr size_t WS_WRT = 4 * MiB;
constexpr size_t WS_TOPI = 5 * MiB;
constexpr size_t WS_TOPW = 5 * MiB + 256 * 1024;
constexpr size_t WS_TRANK = 5 * MiB + 512 * 1024;
constexpr size_t WS_ECNT = WS_CTL + 512 * 1024;
constexpr size_t WS_STOK = 6 * MiB;
constexpr size_t WS_WIN = 8 * MiB;
constexpr size_t WS_WAO = 72 * MiB, WS_WO = 88 * MiB;
constexpr size_t WS_WUP = 96 * MiB;
constexpr size_t WS_WDN = 608 * MiB;
constexpr size_t WS_H = 864 * MiB;
constexpr size_t WS_Q = 896 * MiB, WS_K = 928 * MiB, WS_V = 960 * MiB;
constexpr size_t WS_R = 992 * MiB;
constexpr size_t WS_OA = 1152 * MiB;
constexpr size_t WS_ON = 1216 * MiB;
constexpr size_t WS_TMP = 1280 * MiB;
constexpr size_t WS_MG = 1344 * MiB;
constexpr size_t WS_X1 = 1376 * MiB;
constexpr size_t WS_XS = 1440 * MiB;
constexpr size_t WS_ACT = 1600 * MiB;
constexpr size_t WS_YS = 1760 * MiB;
constexpr size_t WS_END = 1920 * MiB;
constexpr int CW_BAR = 4096;
constexpr int RING_OFF = 0, RING_BYTES = 131072;
constexpr int TOKTAB_OFF = 131072;
constexpr int LDSCTL_OFF = 157696, MISC_OFF = LDSCTL_OFF + 320, TILE_OFF = LDSCTL_OFF + 1024;
constexpr int LDS_BYTES = 163840;

typedef unsigned u32x2 __attribute__((ext_vector_type(2)));
typedef int i32x4 __attribute__((ext_vector_type(4)));
__device__ __forceinline__ int fresh_lane() { int l; asm volatile("v_mbcnt_lo_u32_b32 %0, -1, 0\n\tv_mbcnt_hi_u32_b32 %0, -1, %0" : "=v"(l)); return l; }
__device__ __forceinline__ float wave_sum(float v) {
#pragma unroll
    for (int o = 1; o < 64; o <<= 1) v += __shfl_xor(v, o);
    return v;
}
__device__ __forceinline__ float dot4(f32x4 a, f32x4 b) { return (a.x * b.x + a.y * b.y) + (a.z * b.z + a.w * b.w); }
__device__ __forceinline__ float bflo(unsigned w) { return __uint_as_float(w << 16); }
__device__ __forceinline__ float bfhi(unsigned w) { return __uint_as_float(w & 0xffff0000u); }
__device__ __forceinline__ u32x2 pack4(f32x4 v) { u32x2 w; w.x = pk2(v.x, v.y); w.y = pk2(v.z, v.w); return w; }
__device__ __forceinline__ f32x4 unpack4(u32x2 w) { return (f32x4){bflo(w.x), bfhi(w.x), bflo(w.y), bfhi(w.y)}; }
__device__ __forceinline__ float inv_freq(int i) {
    float r = 1.000000000e+00f;
    r = i == 1 ? 4.403665960e-01f : r; r = i == 2 ? 1.939227432e-01f : r; r = i == 3 ? 8.539710194e-02f : r; r = i == 4 ? 3.760603070e-02f : r;
    r = i == 5 ? 1.656043902e-02f : r; r = i == 6 ? 7.292664610e-03f : r; r = i == 7 ? 3.211445874e-03f : r; r = i == 8 ? 1.414213562e-03f : r;
    r = i == 9 ? 6.227723788e-04f : r; r = i == 10 ? 2.742481884e-04f : r; r = i == 11 ? 1.207697351e-04f : r; r = i == 12 ? 5.318296098e-05f : r;
    r = i == 13 ? 2.341999971e-05f : r; r = i == 14 ? 1.031338616e-05f : r; r = i == 15 ? 4.541670478e-06f : r;
    return r;
}

struct Args { const void* in[24]; float* out; unsigned char* ws; int ph_lo, ph_hi, li, pad; };
typedef const __attribute__((address_space(4))) unsigned long long* KP;
__device__ __forceinline__ KP kargs() { KP kp = (KP)__builtin_amdgcn_kernarg_segment_ptr(); asm volatile("" : "+s"(kp)); return kp; }
#define KIN(i) ((const void*)(const GAS char*)kp[(i)])
#define KWS() ((unsigned char*)(GAS unsigned char*)kp[25])
#define KOUT() ((float*)(GAS float*)kp[24])

struct ConvSrc { const float* W; bf16* WT; int N; int item; int ldk; int kfast; int tiled; int ktoff; };
__device__ __forceinline__ ConvSrc conv_decode(KP kp, unsigned char* ws, int it) {
    constexpr int I_IN = 32 * 256, I_SQ = 32 * 32, I_UP = 32 * 64, I_DN = 32 * 32;
    ConvSrc c; int r = it; c.ldk = 2048; c.kfast = 0; c.tiled = 32; c.ktoff = 0;
    if (r < I_IN) { c.W = (const float*)KIN(6); c.WT = (bf16*)(ws + WS_WIN); c.N = 16384; c.item = r; return c; } r -= I_IN;
    if (r < I_SQ) { c.W = (const float*)KIN(13); c.WT = (bf16*)(ws + WS_WAO); c.N = 2048; c.item = r; c.ldk = 4096; c.tiled = 64; return c; } r -= I_SQ;
    if (r < I_SQ) { c.W = (const float*)KIN(14); c.WT = (bf16*)(ws + WS_WAO); c.N = 2048; c.item = r; c.ldk = 4096; c.tiled = 64; c.ktoff = 32; return c; } r -= I_SQ;
    if (r < I_SQ) { c.W = (const float*)KIN(15); c.WT = (bf16*)(ws + WS_WO); c.N = 2048; c.item = r; return c; } r -= I_SQ;
    if (r < NE * I_UP) { const int e = r / I_UP; c.W = (const float*)KIN(19) + (size_t)e * 2048 * 4096; c.WT = (bf16*)(ws + WS_WUP) + (size_t)e * 4096 * 2048; c.N = 4096; c.item = r - e * I_UP; return c; } r -= NE * I_UP;
    { const int e = r / I_DN; c.W = (const float*)KIN(21) + (size_t)e * 2048 * 2048; c.WT = (bf16*)(ws + WS_WDN) + (size_t)e * 2048 * 2048; c.N = 2048; c.item = r - e * I_DN; return c; }
}
constexpr int CONV_DENSE_ITEMS = 32 * 256 + 3 * 32 * 32, CONV_UP_MID = CONV_DENSE_ITEMS + NE * 32 * 32, CONV_UP_END = CONV_DENSE_ITEMS + NE * 32 * 64, CONV_ALL_ITEMS = CONV_UP_END + NE * 32 * 32;
__device__ __forceinline__ void conv_load(const ConvSrc& c, int lane, f32x4 (&ra)[8], f32x4 (&rb)[8]) {
    const int nblk = c.N >> 6, kb = c.kfast ? (c.item & 31) : c.item / nblk, nb = c.kfast ? (c.item >> 5) : c.item - kb * nblk, k0 = kb * 64, n0 = nb * 64;
    const int n4 = (lane & 15) * 4, kq = lane >> 4;
#pragma unroll
    for (int i = 0; i < 8; ++i) { const int kp2 = 4 * i + kq; const float* p = c.W + (size_t)(k0 + 2 * kp2) * c.N + n0 + n4; ra[i] = __builtin_nontemporal_load((const GAS f32x4*)p); rb[i] = __builtin_nontemporal_load((const GAS f32x4*)(p + c.N)); }
}
__device__ __forceinline__ void conv_emit(const ConvSrc& c, int lane, LAS unsigned* P, const f32x4 (&ra)[8], const f32x4 (&rb)[8]) {
    const int nblk = c.N >> 6, kb = c.kfast ? (c.item & 31) : c.item / nblk, nb = c.kfast ? (c.item >> 5) : c.item - kb * nblk, k0 = kb * 64, n0 = nb * 64;
    const int n4 = (lane & 15) * 4, kq = lane >> 4;
#pragma unroll
    for (int i = 0; i < 8; ++i) { const int kp2 = 4 * i + kq; LAS unsigned* d = P + kp2 * 65 + n4;
        d[0] = pg8::cvt_pk_bf16(ra[i].x, rb[i].x); d[1] = pg8::cvt_pk_bf16(ra[i].y, rb[i].y); d[2] = pg8::cvt_pk_bf16(ra[i].z, rb[i].z); d[3] = pg8::cvt_pk_bf16(ra[i].w, rb[i].w); }
    LDS_WAIT(); asm volatile("" ::: "memory");
    const int cc = lane & 7;
#pragma unroll
    for (int jj = 0; jj < 8; ++jj) { const int n = (lane >> 3) + 8 * jj; const LAS unsigned* sp = P + (4 * cc) * 65 + n;
        v4u o; o.x = sp[0]; o.y = sp[65]; o.z = sp[130]; o.w = sp[195];
        bf16* dst = c.tiled ? c.WT + (size_t)((nb >> 2) * c.tiled + c.ktoff + kb) * 16384 + ((nb & 3) * 64 + n) * 64 + 8 * cc : c.WT + (size_t)(n0 + n) * c.ldk + k0 + 8 * cc;
        __builtin_nontemporal_store(o, (GAS v4u*)dst); }
    LDS_WAIT(); asm volatile("" ::: "memory");
}
__device__ __forceinline__ void conv_run(KP kp, unsigned char* ws, LAS unsigned* P, int lane, int first, int it_hi, int step) {
    if (first >= it_hi) return;
    const int lastv = first + ((it_hi - 1 - first) / step) * step;
    f32x4 a0[8], b0[8], a1[8], b1[8];
    ConvSrc c0 = conv_decode(kp, ws, first), c1;
    conv_load(c0, lane, a0, b0);
    for (int it = first; it < it_hi; it += 2 * step) {
        c1 = conv_decode(kp, ws, min(it + step, lastv)); conv_load(c1, lane, a1, b1);
        conv_emit(c0, lane, P, a0, b0);
        c0 = conv_decode(kp, ws, min(it + 2 * step, lastv)); conv_load(c0, lane, a0, b0);
        conv_emit(c1, lane, P, a1, b1);
    }
}

__device__ __forceinline__ void phase0(KP kp, LAS unsigned char* lds, int wave, int bid, int G) {
    const int lane = fresh_lane(), tid = wave * 64 + lane;
    unsigned char* ws = KWS();
    { const int* pos = (const int*)KIN(2); float* rope = (float*)(ws + WS_ROPE);
      for (int i = bid * 512 + tid; i < T * 16; i += G * 512) { const int t = i >> 4, f = i & 15;
          const float ang = (float)pos[t] * inv_freq(f); double rev = (double)ang * 0.15915494309189535; rev -= __builtin_rint(rev);
          const float fr = (float)rev; rope[t * 32 + f] = __builtin_amdgcn_cosf(fr); rope[t * 32 + 16 + f] = __builtin_amdgcn_sinf(fr); } }
    { const float* wr = (const float*)KIN(17); float* wrt = (float*)(ws + WS_WRT);
      for (int i = bid * 512 + tid; i < NE * DM; i += G * 512) { const int e = i >> 11, c = i & 2047; wrt[i] = wr[c * NE + e]; } }
    for (int u = bid; u < 256; u += G) {
        const int nc = u & 15, kr = u >> 4, n0 = 768 * nc, k0 = 128 * kr;
        const float* cvec = (const float*)KIN(1); const float* wada = (const float*)KIN(3);
        f32x4 acc[3] = {(f32x4){0.f, 0.f, 0.f, 0.f}, (f32x4){0.f, 0.f, 0.f, 0.f}, (f32x4){0.f, 0.f, 0.f, 0.f}};
#pragma unroll 4
        for (int i = 0; i < 16; ++i) { const int k = k0 + wave + 8 * i; const float cv = cvec[k]; const float s = cv / (1.0f + __expf(-cv));
            const float* p = wada + (size_t)k * 12288 + n0 + 4 * lane;
#pragma unroll
            for (int q = 0; q < 3; ++q) acc[q] += s * *(const GAS f32x4*)(p + 256 * q); }
        LAS float* red = (LAS float*)lds;
#pragma unroll
        for (int q = 0; q < 3; ++q) *(LAS f32x4*)(red + wave * 768 + 256 * q + 4 * lane) = acc[q];
        __syncthreads();
        if (tid < 192) { f32x4 s = *(LAS f32x4*)(red + 4 * tid);
#pragma unroll
            for (int w = 1; w < 8; ++w) s += *(LAS f32x4*)(red + w * 768 + 4 * tid);
            *(GAS f32x4*)((float*)(ws + WS_MODP) + (size_t)kr * 12288 + n0 + 4 * tid) = s; }
        __syncthreads();
    }
    conv_run(kp, ws, (LAS unsigned*)(lds + wave * 8448), lane, bid * NWAVES + wave, CONV_DENSE_ITEMS, G * NWAVES);
}
__device__ __forceinline__ void conv_moe_share(KP kp, LAS unsigned char* lds, int wave, int bid, int G, int it_lo, int it_hi, int lds_off = 0) {
    const int lane = fresh_lane();
    conv_run(kp, KWS(), (LAS unsigned*)(lds + lds_off + wave * 8320), lane, it_lo + bid * NWAVES + wave, it_hi, G * NWAVES);
    __syncthreads();
}
__device__ __forceinline__ void conv_moe_range(KP kp, LAS unsigned char* lds, int wave, int lo, int hi) {
    const int lane = fresh_lane();
    conv_run(kp, KWS(), (LAS unsigned*)(lds + wave * 8320), lane, lo + wave, hi, NWAVES);
    __syncthreads();
}

__device__ __forceinline__ void phase1(KP kp, LAS unsigned char* lds, int wave, int bid, int G) {
    const int lane = fresh_lane(), tid = wave * 64 + lane;
    unsigned char* ws = KWS();
    LAS float* A1 = (LAS float*)lds; LAS float* B1 = A1 + 2048;
    const float* modp = (const float*)(ws + WS_MODP); const float* b_ada = (const float*)KIN(4); const float* n1g = (const float*)KIN(5);
    for (int c = tid; c < 2048; c += 512) { float sh = b_ada[c], sc = b_ada[2048 + c];
        for (int r = 0; r < 16; ++r) { sh += modp[r * 12288 + c]; sc += modp[r * 12288 + 2048 + c]; }
        A1[c] = n1g[c] * (1.0f + sc); B1[c] = sh; }
    { float* mod = (float*)(ws + WS_MOD);
      for (int n = bid * 512 + tid; n < 12288; n += G * 512) { float s = b_ada[n]; for (int r = 0; r < 16; ++r) s += modp[r * 12288 + n]; mod[n] = s; } }
    __syncthreads();
    const float* x = (const float*)KIN(0); bf16* H = (bf16*)(ws + WS_H);
    for (int m = bid * NWAVES + wave; m < T; m += G * NWAVES) {
        const GAS f32x4* xr = (const GAS f32x4*)(x + (size_t)m * DM) + lane;
        f32x4 v[8]; float s = 0.f;
#pragma unroll
        for (int j = 0; j < 8; ++j) { v[j] = xr[64 * j]; s += dot4(v[j], v[j]); }
        const float rstd = 1.0f / sqrtf(wave_sum(s) * (1.0f / DM) + EPS);
        GAS u32x2* o8 = (GAS u32x2*)(H + (size_t)m * DM) + lane;
#pragma unroll
        for (int j = 0; j < 8; ++j) { const f32x4 av = *(const LAS f32x4*)(A1 + 256 * j + 4 * lane), bv = *(const LAS f32x4*)(B1 + 256 * j + 4 * lane);
            o8[64 * j] = pack4(v[j] * rstd * av + bv); }
    }
}

__device__ __forceinline__ void phase4(KP kp, int wave, int bid, int G) {
    const int lane = fresh_lane();
    unsigned char* ws = KWS();
    const int gw = bid * NWAVES + wave, NGW = G * NWAVES;
    float lam;
    { const float* q1 = (const float*)KIN(8); const float* k1 = (const float*)KIN(9); const float* q2 = (const float*)KIN(10); const float* k2 = (const float*)KIN(11);
      const float s1 = wave_sum(q1[lane] * k1[lane] + q1[lane + 64] * k1[lane + 64]), s2 = wave_sum(q2[lane] * k2[lane] + q2[lane + 64] * k2[lane + 64]);
      lam = expf(s1) - expf(s2) + 0.2f; }
    const bf16* OA = (const bf16*)(ws + WS_OA); bf16* ON = (bf16*)(ws + WS_ON);
    const f32x4 sg = *(const GAS f32x4*)((const float*)KIN(12) + 4 * lane) * 0.8f;
    for (int it = gw; it < T * 8; it += NGW) { const int t = it >> 3, hd = it & 7;
        const bf16* o0 = OA + (size_t)t * 4096 + hd * 512 + 4 * lane;
        const f32x4 d = unpack4(*(const GAS u32x2*)o0) - lam * unpack4(*(const GAS u32x2*)(o0 + 256));
        const float rstd = 1.0f / sqrtf(wave_sum(dot4(d, d)) * (1.0f / 256.0f) + EPS);
        *(GAS u32x2*)(ON + (size_t)t * 4096 + hd * 256 + 4 * lane) = pack4(d * rstd * sg); }
    const bf16* R = (const bf16*)(ws + WS_R); bf16* CV = (bf16*)(ws + WS_ON) + 2048; const float* cw = (const float*)KIN(7);
    for (int it = gw; it < 2048; it += NGW) { const int tb = it >> 2, ch = (it & 3) * 512 + 8 * lane, t0 = tb * 16;
        f32x4 w0a = *(const GAS f32x4*)(cw + ch), w0b = *(const GAS f32x4*)(cw + ch + 4), w1a = *(const GAS f32x4*)(cw + 2048 + ch), w1b = *(const GAS f32x4*)(cw + 2048 + ch + 4),
              w2a = *(const GAS f32x4*)(cw + 4096 + ch), w2b = *(const GAS f32x4*)(cw + 4096 + ch + 4);
        f32x4 u1a = (f32x4){0.f, 0.f, 0.f, 0.f}, u1b = u1a, u2a = u1a, u2b = u1a;
        if (t0 > 0) {
            { const bf16* r = R + (size_t)(t0 - 1) * 10240 + ch; const v4u c = *(const GAS v4u*)(r + 2048), h = *(const GAS v4u*)(r + 4096);
              u1a = unpack4((u32x2){c.x, c.y}) * unpack4((u32x2){h.x, h.y}); u1b = unpack4((u32x2){c.z, c.w}) * unpack4((u32x2){h.z, h.w}); }
            { const bf16* r = R + (size_t)(t0 - 2) * 10240 + ch; const v4u c = *(const GAS v4u*)(r + 2048), h = *(const GAS v4u*)(r + 4096);
              u2a = unpack4((u32x2){c.x, c.y}) * unpack4((u32x2){h.x, h.y}); u2b = unpack4((u32x2){c.z, c.w}) * unpack4((u32x2){h.z, h.w}); }
        }
#pragma unroll 4
        for (int i = 0; i < 16; ++i) { const int t = t0 + i; const bf16* r = R + (size_t)t * 10240 + ch;
            const v4u b = *(const GAS v4u*)r, c = *(const GAS v4u*)(r + 2048), h = *(const GAS v4u*)(r + 4096);
            const f32x4 ua = unpack4((u32x2){c.x, c.y}) * unpack4((u32x2){h.x, h.y}), ub = unpack4((u32x2){c.z, c.w}) * unpack4((u32x2){h.z, h.w});
            const f32x4 ya = unpack4((u32x2){b.x, b.y}) * (w0a * u2a + w1a * u1a + w2a * ua), yb = unpack4((u32x2){b.z, b.w}) * (w0b * u2b + w1b * u1b + w2b * ub);
            const u32x2 pa = pack4(ya), pb = pack4(yb);
            *(GAS v4u*)(CV + (size_t)t * 4096 + ch) = (v4u){pa.x, pa.y, pb.x, pb.y};
            u2a = u1a; u2b = u1b; u1a = ua; u1b = ub; }
    }
}

typedef float f32x16 __attribute__((ext_vector_type(16)));
__device__ __forceinline__ float half_max(float v) { v = fmaxf(v, __shfl_xor(v, 1)); v = fmaxf(v, __shfl_xor(v, 2)); v = fmaxf(v, __shfl_xor(v, 4)); v = fmaxf(v, __shfl_xor(v, 8)); v = fmaxf(v, __shfl_xor(v, 16)); return v; }
__device__ __forceinline__ int half_min(int v) { v = min(v, __shfl_xor(v, 1)); v = min(v, __shfl_xor(v, 2)); v = min(v, __shfl_xor(v, 4)); v = min(v, __shfl_xor(v, 8)); v = min(v, __shfl_xor(v, 16)); return v; }
__device__ __forceinline__ void phase8(KP kp, LAS unsigned char* lds, int wave, int bid) {
    const int lane = fresh_lane(), tid = wave * 64 + lane;
    unsigned char* ws = KWS();
    LAS float* A2 = (LAS float*)lds; LAS float* B2 = A2 + 2048;
    LAS float* rs = (LAS float*)(lds + 16384);
    LAS int* eidx = (LAS int*)(lds + 16384 + 128);
    LAS float* part = (LAS float*)(lds + 20480);
    LAS float* lg = (LAS float*)(lds + 56320);
    const float* mod = (const float*)(ws + WS_MOD); const float* n2g = (const float*)KIN(16);
    for (int c = tid; c < 2048; c += 512) { A2[c] = n2g[c] * (1.0f + mod[4 * 2048 + c]); B2[c] = mod[3 * 2048 + c]; }
    __syncthreads();
    const float* X1 = (const float*)(ws + WS_X1); bf16* H = (bf16*)(ws + WS_H); const float* wrt = (const float*)(ws + WS_WRT); const float* br = (const float*)KIN(18);
    int* TOPI = (int*)(ws + WS_TOPI); float* TOPW = (float*)(ws + WS_TOPW);
#pragma unroll 2
    for (int q = 0; q < 4; ++q) {
        const int lt = 4 * wave + q, t = 32 * bid + lt;
        const GAS f32x4* xr = (const GAS f32x4*)(X1 + (size_t)t * DM) + lane;
        f32x4 v[8]; float s = 0.f;
#pragma unroll
        for (int j = 0; j < 8; ++j) { v[j] = xr[64 * j]; s += dot4(v[j], v[j]); }
        const float rstd = 1.0f / sqrtf(wave_sum(s) * (1.0f / DM) + EPS);
        if (lane == 0) rs[lt] = rstd;
        GAS u32x2* o8 = (GAS u32x2*)(H + (size_t)t * DM) + lane;
#pragma unroll
        for (int j = 0; j < 8; ++j) { const f32x4 av = *(const LAS f32x4*)(A2 + 256 * j + 4 * lane), bv = *(const LAS f32x4*)(B2 + 256 * j + 4 * lane);
            o8[64 * j] = pack4(v[j] * rstd * av + bv); }
    }
    __syncthreads();
    {
        const int i = lane & 31, hk = lane >> 5; const float rstd_i = rs[i];
        const float* xrow = X1 + (size_t)(32 * bid + i) * DM + 256 * wave + 16 * hk; const float* wrow = wrt + (size_t)i * DM + 256 * wave + 16 * hk;
        const LAS float* a2p = A2 + 256 * wave + 16 * hk; const LAS float* b2p = B2 + 256 * wave + 16 * hk;
        f32x16 acc = {0.f, 0.f, 0.f, 0.f, 0.f, 0.f, 0.f, 0.f, 0.f, 0.f, 0.f, 0.f, 0.f, 0.f, 0.f, 0.f};
#pragma unroll 2
        for (int kb = 0; kb < 8; ++kb) {
            f32x4 xv[4], wv[4];
#pragma unroll
            for (int q = 0; q < 4; ++q) { xv[q] = *(const GAS f32x4*)(xrow + 32 * kb + 4 * q); wv[q] = *(const GAS f32x4*)(wrow + 32 * kb + 4 * q); }
#pragma unroll
            for (int q = 0; q < 4; ++q) { const f32x4 av = *(const LAS f32x4*)(a2p + 32 * kb + 4 * q), bv = *(const LAS f32x4*)(b2p + 32 * kb + 4 * q); xv[q] = xv[q] * rstd_i * av + bv; }
#pragma unroll
            for (int q = 0; q < 4; ++q) {
                acc = __builtin_amdgcn_mfma_f32_32x32x2f32(xv[q].x, wv[q].x, acc, 0, 0, 0); acc = __builtin_amdgcn_mfma_f32_32x32x2f32(xv[q].y, wv[q].y, acc, 0, 0, 0);
                acc = __builtin_amdgcn_mfma_f32_32x32x2f32(xv[q].z, wv[q].z, acc, 0, 0, 0); acc = __builtin_amdgcn_mfma_f32_32x32x2f32(xv[q].w, wv[q].w, acc, 0, 0, 0); }
        }
#pragma unroll
        for (int r = 0; r < 16; ++r) part[(wave * 32 + (r & 3) + 8 * (r >> 2) + 4 * hk) * 33 + i] = acc[r];
    }
    __syncthreads();
#pragma unroll
    for (int o = tid; o < 1024; o += 512) { const int tok = o >> 5, e = o & 31; float s = br[e];
#pragma unroll
        for (int w = 0; w < 8; ++w) s += part[(w * 32 + tok) * 33 + e];
        lg[tok * 33 + e] = s; }
    __syncthreads();
#pragma unroll
    for (int p = 0; p < 2; ++p) {
        const int tok = 4 * wave + 2 * p + (lane >> 5), e = lane & 31;
        float v = lg[tok * 33 + e]; float tv[4]; int ti[4];
#pragma unroll
        for (int k = 0; k < 4; ++k) { const float m = half_max(v); const int idx = min(half_min(v == m ? e : 64), 31);     tv[k] = m; ti[k] = idx; v = (e == idx) ? -3.0e38f : v; }
        const float p1 = __expf(tv[1] - tv[0]), p2 = __expf(tv[2] - tv[0]), p3 = __expf(tv[3] - tv[0]); const float inv = 1.0f / (1.0f + p1 + p2 + p3);
        if (e == 0) { const int t = 32 * bid + tok;
            *(GAS i32x4*)(TOPI + t * 4) = (i32x4){ti[0], ti[1], ti[2], ti[3]}; *(GAS f32x4*)(TOPW + t * 4) = (f32x4){inv, p1 * inv, p2 * inv, p3 * inv};
            eidx[tok * 4 + 0] = ti[0]; eidx[tok * 4 + 1] = ti[1]; eidx[tok * 4 + 2] = ti[2]; eidx[tok * 4 + 3] = ti[3]; }
    }
    __syncthreads();
    LAS int* cbase = (LAS int*)(lds + 16384 + 1024);
    int rank = 0, em = 0;
    if (tid < 128) { em = eidx[tid]; for (int q = 0; q < tid; ++q) rank += (eidx[q] == em) ? 1 : 0; }
    if (tid < 32) { int cnt = 0; for (int q = 0; q < 128; ++q) cnt += (eidx[q] == tid) ? 1 : 0;
        cbase[tid] = cnt ? __hip_atomic_fetch_add((int*)(ws + WS_ECNT) + 16 * tid, cnt, __ATOMIC_RELAXED, __HIP_MEMORY_SCOPE_AGENT) : 0; }
    __syncthreads();
    if (tid < 128) { const int r = cbase[em] + rank; ((int*)(ws + WS_TRANK))[32 * bid * 4 + tid] = r; ((int*)(ws + WS_STOK))[em * 8192 + r] = 32 * bid + (tid >> 2); }
}

__device__ __forceinline__ void moe_tables(const int* ECNT, LAS unsigned char* lds, int tid) {
    LAS int* totp = (LAS int*)lds;
    LAS int* tile_e = (LAS int*)(lds + TILE_OFF); LAS int* ntl = tile_e + 160; LAS int* pstart = (LAS int*)(lds + TILE_OFF + 1024);
    if (tid < 32) { const int tot = ECNT[16 * tid]; totp[tid] = tot; ((LAS int*)(lds + TILE_OFF + 1280))[tid] = tot; }
    __syncthreads();
    if (tid == 0) { int ps = 0, nt = 0;
        for (int e = 0; e < NE; ++e) { const int c = totp[e]; const int npad = (c + 255) >> 8; pstart[e] = ps; for (int k = 0; k < npad; ++k) { if (nt < 160) tile_e[nt] = e; ++nt; } ps += npad * 256; }
        *ntl = nt < 160 ? nt : 160; }
    __syncthreads();
}

__device__ __forceinline__ void phase12(KP kp, LAS unsigned char* lds, int wave, int bid, int G) {
    const int lane = fresh_lane();
    unsigned char* ws = KWS();
    const float* X1 = (const float*)(ws + WS_X1); const bf16* YS = (const bf16*)(ws + WS_YS); const float* mod = (const float*)(ws + WS_MOD); const float* fg = (const float*)KIN(23);
    const int* TOPI = (const int*)(ws + WS_TOPI); const int* TRANK = (const int*)(ws + WS_TRANK); const float* TOPW = (const float*)(ws + WS_TOPW);
    const LAS int* pstart = (const LAS int*)(lds + TILE_OFF + 1024);
    for (int m = bid * NWAVES + wave; m < T; m += G * NWAVES) {
        const GAS f32x4* xr = (const GAS f32x4*)(X1 + (size_t)m * DM) + lane;
        const i32x4 te = *(const GAS i32x4*)(TOPI + m * 4), rk = *(const GAS i32x4*)(TRANK + m * 4); const f32x4 tw = *(const GAS f32x4*)(TOPW + m * 4);
        const i32x4 sl = (i32x4){pstart[te.x] + rk.x, pstart[te.y] + rk.y, pstart[te.z] + rk.z, pstart[te.w] + rk.w};
        const GAS u32x2* y0 = (const GAS u32x2*)(YS + (size_t)sl.x * DM) + lane; const GAS u32x2* y1 = (const GAS u32x2*)(YS + (size_t)sl.y * DM) + lane;
        const GAS u32x2* y2 = (const GAS u32x2*)(YS + (size_t)sl.z * DM) + lane; const GAS u32x2* y3 = (const GAS u32x2*)(YS + (size_t)sl.w * DM) + lane;
        f32x4 v[8]; float s = 0.f;
#pragma unroll
        for (int j = 0; j < 8; ++j) {
            const f32x4 mo = tw.x * unpack4(y0[64 * j]) + tw.y * unpack4(y1[64 * j]) + tw.z * unpack4(y2[64 * j]) + tw.w * unpack4(y3[64 * j]);
            const f32x4 g2 = *(const GAS f32x4*)(mod + 5 * 2048 + 256 * j + 4 * lane);
            v[j] = xr[64 * j] + g2 * mo; s += dot4(v[j], v[j]); }
        const float rstd = 1.0f / sqrtf(wave_sum(s) * (1.0f / DM) + EPS);
        GAS f32x4* o = (GAS f32x4*)(KOUT() + (size_t)m * DM) + lane;
#pragma unroll
        for (int j = 0; j < 8; ++j) o[64 * j] = v[j] * rstd * *(const GAS f32x4*)(fg + 256 * j + 4 * lane);
    }
}

__device__ __forceinline__ void phase3(KP kp, char* lds, LAS unsigned char* ldsl, int wave, int bid, int G) {
    typedef attn::bf16 abf;
    const int tid = wave * 64 + fresh_lane();
    unsigned char* ws = KWS();
    const abf* Qb = (const abf*)(ws + WS_Q); const abf* Kb = (const abf*)(ws + WS_K); const abf* Vb = (const abf*)(ws + WS_V); abf* OAp = (abf*)(ws + WS_OA);
    for (int L = bid; L < 256; L += G) {
        const int x = L & 7, s = L >> 3, j = 2 * x + (s >> 4), y = s & 15;
#pragma unroll 1
        for (int pass = 0; pass < 2; ++pass) {
            const int qb = (pass ^ ((y ^ j) & 1)) ? y : 31 - y;
            attn3::Blk B; B.Q = Qb + ((size_t)j * T + (size_t)qb * 256) * 128; B.K = Kb + (size_t)j * T * 128;
            B.V0 = Vb + (size_t)((j >> 1) * 2) * T * 128; B.V1 = B.V0 + (size_t)T * 128;
            B.O = OAp + (size_t)(qb * 256) * 4096 + j * 256; B.P0 = qb * 256;
            const int tid_p = wave * 64 + fresh_lane();
            attn3::block(B, lds, ldsl, tid_p);
            if (pass == 0) { conv_run(kargs(), KWS(), (LAS unsigned*)(ldsl + wave * 8320), fresh_lane(), CONV_DENSE_ITEMS + bid * NWAVES + wave, CONV_UP_END, G * NWAVES); __syncthreads(); }
        }
    }
}

__global__ void __launch_bounds__(NWAVES * 64, 2) mk_fwd(Args args) {
    extern __shared__ __attribute__((aligned(16))) unsigned char lds_raw[];
    LAS unsigned char* lds = (LAS unsigned char*)lds_raw;
    volatile LAS unsigned* MISC = (volatile LAS unsigned*)(lds + MISC_OFF);
    const int wave = __builtin_amdgcn_readfirstlane(threadIdx.x >> 6);
    const int G = gridDim.x, bid = blockIdx.x;
    const int lo = ((const __attribute__((address_space(4))) int*)__builtin_amdgcn_kernarg_segment_ptr())[52], hi = ((const __attribute__((address_space(4))) int*)__builtin_amdgcn_kernarg_segment_ptr())[53];
    XcdBarrier bar;
    { KP kp = kargs(); gu32* ctl = (gu32*)(KWS() + WS_CTL);
      const int tid = wave * 64 + fresh_lane();
      for (int u = tid; u < (LDS_BYTES - LDSCTL_OFF) / 4; u += NWAVES * 64) ((LAS unsigned*)(lds + LDSCTL_OFF))[u] = 0u;
      __syncthreads();
      bar.bar = (unsigned*)(ctl + CW_BAR); bar.x = 0; bar.st = nullptr;
      if (hi - lo > 1) bar = xcd_barrier_post((unsigned*)(ctl + CW_BAR), MISC + 8); }
#ifndef PH_MASK
#define PH_MASK 0x1FFF
#endif
#define IN(k) (((PH_MASK >> (k)) & 1) && lo <= (k) && (k) < hi)
#ifndef PH_DUP
#define PH_DUP 0
#endif
#define REP(k) for (int rep_ = 0; rep_ <= ((PH_DUP >> (k)) & 1); ++rep_)
#define REPBAR() do { if (rep_) xcd_barrier(bar, wave * 64 + fresh_lane()); } while (0)
#define NEXTPH(k) ((k) == 5 ? 7 : (k) == 8 ? 10 : (k) + 1)
#define SEAM(k) do { if (IN(k) && IN(NEXTPH(k))) xcd_barrier(bar, wave * 64 + fresh_lane()); } while (0)

    if (IN(0)) { REP(0) { REPBAR(); phase0(kargs(), lds, wave, bid, G); } SEAM(0); }
    if (IN(1)) { REP(1) { REPBAR(); phase1(kargs(), lds, wave, bid, G); } SEAM(1); }
    if (IN(2)) {
        REP(2) { REPBAR();
        KP kp = kargs(); unsigned char* ws = KWS();
        pg8::Gemm g{(const pg8::bf16_t*)(ws + WS_H), (const pg8::bf16_t*)(ws + WS_WIN), T, 16384, 2048, 0, 1};
        pg8::StaticOrder S; S.init(T, 16384, G, bid);
        pg8::EpiInProj E{(pg8::bf16_t*)(ws + WS_Q), (pg8::bf16_t*)(ws + WS_K), (pg8::bf16_t*)(ws + WS_V), (pg8::bf16_t*)(ws + WS_R), (const float*)(ws + WS_ROPE)};
        pg8::gemm_phase<pg8::EpiInProj, pg8::StaticOrder, true, true>(lds + RING_OFF, g, S, E, wave * 64 + fresh_lane());
        }
        SEAM(2);
    }
    if (IN(3)) { REP(3) { REPBAR(); phase3(kargs(), (char*)lds_raw + RING_OFF, lds + RING_OFF, wave, bid, G); } SEAM(3); }
    if (IN(4)) { REP(4) { REPBAR(); phase4(kargs(), wave, bid, G); } SEAM(4); }
    if (IN(5)) {
        REP(5) { REPBAR();
        KP kp = kargs(); unsigned char* ws = KWS();
        pg8::Gemm g{(const pg8::bf16_t*)(ws + WS_ON), (const pg8::bf16_t*)(ws + WS_WAO), T, 2048, 4096, 0, 1};
        pg8::StaticOrder S; S.init(T, 2048, G, bid);
        pg8::EpiMerge2 E{(pg8::bf16_t*)(ws + WS_MG), (const pg8::bf16_t*)(ws + WS_R)};
        pg8::gemm_phase<pg8::EpiMerge2, pg8::StaticOrder, true, true>(lds + RING_OFF, g, S, E, wave * 64 + fresh_lane());
        }
        SEAM(5);
    }
    if (IN(7)) {
        REP(7) { REPBAR();
        KP kp = kargs(); unsigned char* ws = KWS();
        pg8::Gemm g{(const pg8::bf16_t*)(ws + WS_MG), (const pg8::bf16_t*)(ws + WS_WO), T, 2048, 2048, 0, 1};
        pg8::StaticOrder S; S.init(T, 2048, G, bid);
        pg8::EpiResid E{(const float*)KIN(0), (float*)(ws + WS_X1), (const float*)(ws + WS_MOD) + 2 * 2048};
        pg8::gemm_phase<pg8::EpiResid, pg8::StaticOrder, true, true>(lds + RING_OFF, g, S, E, wave * 64 + fresh_lane());
        }
        SEAM(7);
    }
    if (IN(8)) { REP(8) { REPBAR(); phase8(kargs(), lds, wave, bid); } SEAM(8); }
    if (IN(10)) {
        REP(10) { REPBAR();
        KP kp = kargs(); unsigned char* ws = KWS();
        moe_tables((const int*)(ws + WS_ECNT), lds, wave * 64 + fresh_lane());
        const LAS int* tile_e = (const LAS int*)(lds + TILE_OFF); const int nTiles = tile_e[160];
        pg8::Gemm g{(const pg8::bf16_t*)(ws + WS_H), (const pg8::bf16_t*)(ws + WS_WUP), nTiles * 256, 4096, 2048, (size_t)4096 * 2048 * 2, 1};
        pg8::MoeOrder<true> S; S.init(nTiles, 4096, G, bid, tile_e); S.tab = (const LAS int*)(lds + TOKTAB_OFF);
        { const int tid = wave * 64 + fresh_lane(); const int* STOK = (const int*)(ws + WS_STOK); LAS int* tab = (LAS int*)(lds + TOKTAB_OFF);
          const LAS int* pstart = (const LAS int*)(lds + TILE_OFF + 1024); const LAS int* etot = (const LAS int*)(lds + TILE_OFF + 1280);
          for (int i = 0; i < 10; ++i) { pg8::Unit u; if (!S.next(i, u)) break;
              if (tid < 256) { const int rr = u.pm * 256 + tid - pstart[u.e]; const bool valid = rr < etot[u.e]; tab[i * 256 + tid] = valid ? STOK[u.e * 8192 + rr] : 0; } }
          __syncthreads(); }
        pg8::EpiSwiglu E{(pg8::bf16_t*)(ws + WS_ACT), (const float*)KIN(20)};
        const int slot = (bid >> 3) & 7;
        if (slot > 0) { S.i0 = 0; S.imax = slot; pg8::gemm_phase<pg8::EpiSwiglu, pg8::MoeOrder<true>, true, true>(lds + RING_OFF, g, S, E, wave * 64 + fresh_lane()); }
        {
          constexpr int CONV_D = 68; const int nwg = nTiles * 16, rem = nwg - (nwg / G) * G; const long I = CONV_ALL_ITEMS - CONV_UP_END;
          const long Sl = I + (long)CONV_D * rem, Sh = Sl - (long)CONV_D * G;
          const long P0 = bid < rem ? bid * Sh : rem * Sh + (bid - rem) * Sl, P1 = P0 + (bid < rem ? Sh : Sl);
          conv_moe_range(kargs(), lds, wave, CONV_UP_END + (int)(P0 / G), CONV_UP_END + (int)(P1 / G)); }
        S.i0 = slot; S.imax = 1 << 30;
        pg8::gemm_phase<pg8::EpiSwiglu, pg8::MoeOrder<true>, true, true>(lds + RING_OFF, g, S, E, wave * 64 + fresh_lane());
        }
        SEAM(10);
    }
    if (IN(11)) {
        REP(11) { REPBAR();
        KP kp = kargs(); unsigned char* ws = KWS();
        if (!IN(10)) moe_tables((const int*)(ws + WS_ECNT), lds, wave * 64 + fresh_lane());
        const LAS int* tile_e = (const LAS int*)(lds + TILE_OFF); const int nTiles = tile_e[160];
        pg8::Gemm g{(const pg8::bf16_t*)(ws + WS_ACT), (const pg8::bf16_t*)(ws + WS_WDN), nTiles * 256, 2048, 2048, (size_t)2048 * 2048 * 2, 1};
        pg8::MoeOrder<false> S; S.init(nTiles, 2048, G, bid, tile_e);
        pg8::EpiDown E{(pg8::bf16_t*)(ws + WS_YS), (const float*)KIN(22)};
        pg8::gemm_phase<pg8::EpiDown, pg8::MoeOrder<false>, true, true>(lds + RING_OFF, g, S, E, wave * 64 + fresh_lane());
        }
        SEAM(11);
    }
    if (IN(12)) { REP(12) { REPBAR(); if (!IN(11)) { KP kp = kargs(); moe_tables((const int*)(KWS() + WS_ECNT), lds, wave * 64 + fresh_lane()); } phase12(kargs(), lds, wave, bid, G); } }
#undef IN
#undef SEAM
}

extern "C" void kernel_launch(void* const* d_in, const int* in_sizes, int n_in, void* d_out, int out_size, void* d_ws, size_t ws_size, hipStream_t stream) {
    static int grid = 0;
    if (grid == 0) {
        if (n_in != 24 || out_size != T * DM || ws_size < WS_END) { fprintf(stderr, "kernel_launch: unexpected shapes (n_in %d, out %d, ws %zu)\n", n_in, out_size, ws_size); grid = -1; return; }
        if (hipFuncSetAttribute((const void*)mk_fwd, hipFuncAttributeMaxDynamicSharedMemorySize, LDS_BYTES) != hipSuccess) { fprintf(stderr, "kernel_launch: hipFuncSetAttribute failed\n"); grid = -1; return; }
        int per_cu = 0;
        if (hipOccupancyMaxActiveBlocksPerMultiprocessor(&per_cu, (const void*)mk_fwd, NWAVES * 64, LDS_BYTES) != hipSuccess || per_cu < 1) fprintf(stderr, "kernel_launch: occupancy query reports %d\n", per_cu);
        (void)hipGetLastError();
        grid = 256;
    }
    if (grid < 0) return;
    if (hipMemsetAsync((char*)d_ws + WS_CTL, 0, CTL_ZERO_BYTES, stream) != hipSuccess) { fprintf(stderr, "kernel_launch: memset failed\n"); return; }
    Args a{};
    for (int i = 0; i < 24; ++i) a.in[i] = d_in[i];
    a.out = (float*)d_out; a.ws = (unsigned char*)d_ws;
#if MK_ONE_LAUNCH
    a.ph_lo = 0; a.ph_hi = NPHASE; a.li = 0; a.pad = 0;
    hipLaunchKernelGGL(mk_fwd, dim3(grid), dim3(NWAVES * 64), LDS_BYTES, stream, a);
#else
    for (int p = 0; p < NPHASE; ++p) { a.ph_lo = p; a.ph_hi = p + 1; a.li = p; a.pad = 0;
        hipLaunchKernelGGL(mk_fwd, dim3(grid), dim3(NWAVES * 64), LDS_BYTES, stream, a); }
#endif
}
```
